# Optimizing an MI355X kernel written in HIP

```python
import math
import jax, jax.numpy as jnp
from jax import lax
import numpy as np

D_MODEL = 2048
BATCH = 16
SEQ = 2048
DEPTH = 1
DEC_BATCH = 4
DEC_SEQ = 8192
PAST_LEN = 128

MIX_WIDTH = D_MODEL
ATTN_WIDTH = MIX_WIDTH // 2
SSM_WIDTH = MIX_WIDTH - ATTN_WIDTH
HEAD_DIM = 128
N_HEADS = ATTN_WIDTH // HEAD_DIM
N_KV_HEADS = 2
GQA_GROUP = N_HEADS // N_KV_HEADS
KV_WIDTH = N_KV_HEADS * HEAD_DIM
ROPE_AXIS_DIM = HEAD_DIM // 2
ROPE_PAIRS = ROPE_AXIS_DIM // 2
ROPE_THETA = 10000.0
GRID_W = 64
Q_BLOCK = 128
SSM_GROUP = 16
N_SSM_GROUPS = SSM_WIDTH // SSM_GROUP
SSM_STATE = 64
DT_MIN = 0.001
DT_MAX = 0.1
NORM_EPS = 1e-6
IN_COLS = ATTN_WIDTH + 2 * KV_WIDTH + ATTN_WIDTH + SSM_WIDTH + SSM_WIDTH

kernel_name = 'hymba_axial_gqa_s5_bidir_encoder'


def rms_norm(x, w):
    xf = x.astype(jnp.float32)
    return xf * lax.rsqrt(jnp.mean(xf * xf, axis=-1, keepdims=True) + NORM_EPS) * w.astype(jnp.float32)


def axial_rope_tables(n_tokens):
    n_rows = n_tokens // GRID_W
    row = jnp.repeat(jnp.arange(n_rows, dtype=jnp.float32), GRID_W)
    col = jnp.tile(jnp.arange(GRID_W, dtype=jnp.float32), n_rows)
    inv_freq = 1.0 / (ROPE_THETA ** (jnp.arange(ROPE_PAIRS, dtype=jnp.float32) / ROPE_PAIRS))
    ang_r = row[:, None] * inv_freq[None, :]
    ang_c = col[:, None] * inv_freq[None, :]
    ang = jnp.concatenate([ang_r, ang_r, ang_c, ang_c], axis=-1)
    return jnp.cos(ang), jnp.sin(ang)


def apply_axial_rope(x, cos, sin):
    x4 = x.reshape(x.shape[:-1] + (2, 2, ROPE_PAIRS))
    rot = jnp.stack([-x4[..., 1, :], x4[..., 0, :]], axis=-2).reshape(x.shape)
    return x * cos[None, :, None, :] + rot * sin[None, :, None, :]


def block_attention(q, k, v):
    b, s = q.shape[0], q.shape[1]
    n_blocks = s // Q_BLOCK
    qb = q.reshape(b, n_blocks, Q_BLOCK, N_KV_HEADS, GQA_GROUP, HEAD_DIM).transpose(1, 0, 2, 3, 4, 5)
    scale = HEAD_DIM ** -0.5

    def one_block(q_blk):
        scores = jnp.einsum('bqkgd,bskd->bkgqs', q_blk, k) * scale
        probs = jax.nn.softmax(scores, axis=-1)
        return jnp.einsum('bkgqs,bskd->bqkgd', probs, v)

    out = lax.map(one_block, qb)
    return out.transpose(1, 0, 2, 3, 4, 5).reshape(b, s, ATTN_WIDTH)


def _ssm_combine(left, right):
    a_l, b_l = left
    a_r, b_r = right
    return a_r * a_l, a_r * b_l + b_r


def s5_branch(u, lambda_re, lambda_im, log_step, b_re, b_im, c_re, c_im, d_skip):
    bsz, length = u.shape[0], u.shape[1]
    uf = u.astype(jnp.float32)
    ug = uf.reshape(bsz, length, N_SSM_GROUPS, SSM_GROUP)
    bu = lax.complex(jnp.einsum('blgc,gpc->blgp', ug, b_re.astype(jnp.float32)),
                     jnp.einsum('blgc,gpc->blgp', ug, b_im.astype(jnp.float32)))
    y = uf * d_skip.astype(jnp.float32)
    for direction in range(2):
        lam = lax.complex(lambda_re[direction].astype(jnp.float32), lambda_im[direction].astype(jnp.float32))
        dt = jnp.exp(log_step[direction].astype(jnp.float32))[:, None]
        lam_bar = jnp.exp(lam * dt)
        b_scale = (lam_bar - 1.0) / lam
        a_seq = jnp.broadcast_to(lam_bar, (1, length, N_SSM_GROUPS, SSM_STATE))
        _, states = lax.associative_scan(_ssm_combine, (a_seq, bu * b_scale),
                                         reverse=(direction == 1), axis=1)
        y_dir = (jnp.einsum('blgp,gcp->blgc', jnp.real(states), c_re[direction].astype(jnp.float32))
                 - jnp.einsum('blgp,gcp->blgc', jnp.imag(states), c_im[direction].astype(jnp.float32)))
        y = y + y_dir.reshape(bsz, length, SSM_WIDTH)
    return y


def encoder_layer(x, norm_w, w_in, q_norm_w, k_norm_w, lambda_re, lambda_im, log_step,
                  b_re, b_im, c_re, c_im, d_skip, w_glu, attn_out_norm_w, ssm_out_norm_w, w_out):
    bsz, s = x.shape[0], x.shape[1]
    h = rms_norm(x, norm_w).astype(x.dtype)
    z = jnp.einsum('bsd,de->bse', h, w_in)
    o0 = 0
    o1 = o0 + ATTN_WIDTH
    o2 = o1 + KV_WIDTH
    o3 = o2 + KV_WIDTH
    o4 = o3 + ATTN_WIDTH
    o5 = o4 + SSM_WIDTH
    q = z[..., o0:o1].reshape(bsz, s, N_HEADS, HEAD_DIM)
    k = z[..., o1:o2].reshape(bsz, s, N_KV_HEADS, HEAD_DIM)
    v = z[..., o2:o3].reshape(bsz, s, N_KV_HEADS, HEAD_DIM).astype(jnp.float32)
    g_attn = z[..., o3:o4].astype(jnp.float32)
    u_ssm = z[..., o4:o5]
    g_ssm = z[..., o5:].astype(jnp.float32)

    cos, sin = axial_rope_tables(s)
    q = apply_axial_rope(rms_norm(q, q_norm_w), cos, sin)
    k = apply_axial_rope(rms_norm(k, k_norm_w), cos, sin)
    q = q.reshape(bsz, s, N_KV_HEADS, GQA_GROUP, HEAD_DIM)
    o_attn = block_attention(q, k, v) * jax.nn.silu(g_attn)

    y_ssm = jax.nn.gelu(s5_branch(u_ssm, lambda_re, lambda_im, log_step, b_re, b_im, c_re, c_im, d_skip))
    y_ssm = y_ssm * jax.nn.sigmoid(jnp.einsum('bse,ef->bsf', y_ssm, w_glu.astype(jnp.float32)))
    o_ssm = y_ssm * jax.nn.silu(g_ssm)

    merged = jnp.concatenate([rms_norm(o_attn, attn_out_norm_w), rms_norm(o_ssm, ssm_out_norm_w)],
                             axis=-1).astype(x.dtype)
    return x + jnp.einsum('bse,ed->bsd', merged, w_out).astype(x.dtype)


def setup_inputs(seed: int = 0) -> dict:
    key = jax.random.key(seed)
    ks = jax.random.split(key, 20)
    f32 = jnp.float32
    G, P, C = N_SSM_GROUPS, SSM_STATE, SSM_GROUP
    x_prompt = jax.random.normal(ks[0], (BATCH, SEQ, D_MODEL), f32)
    x_sample = jax.random.normal(ks[1], (DEC_BATCH, DEC_SEQ, D_MODEL), f32)
    norm_w = 1.0 + 0.02 * jax.random.normal(ks[2], (DEPTH, D_MODEL), f32)
    w_in = jax.random.normal(ks[3], (DEPTH, D_MODEL, IN_COLS), f32) * D_MODEL ** -0.5
    q_norm_w = 1.0 + 0.02 * jax.random.normal(ks[4], (DEPTH, HEAD_DIM), f32)
    k_norm_w = 1.0 + 0.02 * jax.random.normal(ks[5], (DEPTH, HEAD_DIM), f32)
    lambda_re = -0.5 + 0.01 * jax.random.normal(ks[6], (DEPTH, 2, G, P), f32)
    lambda_im = jnp.broadcast_to(math.pi * jnp.arange(P, dtype=f32), (DEPTH, 2, G, P)) \
        + 0.01 * jax.random.normal(ks[7], (DEPTH, 2, G, P), f32)
    log_step = jax.random.uniform(ks[8], (DEPTH, 2, G), f32) * (math.log(DT_MAX) - math.log(DT_MIN)) \
        + math.log(DT_MIN)
    b_re = jax.random.normal(ks[9], (DEPTH, G, P, C), f32) * (2 * C) ** -0.5
    b_im = jax.random.normal(ks[10], (DEPTH, G, P, C), f32) * (2 * C) ** -0.5
    c_re = jax.random.normal(ks[11], (DEPTH, 2, G, C, P), f32) * (2 * P) ** -0.5
    c_im = jax.random.normal(ks[12], (DEPTH, 2, G, C, P), f32) * (2 * P) ** -0.5
    d_skip = jax.random.normal(ks[13], (DEPTH, SSM_WIDTH), f32)
    w_glu = jax.random.normal(ks[14], (DEPTH, SSM_WIDTH, SSM_WIDTH), f32) * SSM_WIDTH ** -0.5
    attn_out_norm_w = 1.0 + 0.02 * jax.random.normal(ks[15], (DEPTH, ATTN_WIDTH), f32)
    ssm_out_norm_w = 1.0 + 0.02 * jax.random.normal(ks[16], (DEPTH, SSM_WIDTH), f32)
    w_out = jax.random.normal(ks[17], (DEPTH, MIX_WIDTH, D_MODEL), f32) * MIX_WIDTH ** -0.5
    return {'x_prompt': x_prompt, 'x_sample': x_sample, 'norm_w': norm_w, 'w_in': w_in,
            'q_norm_w': q_norm_w, 'k_norm_w': k_norm_w, 'lambda_re': lambda_re,
            'lambda_im': lambda_im, 'log_step': log_step, 'b_re': b_re, 'b_im': b_im,
            'c_re': c_re, 'c_im': c_im, 'd_skip': d_skip, 'w_glu': w_glu,
            'attn_out_norm_w': attn_out_norm_w, 'ssm_out_norm_w': ssm_out_norm_w, 'w_out': w_out}


def reference(x_prompt, x_sample, norm_w, w_in, q_norm_w, k_norm_w, lambda_re, lambda_im, log_step,
              b_re, b_im, c_re, c_im, d_skip, w_glu, attn_out_norm_w, ssm_out_norm_w, w_out):
    hp = x_prompt
    hs = x_sample
    for l in range(DEPTH):
        p = (norm_w[l], w_in[l], q_norm_w[l], k_norm_w[l], lambda_re[l], lambda_im[l], log_step[l],
             b_re[l], b_im[l], c_re[l], c_im[l], d_skip[l], w_glu[l], attn_out_norm_w[l],
             ssm_out_norm_w[l], w_out[l])
        hp = encoder_layer(hp, *p)
        hs = encoder_layer(hs, *p)
    y_prompt = hp
    y_sample = hs
    return (y_prompt, y_sample)
```

```cpp
#include <hip/hip_runtime.h>
#include <hip/hip_bf16.h>
#include <cstdio>
#include <cstdint>
#include <cmath>

#ifndef MK_N_LAUNCHES
#define MK_N_LAUNCHES 8
#endif
constexpr int NPH = 8;
constexpr int N_LAUNCHES = MK_N_LAUNCHES;

constexpr int DM = 2048, NTOK = 65536, NPROMPT = 32768, SP = 2048, SS = 8192;
constexpr int INC = 4608;
constexpr int NG = 64, NPST = 64, NCH = 16, CT = 64, NCHUNK = NTOK / CT;
constexpr int KA = CT * NCH + 4 * NPST;
constexpr float EPS = 1e-6f;

#define GAS __attribute__((address_space(1)))
#define LAS __attribute__((address_space(3)))
typedef unsigned short bf16_t;
typedef short bf16x8 __attribute__((ext_vector_type(8)));
typedef float f32x4 __attribute__((ext_vector_type(4)));
typedef float f32x2 __attribute__((ext_vector_type(2)));
typedef unsigned u32x4 __attribute__((ext_vector_type(4)));
typedef unsigned u32x2 __attribute__((ext_vector_type(2)));
typedef GAS unsigned gu32;

__device__ __forceinline__ unsigned cvt_pk_bf16(float lo, float hi) { unsigned r; asm volatile("v_cvt_pk_bf16_f32 %0, %1, %2" : "=v"(r) : "v"(lo), "v"(hi)); return r; }
__device__ __forceinline__ float bf2f(unsigned short b) { return __uint_as_float(((unsigned)b) << 16); }
__device__ __forceinline__ float bflo(unsigned w) { return __uint_as_float(w << 16); }
__device__ __forceinline__ float bfhi(unsigned w) { return __uint_as_float(w & 0xffff0000u); }
__device__ __forceinline__ float fast_sigmoid(float x) { return __builtin_amdgcn_rcpf(1.0f + __builtin_amdgcn_exp2f(-1.4426950408889634f * x)); }
__device__ __forceinline__ float silu_f(float x) { return x * fast_sigmoid(x); }
__device__ __forceinline__ float gelu_tanh(float x) { const float z = 0.7978845608028654f * (x + 0.044715f * x * x * x); return x * fast_sigmoid(2.0f * z); }

namespace pg8 {
#define PG8_LAS __attribute__((address_space(3)))
constexpr int BM = 256, BK = 64, HALF = 128, HTB = HALF * BK * 2, STAGE_BYTES = 8 * HTB, NXCD = 8, WGM = 8;
__host__ __device__ __forceinline__ int lds_byte(int r, int c) { const int st = (r >> 4) * 2 + (c >> 5), rr = r & 15, cc = c & 31, ob = rr * 64 + cc * 2; return st * 1024 + (ob ^ (((ob >> 9) & 1) << 5)); }
__host__ __device__ __forceinline__ void stage_rc(int b, int& R, int& C) { const int st = b / 1024, sb = b % 1024, swz = sb ^ (((sb >> 9) & 1) << 5); R = (st >> 1) * 16 + swz / 64; C = (st & 1) * 32 + (swz % 64) / 2; }
__host__ __device__ __forceinline__ int perm32(int rho) { const int n = rho >> 4, i = rho & 15; return 8 * (i >> 2) + 4 * n + (i & 3); }

struct Unit { int pm, pn, g; };
struct Gemm { const bf16_t* A; const bf16_t* Bt; int lda, ldb, K; size_t gsA, gsB; };

struct StaticOrder {
    int nM, nN, nwg, G, c;
    __host__ __device__ void init(int M, int N, int G_, int c_) { nM = M / BM; nN = N / BM; nwg = nM * nN; G = G_; c = c_; }
    __host__ __device__ bool next(int i, Unit& u) const {
        const long L = (long)i * G + c; if (L >= nwg) return false;
        int wgid = (int)L; { const int q = nwg / NXCD, r = nwg % NXCD, xcd = wgid % NXCD, off = wgid / NXCD; wgid = (xcd < r ? xcd * (q + 1) : r * (q + 1) + (xcd - r) * q) + off; }
        const int nig = WGM * nN, gid = wgid / nig, fm = gid * WGM, gsz = (nM - fm) < WGM ? (nM - fm) : WGM;
        u.pm = fm + ((wgid % nig) % gsz); u.pn = (wgid % nig) / gsz; u.g = 0; return true;
    }
};
struct BatchOrder {
    int nPm, nPn, ntot, G, vcu;
    __host__ __device__ void init(int nb, int nPm_, int nPn_, int G_, int vcu_) { nPm = nPm_; nPn = nPn_; ntot = nb * nPm_ * nPn_; G = G_; vcu = vcu_; }
    __host__ __device__ bool next(int i, Unit& u) const {
        const long L = (long)i * G + vcu; if (L >= ntot) return false;
        const int per = nPm * nPn, l = (int)L; u.g = l / per; const int t = l % per; u.pm = t / nPn; u.pn = t % nPn; return true;
    }
};

template <class Epi, class Sched, bool ALIGN_EPI = false, bool SP2 = true>
__device__ __forceinline__ void gemm_phase(PG8_LAS unsigned char* lds, const Gemm g, const Sched& S, const Epi& E) {
    const int tid = threadIdx.x, wid = __builtin_amdgcn_readfirstlane(tid >> 6), lane = tid & 63, wr = wid >> 2, wc = wid & 3, fr = lane & 15, fq = lane >> 4;
    const int K = g.K, nt = K / BK;
    unsigned voffA[2], voffB[2];
#pragma unroll
    for (int i = 0; i < 2; ++i) { int R, C; stage_rc(tid * 16 + i * 8192, R, C); const int Rb = Epi::PERM ? ((R & ~31) + perm32(R & 31)) : R;
        voffA[i] = (unsigned)(R * g.lda + C) * 2u; voffB[i] = (unsigned)(Rb * g.ldb + C) * 2u; }
    const size_t kstep = (size_t)(BK * 2);
    const size_t hstepA = (size_t)HALF * g.lda * 2, hstepB = (size_t)HALF * g.ldb * 2;
    const size_t tstepA = 2 * hstepA, tstepB = 2 * hstepB;
    const unsigned ldsw = (unsigned)wid * 1024u;
    const int aoff = lds_byte(wr * 64 + fr, fq * 8), boff = lds_byte(wc * 32 + fr, fq * 8);
#define PG8_SA(b, h) (((b) * 2 + (h)) * HTB)
#define PG8_SB(b, h) ((4 + (b) * 2 + (h)) * HTB)
#define PG8_STAGE(bufoff, gbase, voff) do { _Pragma("unroll") for (int _i = 0; _i < 2; ++_i) \
        __builtin_amdgcn_global_load_lds((const unsigned*)((const char*)(gbase) + (voff)[_i]), (PG8_LAS unsigned*)(lds + (bufoff) + ldsw + _i * 8192), 16, 0, 0); } while (0)
#define PG8_LDA(dst, b, h) do { _Pragma("unroll") for (int m = 0; m < 4; ++m) _Pragma("unroll") for (int k = 0; k < 2; ++k) dst[m][k] = *(const PG8_LAS bf16x8*)(lds + PG8_SA(b, h) + aoff + m * 2048 + k * 1024); } while (0)
#define PG8_LDB(dst, b, h) do { _Pragma("unroll") for (int n = 0; n < 2; ++n) _Pragma("unroll") for (int k = 0; k < 2; ++k) dst[n][k] = *(const PG8_LAS bf16x8*)(lds + PG8_SB(b, h) + boff + n * 2048 + k * 1024); } while (0)
#define PG8_MMA(ai, bj, At, Bt) do { __builtin_amdgcn_s_setprio(1); _Pragma("unroll") for (int m = 0; m < 4; ++m) _Pragma("unroll") for (int n = 0; n < 2; ++n) _Pragma("unroll") for (int k = 0; k < 2; ++k) \
        acc[ai][bj][m][n] = __builtin_amdgcn_mfma_f32_16x16x32_bf16(Bt[n][k], At[m][k], acc[ai][bj][m][n], 0, 0, 0); __builtin_amdgcn_s_setprio(0); } while (0)
#define PG8_WAIT_V(n) asm volatile("s_waitcnt vmcnt(" #n ")" ::: "memory")
#define PG8_WAIT_L(n) asm volatile("s_waitcnt lgkmcnt(" #n ")" ::: "memory")
#define PG8_BAR __builtin_amdgcn_s_barrier()
#define PG8_SCHED __builtin_amdgcn_sched_barrier(0)
    Unit cur, nxt; int ui = 0;
    if (!S.next(0, cur)) return;
    f32x4 acc[2][2][4][2];
#pragma unroll
    for (int a = 0; a < 2; ++a)
#pragma unroll
        for (int b = 0; b < 2; ++b)
#pragma unroll
            for (int m = 0; m < 4; ++m)
#pragma unroll
                for (int n = 0; n < 2; ++n) acc[a][b][m][n] = (f32x4){0.f, 0.f, 0.f, 0.f};
    bf16x8 At[4][2], B0[2][2], B1[2][2];
    const char* cA = (const char*)(g.A + (size_t)cur.g * g.gsA) + (size_t)cur.pm * tstepA; const char* cB = (const char*)(g.Bt + (size_t)cur.g * g.gsB) + (size_t)cur.pn * tstepB;
    static_assert(SP2, "only the SP2 loop is kept in this file");
    PG8_STAGE(PG8_SB(0, 0), cB, voffB); PG8_STAGE(PG8_SB(0, 1), cB + hstepB, voffB); PG8_STAGE(PG8_SA(0, 0), cA, voffA); PG8_STAGE(PG8_SA(0, 1), cA + hstepA, voffA);
    if (wr == 1) PG8_BAR;
    PG8_WAIT_V(2); PG8_BAR;
    PG8_STAGE(PG8_SB(1, 0), cB + kstep, voffB); PG8_STAGE(PG8_SA(1, 0), cA + kstep, voffA); PG8_STAGE(PG8_SB(1, 1), cB + hstepB + kstep, voffB);
    PG8_WAIT_V(6); PG8_BAR;
    for (;;) {
        const bool has_next = S.next(ui + 1, nxt);
        const char* nA = has_next ? (const char*)(g.A + (size_t)nxt.g * g.gsA) + (size_t)nxt.pm * tstepA : cA;
        const char* nB = has_next ? (const char*)(g.Bt + (size_t)nxt.g * g.gsB) + (size_t)nxt.pn * tstepB : cB;
        for (int t = 0; t < nt; t += 2) {
            const bool last = (t == nt - 2);
            const char* a1 = cA + (size_t)(t + 1) * kstep;
            const char* a2 = last ? nA : cA + (size_t)(t + 2) * kstep; const char* b2 = last ? nB : cB + (size_t)(t + 2) * kstep;
            const char* a3 = a2 + kstep; const char* b3 = b2 + kstep;
            if constexpr (Epi::MIDK) { if (t == (nt >> 1)) E.midk(acc, cur, wr, wc, fr, fq); }
            PG8_LDB(B0, 0, 0); PG8_LDB(B1, 0, 1); PG8_SCHED; PG8_LDA(At, 0, 0); PG8_STAGE(PG8_SA(1, 1), a1 + hstepA, voffA);
            PG8_WAIT_V(8); PG8_WAIT_L(0); PG8_BAR; PG8_MMA(0, 0, At, B0); PG8_MMA(0, 1, At, B1); PG8_BAR; PG8_SCHED;
            PG8_LDA(At, 0, 1); PG8_STAGE(PG8_SB(0, 0), b2, voffB); PG8_STAGE(PG8_SB(0, 1), b2 + hstepB, voffB); PG8_STAGE(PG8_SA(0, 0), a2, voffA);
            PG8_WAIT_V(8); PG8_WAIT_L(0); PG8_BAR; PG8_MMA(1, 0, At, B0); PG8_MMA(1, 1, At, B1); PG8_BAR; PG8_SCHED;
            PG8_LDB(B0, 1, 0); PG8_LDB(B1, 1, 1); PG8_SCHED; PG8_LDA(At, 1, 0); PG8_STAGE(PG8_SA(0, 1), a2 + hstepA, voffA);
            PG8_WAIT_V(8); PG8_WAIT_L(0); PG8_BAR; PG8_MMA(0, 0, At, B0); PG8_MMA(0, 1, At, B1); PG8_BAR; PG8_SCHED;
            PG8_LDA(At, 1, 1); PG8_STAGE(PG8_SB(1, 0), b3, voffB); PG8_STAGE(PG8_SB(1, 1), b3 + hstepB, voffB); PG8_STAGE(PG8_SA(1, 0), a3, voffA);
            PG8_WAIT_V(8); PG8_WAIT_L(0); PG8_BAR; PG8_MMA(1, 0, At, B0); PG8_MMA(1, 1, At, B1); PG8_BAR; PG8_SCHED;
        }
        if constexpr (ALIGN_EPI) { if (wr == 0) PG8_BAR; }
        E(acc, cur, wr, wc, fr, fq);
        if (!has_next) break;
#pragma unroll
        for (int a = 0; a < 2; ++a)
#pragma unroll
            for (int b = 0; b < 2; ++b)
#pragma unroll
                for (int m = 0; m < 4; ++m)
#pragma unroll
                    for (int n = 0; n < 2; ++n) acc[a][b][m][n] = (f32x4){0.f, 0.f, 0.f, 0.f};
        cur = nxt; cA = nA; cB = nB; ++ui;
        if constexpr (ALIGN_EPI) { if (wr == 1) PG8_BAR; }
    }
    PG8_WAIT_V(0);
    if constexpr (!ALIGN_EPI) { if (wr == 0) PG8_BAR; }
    PG8_BAR;
#undef PG8_SA
#undef PG8_SB
#undef PG8_STAGE
#undef PG8_LDA
#undef PG8_LDB
#undef PG8_MMA
#undef PG8_WAIT_V
#undef PG8_WAIT_L
#undef PG8_BAR
#undef PG8_SCHED
}

__device__ __forceinline__ u32x4 pack8(const f32x4 v0, const f32x4 v1) { u32x4 w; w.x = cvt_pk_bf16(v0[0], v0[1]); w.y = cvt_pk_bf16(v0[2], v0[3]); w.z = cvt_pk_bf16(v1[0], v1[1]); w.w = cvt_pk_bf16(v1[2], v1[3]); return w; }

struct EpiInProj {
    static constexpr bool PERM = true, MIDK = false;
    const float* rs; bf16_t *Q, *KV, *GA, *GS, *AG;
    __device__ __forceinline__ void operator()(const f32x4 (&acc)[2][2][4][2], const Unit& u, int wr, int wc, int fr, int fq) const {
        const int pn = u.pn; const int row0 = u.pm * BM + wr * 64 + fr; const int colt = pn * BM + wc * 32 + 8 * fq;
        int kind = 0, ld = 1024, cb = colt; bf16_t* base = Q;
        if (pn >= 4 && pn < 6) { base = KV; ld = 512; cb = colt - 1024; }
        else if (pn >= 6 && pn < 10) { base = GA; cb = colt - 1536; kind = 1; }
        else if (pn >= 10 && pn < 14) { base = AG; cb = colt - 2560; kind = 2; }
        else if (pn >= 14) { base = GS; cb = colt - 3584; kind = 1; }
#pragma unroll
        for (int ai = 0; ai < 2; ++ai)
#pragma unroll
            for (int m = 0; m < 4; ++m) { const int r = row0 + ai * HALF + m * 16; const float s = rs[r];
#pragma unroll
                for (int bj = 0; bj < 2; ++bj) { f32x4 v0 = acc[ai][bj][m][0] * s, v1 = acc[ai][bj][m][1] * s;
                    if (kind == 1) {
#pragma unroll
                        for (int e = 0; e < 4; ++e) { v0[e] = silu_f(v0[e]); v1[e] = silu_f(v1[e]); } }
                    const int c = cb + bj * HALF; size_t off;
                    if (kind == 2) off = ((size_t)((c >> 4) * NCHUNK + (r >> 6))) * KA + (size_t)((r & 63) * 16 + (c & 15));
                    else off = (size_t)r * ld + c;
                    *(u32x4*)(base + off) = pack8(v0, v1); } }
    }
};
struct EpiLR {
    static constexpr bool PERM = false, MIDK = false;
    float* LR;
    __device__ __forceinline__ void operator()(const f32x4 (&acc)[2][2][4][2], const Unit& u, int wr, int wc, int fr, int fq) const {
        const int row0 = u.pm * BM + wr * 64 + fr, col0 = wc * 32 + 4 * fq;
#pragma unroll
        for (int ai = 0; ai < 2; ++ai)
#pragma unroll
            for (int m = 0; m < 4; ++m) { float* rowp = LR + ((size_t)u.g * NCHUNK + row0 + ai * HALF + m * 16) * 256 + col0;
#pragma unroll
                for (int bj = 0; bj < 2; ++bj)
#pragma unroll
                    for (int n = 0; n < 2; ++n) *(f32x4*)(rowp + bj * HALF + n * 16) = acc[ai][bj][m][n]; }
    }
};
struct EpiSsm {
    static constexpr bool PERM = true, MIDK = false;
    const bf16_t* AG; const float* dskip; bf16_t* Y;
    __device__ __forceinline__ void operator()(const f32x4 (&acc)[2][2][4][2], const Unit& u, int wr, int wc, int fr, int fq) const {
        const int ch0 = u.pm * BM + wr * 64 + fr, n00 = u.pn * BM + wc * 32 + 8 * fq; const int g = u.g;
        const int co0 = n00 & 15;
        const f32x4 d0 = *(const f32x4*)(dskip + g * 16 + co0), d1 = *(const f32x4*)(dskip + g * 16 + co0 + 4);
#pragma unroll
        for (int ai = 0; ai < 2; ++ai)
#pragma unroll
            for (int m = 0; m < 4; ++m) { const int ch = ch0 + ai * HALF + m * 16;
#pragma unroll
                for (int bj = 0; bj < 2; ++bj) { const int n0 = n00 + bj * HALF, j = n0 >> 4;
                    const u32x4 uw = *(const u32x4*)(AG + ((size_t)g * NCHUNK + ch) * KA + n0);
                    f32x4 v0 = acc[ai][bj][m][0], v1 = acc[ai][bj][m][1];
                    v0[0] += d0[0] * bflo(uw.x); v0[1] += d0[1] * bfhi(uw.x); v0[2] += d0[2] * bflo(uw.y); v0[3] += d0[3] * bfhi(uw.y);
                    v1[0] += d1[0] * bflo(uw.z); v1[1] += d1[1] * bfhi(uw.z); v1[2] += d1[2] * bflo(uw.w); v1[3] += d1[3] * bfhi(uw.w);
#pragma unroll
                    for (int e = 0; e < 4; ++e) { v0[e] = gelu_tanh(v0[e]); v1[e] = gelu_tanh(v1[e]); }
                    *(u32x4*)(Y + ((size_t)ch * CT + j) * 1024 + g * 16 + co0) = pack8(v0, v1); } }
    }
};
struct EpiGlu {
    static constexpr bool PERM = true, MIDK = false;
    const bf16_t* Y; const bf16_t* GS; bf16_t* MG; float* SSQS;
    __device__ __forceinline__ void operator()(const f32x4 (&acc)[2][2][4][2], const Unit& u, int wr, int wc, int fr, int fq) const {
        const int row0 = u.pm * BM + wr * 64 + fr, c00 = u.pn * BM + wc * 32 + 8 * fq;
#pragma unroll
        for (int ai = 0; ai < 2; ++ai)
#pragma unroll
            for (int m = 0; m < 4; ++m) { const int r = row0 + ai * HALF + m * 16; float ss = 0.f;
#pragma unroll
                for (int bj = 0; bj < 2; ++bj) { const int c = c00 + bj * HALF;
                    const u32x4 yw = *(const u32x4*)(Y + (size_t)r * 1024 + c), gw = *(const u32x4*)(GS + (size_t)r * 1024 + c);
                    const f32x4 a0 = acc[ai][bj][m][0], a1 = acc[ai][bj][m][1]; f32x4 v0, v1;
                    v0[0] = bflo(yw.x) * fast_sigmoid(a0[0]) * bflo(gw.x); v0[1] = bfhi(yw.x) * fast_sigmoid(a0[1]) * bfhi(gw.x);
                    v0[2] = bflo(yw.y) * fast_sigmoid(a0[2]) * bflo(gw.y); v0[3] = bfhi(yw.y) * fast_sigmoid(a0[3]) * bfhi(gw.y);
                    v1[0] = bflo(yw.z) * fast_sigmoid(a1[0]) * bflo(gw.z); v1[1] = bfhi(yw.z) * fast_sigmoid(a1[1]) * bfhi(gw.z);
                    v1[2] = bflo(yw.w) * fast_sigmoid(a1[2]) * bflo(gw.w); v1[3] = bfhi(yw.w) * fast_sigmoid(a1[3]) * bfhi(gw.w);
#pragma unroll
                    for (int e = 0; e < 4; ++e) ss += v0[e] * v0[e] + v1[e] * v1[e];
                    *(u32x4*)(MG + (size_t)r * 2048 + 1024 + c) = pack8(v0, v1); }
                ss += __shfl_xor(ss, 16); ss += __shfl_xor(ss, 32);
                if (fq == 0) SSQS[(size_t)r * 16 + u.pn * 4 + wc] = ss; }
    }
};
struct EpiOut {
    static constexpr bool PERM = false, MIDK = true;
    const float* xp; const float* xs; float* out; const float* ratio; const float* rsn;
    __device__ __forceinline__ void midk(f32x4 (&acc)[2][2][4][2], const Unit& u, int wr, int wc, int fr, int fq) const {
        const int row0 = u.pm * BM + wr * 64 + fr;
#pragma unroll
        for (int ai = 0; ai < 2; ++ai)
#pragma unroll
            for (int m = 0; m < 4; ++m) { const float s = ratio[row0 + ai * HALF + m * 16];
#pragma unroll
                for (int bj = 0; bj < 2; ++bj)
#pragma unroll
                    for (int n = 0; n < 2; ++n) acc[ai][bj][m][n] *= s; }
    }
    __device__ __forceinline__ void operator()(const f32x4 (&acc)[2][2][4][2], const Unit& u, int wr, int wc, int fr, int fq) const {
        const int row0 = u.pm * BM + wr * 64 + fr, col0 = u.pn * BM + wc * 32 + 4 * fq;
#pragma unroll
        for (int ai = 0; ai < 2; ++ai)
#pragma unroll
            for (int m = 0; m < 4; ++m) { const int r = row0 + ai * HALF + m * 16; const float s = rsn[r];
                const float* xr = (r < NPROMPT ? xp + (size_t)r * DM : xs + (size_t)(r - NPROMPT) * DM) + col0; float* orow = out + (size_t)r * DM + col0;
#pragma unroll
                for (int bj = 0; bj < 2; ++bj)
#pragma unroll
                    for (int n = 0; n < 2; ++n) { const f32x4 xv = *(const f32x4*)(xr + bj * HALF + n * 16); *(f32x4*)(orow + bj * HALF + n * 16) = xv + acc[ai][bj][m][n] * s; } }
    }
};
}

namespace attn {
using bf16 = __hip_bfloat16;
constexpr int D = 128, NW = 8, QBLK = 32, KVBLK = 64;
constexpr float SCALE = 0.088388347648318440f;
constexpr float THR = 8.f;
constexpr int SDEPTH = 2;
constexpr int LDQ = 1024, LDK = 512, LDO = 2048;
constexpr size_t SHM_V = KVBLK * D * 2, SHM_K = KVBLK * D * 2, SHM_ATTN = 2 * SHM_V + 2 * SHM_K + NW * 64 * 4;
using s16x4 = __attribute__((ext_vector_type(4))) short;
using f32x16 = __attribute__((ext_vector_type(16))) float;
#define KSWZ(row, colB) ((row) * 256 + ((colB) ^ (((row) & 7) << 4)))
#define SBAR() __builtin_amdgcn_sched_barrier(0)
__device__ __forceinline__ int crow(int r, int hi) { return (r & 3) + 8 * (r >> 2) + 4 * hi; }
__device__ __forceinline__ unsigned cvtpk(float lo, float hi) { unsigned r; asm volatile("v_cvt_pk_bf16_f32 %0, %1, %2" : "=v"(r) : "v"(lo), "v"(hi)); return r; }
__device__ __forceinline__ void partialSM(f32x16& p0, f32x16& p1, float& m_reg, float& mn, float& alpha) {
  constexpr float C = SCALE * 1.4426950408889634f;
  float pmax = p0[0]; for (int r = 1; r < 16; ++r) pmax = fmaxf(pmax, p0[r]); for (int r = 0; r < 16; ++r) pmax = fmaxf(pmax, p1[r]);
  { auto rr = __builtin_amdgcn_permlane32_swap(__float_as_uint(pmax), __float_as_uint(pmax), false, false);
    pmax = fmaxf(__uint_as_float(rr[0]), __uint_as_float(rr[1])); }
  if (__builtin_expect(__all(pmax - m_reg <= THR / SCALE), 1)) { mn = m_reg; alpha = 1.f; }
  else { mn = fmaxf(m_reg, pmax); alpha = __builtin_amdgcn_exp2f((m_reg - mn) * C); m_reg = mn; }
  float mnC = -mn * C;
  for (int r = 0; r < 16; ++r) p0[r] = fmaf(p0[r], C, mnC); for (int r = 0; r < 16; ++r) p1[r] = fmaf(p1[r], C, mnC);
  for (int r = 0; r < 16; ++r) p0[r] = __builtin_amdgcn_exp2f(p0[r]);
}
__device__ __forceinline__ void finishSM(f32x16& p0, f32x16& p1, float alpha, float& l_reg, bf16x8& pa0, bf16x8& pa1, bf16x8& pa2, bf16x8& pa3) {
  for (int r = 0; r < 16; ++r) p1[r] = __builtin_amdgcn_exp2f(p1[r]);
  float ps = 0; for (int r = 0; r < 16; ++r) ps += p0[r]; for (int r = 0; r < 16; ++r) ps += p1[r];
  { auto rr = __builtin_amdgcn_permlane32_swap(__float_as_uint(ps), __float_as_uint(ps), false, false);
    ps = __uint_as_float(rr[0]) + __uint_as_float(rr[1]); }
  l_reg = l_reg * alpha + ps;
#define PK4(P, BASE, OUT) do { unsigned a0 = cvtpk(P[BASE + 0], P[BASE + 1]), a1 = cvtpk(P[BASE + 2], P[BASE + 3]);   \
    unsigned b0 = cvtpk(P[BASE + 4], P[BASE + 5]), b1 = cvtpk(P[BASE + 6], P[BASE + 7]);                              \
    auto r0 = __builtin_amdgcn_permlane32_swap(a0, b0, false, false); auto r1 = __builtin_amdgcn_permlane32_swap(a1, b1, false, false); \
    u32x4 w = {r0[0], r1[0], r0[1], r1[1]}; OUT = *reinterpret_cast<bf16x8*>(&w); } while (0)
  PK4(p0, 0, pa0); PK4(p0, 8, pa1); PK4(p1, 0, pa2); PK4(p1, 8, pa3);
#undef PK4
}
__device__ __forceinline__ void qkt(f32x16& p0, f32x16& p1, const bf16* Ks, const bf16x8* qr, int r32, int hi) {
  p0 = f32x16{}; p1 = f32x16{};
  for (int d0 = 0; d0 < 8; ++d0) { int cb = (d0 * 16 + hi * 8) * 2;
    bf16x8 b0 = *reinterpret_cast<const bf16x8*>((const char*)Ks + KSWZ(r32, cb));
    bf16x8 b1 = *reinterpret_cast<const bf16x8*>((const char*)Ks + KSWZ(32 + r32, cb));
    p0 = __builtin_amdgcn_mfma_f32_32x32x16_bf16(b0, qr[d0], p0, 0, 0, 0);
    p1 = __builtin_amdgcn_mfma_f32_32x32x16_bf16(b1, qr[d0], p1, 0, 0, 0); }
}
__device__ __forceinline__ int v_st(int k, int c) { const int kk = (k & ~0xC) | ((k & 4) << 1) | ((k & 8) >> 1); return ((kk >> 3) * 4 + (c >> 5)) * 512 + ((kk & 7) * 32 + (c & 31)) * 2; }
__device__ __forceinline__ int v_rd_base(int lane) { return ((lane & 3) << 3) | (((lane >> 2) & 3) << 6) | (((lane >> 4) & 1) << 5) | (((lane >> 5) & 1) << 8); }
constexpr int v_rd_off(int d0, int ks, int half) { return d0 * 512 + ks * 4096 + half * 2048; }
template <int OFF> __device__ __forceinline__ s16x4 tr_read(int vb) {
  s16x4 r; asm volatile("ds_read_b64_tr_b16 %0, %1 offset:%2" : "=&v"(r) : "v"(vb), "i"(OFF) : "memory"); return r;
}
template <int D0> __device__ __forceinline__ void pv_one(f32x16& od, int vb, bf16x8 pa0, bf16x8 pa1, bf16x8 pa2, bf16x8 pa3) {
  const s16x4 l0 = tr_read<v_rd_off(D0, 0, 0)>(vb), h0 = tr_read<v_rd_off(D0, 0, 1)>(vb), l1 = tr_read<v_rd_off(D0, 1, 0)>(vb), h1 = tr_read<v_rd_off(D0, 1, 1)>(vb);
  const s16x4 l2 = tr_read<v_rd_off(D0, 2, 0)>(vb), h2 = tr_read<v_rd_off(D0, 2, 1)>(vb), l3 = tr_read<v_rd_off(D0, 3, 0)>(vb), h3 = tr_read<v_rd_off(D0, 3, 1)>(vb);
  asm volatile("s_waitcnt lgkmcnt(0)" ::: "memory"); SBAR();
#define PK(L, H) (bf16x8){L[0], L[1], L[2], L[3], H[0], H[1], H[2], H[3]}
  od = __builtin_amdgcn_mfma_f32_32x32x16_bf16(pa0, PK(l0, h0), od, 0, 0, 0);
  od = __builtin_amdgcn_mfma_f32_32x32x16_bf16(pa1, PK(l1, h1), od, 0, 0, 0);
  od = __builtin_amdgcn_mfma_f32_32x32x16_bf16(pa2, PK(l2, h2), od, 0, 0, 0);
  od = __builtin_amdgcn_mfma_f32_32x32x16_bf16(pa3, PK(l3, h3), od, 0, 0, 0);
#undef PK
}
__device__ __forceinline__ void pv_d0(f32x16* o, int vb, bf16x8 pa0, bf16x8 pa1, bf16x8 pa2, bf16x8 pa3) {
  pv_one<0>(o[0], vb, pa0, pa1, pa2, pa3); pv_one<1>(o[1], vb, pa0, pa1, pa2, pa3); pv_one<2>(o[2], vb, pa0, pa1, pa2, pa3); pv_one<3>(o[3], vb, pa0, pa1, pa2, pa3);
}

__device__ __forceinline__ void attn_dense_body(const bf16_t* __restrict__ Qb, const bf16* __restrict__ Kh, const bf16* __restrict__ Vh,
                                                const bf16_t* __restrict__ GAb, bf16_t* __restrict__ Ob, float* __restrict__ ssq,
                                                const float* __restrict__ qnw, const f32x2* __restrict__ tab, int pos0, int seq, char* lds) {
  const int tid = threadIdx.x, wid = tid >> 6, lane = tid & 63, r32 = lane & 31, hi = lane >> 5;
  bf16* V_lds = (bf16*)lds; bf16* K_lds = (bf16*)(lds + 2 * SHM_V);
  float* ws = (float*)(lds + 2 * SHM_V + 2 * SHM_K) + wid * 64; float* li_l = ws; float* al_l = ws + 32;
  bf16x8 qr[8];
  {
    const bf16_t* Qw = Qb + (long)(wid * QBLK + r32) * LDQ + hi * 8;
    u32x4 raw[8]; float ss = 0.f;
#pragma unroll
    for (int d0 = 0; d0 < 8; ++d0) raw[d0] = *reinterpret_cast<const u32x4*>(Qw + d0 * 16);
#pragma unroll
    for (int d0 = 0; d0 < 8; ++d0) {
#pragma unroll
      for (int q = 0; q < 4; ++q) { const float a = bflo(raw[d0][q]), b = bfhi(raw[d0][q]); ss += a * a + b * b; } }
    { auto rr = __builtin_amdgcn_permlane32_swap(__float_as_uint(ss), __float_as_uint(ss), false, false); ss = __uint_as_float(rr[0]) + __uint_as_float(rr[1]); }
    const float rn = 1.0f / sqrtf(ss * (1.0f / 128.0f) + EPS);
    const int pos = pos0 + wid * QBLK + r32, prow = pos >> 6, pcol = pos & 63;
#pragma unroll
    for (int pg = 0; pg < 4; ++pg) { const int dd = pg & 1, ax = pg >> 1, d0 = ax * 4 + dd;
      const f32x2* tp = tab + (ax == 0 ? prow : pcol) * 32 + hi * 8 + dd * 16;
      const float* wa = qnw + d0 * 16 + hi * 8; const float* wb = wa + 32;
      float na[8], nb[8];
#pragma unroll
      for (int q = 0; q < 4; ++q) {
        const f32x2 c0 = tp[2 * q], c1 = tp[2 * q + 1];
        const float a0 = bflo(raw[d0][q]) * (rn * wa[2 * q]), a1 = bfhi(raw[d0][q]) * (rn * wa[2 * q + 1]);
        const float b0 = bflo(raw[d0 + 2][q]) * (rn * wb[2 * q]), b1 = bfhi(raw[d0 + 2][q]) * (rn * wb[2 * q + 1]);
        na[2 * q] = a0 * c0.x - b0 * c0.y; nb[2 * q] = b0 * c0.x + a0 * c0.y;
        na[2 * q + 1] = a1 * c1.x - b1 * c1.y; nb[2 * q + 1] = b1 * c1.x + a1 * c1.y; }
      { u32x4 w = {cvtpk(na[0], na[1]), cvtpk(na[2], na[3]), cvtpk(na[4], na[5]), cvtpk(na[6], na[7])}; qr[d0] = *reinterpret_cast<bf16x8*>(&w); }
      { u32x4 w = {cvtpk(nb[0], nb[1]), cvtpk(nb[2], nb[3]), cvtpk(nb[4], nb[5]), cvtpk(nb[6], nb[7])}; qr[d0 + 2] = *reinterpret_cast<bf16x8*>(&w); }
      asm volatile("" ::: "memory"); }
  }
  float m_reg = -1e30f, l_reg = 0; f32x16 o[4] = {};
  const int sr = tid >> 4, sc = (tid & 15) * 8, vst0 = v_st(sr, sc), vst1 = v_st(32 + sr, sc);
  const int vb0 = (int)(uintptr_t)V_lds + v_rd_base(lane);
  struct { bf16x8 vs0, vs1, ks0, ks1; } sr_[SDEPTH];
#define SLD8(p) (*reinterpret_cast<const bf16x8*>(p))
#define SLOAD(i, k0) do { sr_[i].vs0 = SLD8(&Vh[(long)((k0) + sr) * LDK + sc]); sr_[i].vs1 = SLD8(&Vh[(long)((k0) + 32 + sr) * LDK + sc]); \
    sr_[i].ks0 = SLD8(&Kh[(long)((k0) + sr) * LDK + sc]); sr_[i].ks1 = SLD8(&Kh[(long)((k0) + 32 + sr) * LDK + sc]); } while (0)
#define SWRITE(b, i) do { *(bf16x8*)((char*)V_lds + (b) * SHM_V + vst0) = sr_[i].vs0;          \
    *(bf16x8*)((char*)V_lds + (b) * SHM_V + vst1) = sr_[i].vs1; int kc = sc * 2;               \
    *(bf16x8*)((char*)K_lds + (b) * SHM_K + KSWZ(sr, kc)) = sr_[i].ks0;                       \
    *(bf16x8*)((char*)K_lds + (b) * SHM_K + KSWZ(32 + sr, kc)) = sr_[i].ks1; } while (0)
#define SWAIT() do { asm volatile("s_waitcnt vmcnt(4)" ::: "memory"); } while (0)
#define RESC(a) do { if (__any((a) < 1.f)) { if (hi == 0) al_l[r32] = (a); asm volatile("s_waitcnt lgkmcnt(0)" ::: "memory"); \
    for (int d = 0; d < 4; ++d) for (int r = 0; r < 16; ++r) o[d][r] *= al_l[crow(r, hi)]; } } while (0)
  f32x16 pA0, pA1, pB0, pB1; float mnA, mnB, alA, alB; bf16x8 pa0, pa1, pa2, pa3; const int NT = seq / KVBLK;
  constexpr int SE = 0, SO = SDEPTH - 1;
  SLOAD(SE, 0); asm volatile("s_waitcnt vmcnt(0)" ::: "memory"); SWRITE(0, SE); __syncthreads();
  qkt(pA0, pA1, K_lds, qr, r32, hi); partialSM(pA0, pA1, m_reg, mnA, alA);
  SLOAD(SO, KVBLK); if (2 < NT) SLOAD(SE, 2 * KVBLK);
  SWAIT(); SWRITE(1, SO); __syncthreads();
  for (int j = 1; j + 1 < NT; j += 2) {
    SBAR(); qkt(pB0, pB1, (bf16*)((char*)K_lds + SHM_K), qr, r32, hi);
    finishSM(pA0, pA1, alA, l_reg, pa0, pa1, pa2, pa3); SBAR();
    SLOAD(SO, (j + SDEPTH) * KVBLK); SBAR();
    pv_d0(o, vb0, pa0, pa1, pa2, pa3); partialSM(pB0, pB1, m_reg, mnB, alB);
    __syncthreads(); SWAIT(); SWRITE(0, SE);
    RESC(alB); __syncthreads();
    SBAR(); qkt(pA0, pA1, K_lds, qr, r32, hi);
    finishSM(pB0, pB1, alB, l_reg, pa0, pa1, pa2, pa3); SBAR();
    if (j + 3 < NT) SLOAD(SE, (j + 1 + SDEPTH) * KVBLK); SBAR();
    pv_d0(o, vb0 + (int)SHM_V, pa0, pa1, pa2, pa3); partialSM(pA0, pA1, m_reg, mnA, alA);
    __syncthreads(); SWAIT(); SWRITE(1, SO);
    RESC(alA); __syncthreads();
  }
  SBAR(); qkt(pB0, pB1, (bf16*)((char*)K_lds + SHM_K), qr, r32, hi);
  finishSM(pA0, pA1, alA, l_reg, pa0, pa1, pa2, pa3); SBAR();
  pv_d0(o, vb0, pa0, pa1, pa2, pa3); partialSM(pB0, pB1, m_reg, mnB, alB);
  __syncthreads(); RESC(alB);
  finishSM(pB0, pB1, alB, l_reg, pa0, pa1, pa2, pa3); SBAR();
  pv_d0(o, vb0 + (int)SHM_V, pa0, pa1, pa2, pa3);
  if (hi == 0) li_l[r32] = l_reg; asm volatile("s_waitcnt lgkmcnt(0)" ::: "memory");
  { int te = threadIdx.x; asm volatile("" : "+v"(te));
    const int ew = te >> 6, er = te & 31, eh = (te >> 5) & 1;
    const long rbase = (long)(ew * QBLK + 4 * eh) ;
#pragma unroll
    for (int r = 0; r < 16; ++r) { const int orow = (r & 3) + 8 * (r >> 2); const float rl = __builtin_amdgcn_rcpf(li_l[orow + 4 * eh]); float s2 = 0.f;
      const bf16_t* gp = GAb + (rbase + orow) * 1024 + er; bf16_t* op = Ob + (rbase + orow) * LDO + er;
#pragma unroll
      for (int d0 = 0; d0 < 4; ++d0) { const float gv = bf2f(gp[d0 * 32]); const float v = o[d0][r] * rl * gv; s2 += v * v;
        op[d0 * 32] = (bf16_t)(cvtpk(v, v) & 0xffffu); }
      s2 += __shfl_xor(s2, 1); s2 += __shfl_xor(s2, 2); s2 += __shfl_xor(s2, 4); s2 += __shfl_xor(s2, 8); s2 += __shfl_xor(s2, 16);
      if (er == 0) ssq[(rbase + orow) * 8] = s2; } }
  __syncthreads();
#undef SLD8
#undef SLOAD
#undef SWRITE
#undef SWAIT
#undef RESC
}
#undef KSWZ
#undef SBAR
}

constexpr size_t MiB = 1u << 20;
constexpr size_t WS_CTL = 0, CTL_ZERO_BYTES = 1 * MiB;
constexpr size_t WS_RS = 1 * MiB;
constexpr size_t WS_RATIO = 2 * MiB;
constexpr size_t WS_RSN = 3 * MiB;
constexpr size_t WS_SSQA = 4 * MiB;
constexpr size_t WS_SSQS = 6 * MiB;
constexpr size_t WS_TAB = 10 * MiB;
constexpr size_t WS_WINT = 16 * MiB;
constexpr size_t WS_WGLUT = 34 * MiB;
constexpr size_t WS_WOUTT = 36 * MiB;
constexpr size_t WS_Q = 64 * MiB;
constexpr size_t WS_KV = 192 * MiB;
constexpr size_t WS_GA = 256 * MiB;
constexpr size_t WS_GS = 384 * MiB;
constexpr size_t WS_MG = 512 * MiB;
constexpr size_t WS_Y = 768 * MiB;
constexpr size_t WS_END = 896 * MiB;
constexpr size_t OU_XB = 0;
constexpr size_t OU_BTM = 0;
constexpr size_t OU_AG = 256 * MiB;
constexpr size_t OU_WLR = 416 * MiB;
constexpr size_t OU_K0 = 448 * MiB;
constexpr size_t OU_LR = 456 * MiB;
constexpr size_t WS_LR = 896 * MiB;
constexpr size_t WS_BTM = 960 * MiB;
constexpr size_t WS_NEED = 960 * MiB;

constexpr int CW_TMO = 0, CW_BAR = 4096;

#define XB_TMO      128
#define XB_XCNT(j)  (256  + 64 * (j))
#define XB_XSUB(j)  (1280 + 64 * (j))
#define XB_XGEN(j)  (2304 + 64 * (j))
#define XB_TOP      3328
#define XB_TOPGEN   3392
#define XCD_BAR_WORDS 3456
#define XB_SPIN_CAP (1u << 20)
__device__ __forceinline__ unsigned xb_ld(unsigned* p)              { return __hip_atomic_load(p, __ATOMIC_RELAXED, __HIP_MEMORY_SCOPE_AGENT); }
__device__ __forceinline__ unsigned xb_add(unsigned* p, unsigned v) { return __hip_atomic_fetch_add(p, v, __ATOMIC_RELAXED, __HIP_MEMORY_SCOPE_AGENT); }
__device__ __forceinline__ unsigned xb_xcc_id() { return (unsigned)__builtin_amdgcn_s_getreg((3 << 11) | 20) & 0xFu; }
#define XB_SPIN(cond, bar) do { unsigned _sp = 0; while (cond) { __builtin_amdgcn_s_sleep(1); \
    if ((++_sp & 255u) == 0u) { if (xb_ld(&(bar)[XB_TMO])) break; if (_sp > XB_SPIN_CAP) { atomicAdd(&(bar)[XB_TMO], 1u); break; } } } } while (0)
struct XcdBarrier { unsigned* bar; unsigned x; volatile LAS unsigned* st; };
__device__ __forceinline__ XcdBarrier xcd_barrier_post(unsigned* bar, volatile LAS unsigned* st) {
    XcdBarrier b; b.bar = bar; b.x = xb_xcc_id(); b.st = st;
    if (threadIdx.x == 0) (void)xb_add(&bar[XB_XCNT(b.x)], 1u);
    return b;
}
__device__ __forceinline__ void xcd_barrier_complete(unsigned* bar, unsigned x, unsigned& nloc, unsigned& nx) {
    const unsigned G = gridDim.x * gridDim.y * gridDim.z;
    unsigned sum, cnt, mine, sp = 0u;
    for (;;) {
        sum = 0u; cnt = 0u; mine = 0u;
#pragma unroll
        for (unsigned j = 0; j < 16; ++j) { const unsigned c = xb_ld(&bar[XB_XCNT(j)]); sum += c; cnt += (c > 0u) ? 1u : 0u; mine = (j == x) ? c : mine; }
        if (sum == G) break;
        __builtin_amdgcn_s_sleep(1);
        if ((++sp & 255u) == 0u) { if (xb_ld(&bar[XB_TMO])) break; if (sp > XB_SPIN_CAP) { atomicAdd(&bar[XB_TMO], 1u); break; } }
    }
    nloc = mine > 0u ? mine : 1u; nx = cnt > 0u ? cnt : 1u;
}
__device__ __forceinline__ void xcd_barrier(const XcdBarrier& b) {
    asm volatile("s_waitcnt vmcnt(0)" ::: "memory");
    __syncthreads();
    if (threadIdx.x == 0) {
        unsigned* bar = b.bar;
        __builtin_amdgcn_s_waitcnt(0);
        unsigned nloc = b.st[0], nx = b.st[1];
        if (nloc == 0u) { xcd_barrier_complete(bar, b.x, nloc, nx); b.st[0] = nloc; b.st[1] = nx; }
        const unsigned old = xb_add(&bar[XB_XSUB(b.x)], 1u);
        const unsigned gen = old / nloc;
        if (old + 1u == (gen + 1u) * nloc) {
            __builtin_amdgcn_fence(__ATOMIC_RELEASE, "agent");
            asm volatile("s_waitcnt vmcnt(0)" ::: "memory");
            const unsigned og = xb_add(&bar[XB_TOP], 1u);
            const unsigned tg = og / nx;
            if (og + 1u == (tg + 1u) * nx) xb_add(&bar[XB_TOPGEN], 1u);
            else XB_SPIN(xb_ld(&bar[XB_TOPGEN]) == tg, bar);
            __builtin_amdgcn_fence(__ATOMIC_ACQUIRE, "agent");
            xb_add(&bar[XB_XGEN(b.x)], 1u);
            asm volatile("s_waitcnt vmcnt(0)" ::: "memory");
        } else {
            XB_SPIN(xb_ld(&bar[XB_XGEN(b.x)]) == gen, bar);
            __builtin_amdgcn_fence(__ATOMIC_ACQUIRE, "agent");
            asm volatile("s_waitcnt vmcnt(0)" ::: "memory");
        }
    }
    __syncthreads();
}

constexpr int RING_OFF = 0, RING_BYTES = 131072;
constexpr int LDSCTL_OFF = RING_BYTES, MISC_OFF = LDSCTL_OFF + 320;
constexpr int LDS_BYTES = 147456;
constexpr int NWAVES = 8;

struct Args {
    const float* in[18]; float* out; unsigned char* ws; int ph_lo, ph_hi, li, pad;
};

__device__ __forceinline__ float wave_sum(float v) {
#pragma unroll
    for (int o = 1; o < 64; o <<= 1) v += __shfl_xor(v, o);
    return v;
}
__device__ __forceinline__ void p0_transpose_item(const float* W, int K, int N, bf16_t* WT, LAS float* scr, int item, int lane, const float* ks1, const float* ks2, int ksplit) {
    const int nblk = N / 32, kb = item / nblk, nb = item % nblk, k0 = 64 * kb, n0 = 32 * nb;
#pragma unroll 8
    for (int i = 0; i < 32; ++i) { const int kk = 2 * i + (lane >> 5), k = k0 + kk; float s = 1.f; if (ks1) s = (k < ksplit) ? ks1[k] : ks2[k - ksplit];
        scr[kk * 33 + (lane & 31)] = W[(size_t)k * N + n0 + (lane & 31)] * s; }
    asm volatile("s_waitcnt lgkmcnt(0)" ::: "memory");
    const int c = lane & 7;
#pragma unroll
    for (int j = 0; j < 4; ++j) { const int n = (lane >> 3) + 8 * j; const LAS float* s = scr + (8 * c) * 33 + n;
        u32x4 o; o.x = cvt_pk_bf16(s[0 * 33], s[1 * 33]); o.y = cvt_pk_bf16(s[2 * 33], s[3 * 33]); o.z = cvt_pk_bf16(s[4 * 33], s[5 * 33]); o.w = cvt_pk_bf16(s[6 * 33], s[7 * 33]);
        *(GAS u32x4*)(WT + (size_t)(n0 + n) * K + k0 + 8 * c) = o; }
    asm volatile("s_waitcnt lgkmcnt(0)" ::: "memory");
}
__device__ __forceinline__ void ssm_disc(const float* lre, const float* lim, const float* lstep, int d, int g, int p, f32x2& lb, f32x2& bs) {
    const float lr = lre[(d * NG + g) * NPST + p], li = lim[(d * NG + g) * NPST + p], dt = expf(lstep[d * NG + g]);
    const float mag = expf(lr * dt), ang = li * dt; lb.x = mag * cosf(ang); lb.y = mag * sinf(ang);
    const float nr = lb.x - 1.0f, ni = lb.y, den = 1.0f / (lr * lr + li * li);
    bs.x = (nr * lr + ni * li) * den; bs.y = (ni * lr - nr * li) * den;
}
__device__ __forceinline__ f32x2 ssm_pow(const float* lre, const float* lim, const float* lstep, int d, int g, int p, int e) {
    const float lr = lre[(d * NG + g) * NPST + p], li = lim[(d * NG + g) * NPST + p], dt = expf(lstep[d * NG + g]);
    const float mag = expf(lr * dt * (float)e), ang = li * dt * (float)e; f32x2 r; r.x = mag * cosf(ang); r.y = mag * sinf(ang); return r;
}
__device__ __forceinline__ f32x2 cmul(f32x2 a, f32x2 b) { f32x2 r; r.x = a.x * b.x - a.y * b.y; r.y = a.x * b.y + a.y * b.x; return r; }

__global__ void __launch_bounds__(NWAVES * 64, 2) enc_fwd(Args args) {
    extern __shared__ __attribute__((aligned(16))) unsigned char lds[];
    LAS unsigned char* const L = (LAS unsigned char*)lds;
    volatile LAS unsigned* const MISC = (volatile LAS unsigned*)(L + MISC_OFF);
    const int tid = threadIdx.x, lane = tid & 63, wave = __builtin_amdgcn_readfirstlane(tid >> 6);
    const int G = gridDim.x; const int bx = blockIdx.x; const int vcu = (G % 8 == 0) ? (bx % 8) * (G / 8) + bx / 8 : bx;
    unsigned char* const ws = args.ws; unsigned char* const ou = (unsigned char*)args.out;
    gu32* const ctl = (gu32*)(ws + WS_CTL);
    const float* x_p = args.in[0]; const float* x_s = args.in[1]; const float* norm_w = args.in[2]; const float* w_in = args.in[3];
    const float* q_norm_w = args.in[4]; const float* k_norm_w = args.in[5]; const float* lam_re = args.in[6]; const float* lam_im = args.in[7]; const float* log_step = args.in[8];
    const float* b_re = args.in[9]; const float* b_im = args.in[10]; const float* c_re = args.in[11]; const float* c_im = args.in[12]; const float* d_skip = args.in[13];
    const float* w_glu = args.in[14]; const float* aonw = args.in[15]; const float* sonw = args.in[16]; const float* w_out = args.in[17];
    float* const RS = (float*)(ws + WS_RS); float* const RATIO = (float*)(ws + WS_RATIO); float* const RSN = (float*)(ws + WS_RSN);
    float* const SSQA = (float*)(ws + WS_SSQA); float* const SSQS = (float*)(ws + WS_SSQS); f32x2* const TAB = (f32x2*)(ws + WS_TAB);
    bf16_t* const WINT = (bf16_t*)(ws + WS_WINT); bf16_t* const WGLUT = (bf16_t*)(ws + WS_WGLUT); bf16_t* const WOUTT = (bf16_t*)(ws + WS_WOUTT);
    bf16_t* const QB = (bf16_t*)(ws + WS_Q); bf16_t* const KVB = (bf16_t*)(ws + WS_KV); bf16_t* const GA = (bf16_t*)(ws + WS_GA); bf16_t* const GS = (bf16_t*)(ws + WS_GS);
    bf16_t* const MG = (bf16_t*)(ws + WS_MG); bf16_t* const YB = (bf16_t*)(ws + WS_Y); float* const LR = (float*)(ws + WS_LR);
    bf16_t* const XB = (bf16_t*)(ou + OU_XB); bf16_t* const BTM = (bf16_t*)(ou + OU_BTM); bf16_t* const AG = (bf16_t*)(ou + OU_AG);
    bf16_t* const WLR = (bf16_t*)(ou + OU_WLR); float* const K0T = (float*)(ou + OU_K0);

    for (int u = tid; u < (LDS_BYTES - LDSCTL_OFF) / 4; u += NWAVES * 64) ((LAS unsigned*)(L + LDSCTL_OFF))[u] = 0u;
    __syncthreads();
    XcdBarrier bar; bar.bar = (unsigned*)(ctl + CW_BAR) + args.li * XCD_BAR_WORDS; bar.x = 0; bar.st = nullptr;
    if (N_LAUNCHES != NPH) bar = xcd_barrier_post((unsigned*)(ctl + CW_BAR) + args.li * XCD_BAR_WORDS, MISC + 8);
#define GRID_BAR() do { if (N_LAUNCHES == NPH) { if (tid == 0) __hip_atomic_store(ctl + CW_TMO, 0xBADBA0u, __ATOMIC_RELAXED, __HIP_MEMORY_SCOPE_AGENT); } else { xcd_barrier(bar); } } while (0)
    const int lo = args.ph_lo, hi = args.ph_hi;
#ifndef PH_ONLY
#define PH_ONLY -1
#endif
#define IN(k) ((PH_ONLY < 0 || PH_ONLY == (k)) && lo <= (k) && (k) < hi)
#define BOTH(k) (IN(k) && IN((k) + 1))
    const int gw = vcu * NWAVES + wave, NGW = G * NWAVES;
    LAS float* const scr = (LAS float*)(L + RING_OFF + wave * 16384);

    if (IN(0)) {
        {
            constexpr int I_IN = (DM / 64) * (INC / 32), I_GLU = (1024 / 64) * (1024 / 32), I_OUT = (2048 / 64) * (2048 / 32);
            for (int it = gw; it < I_IN + I_GLU + I_OUT; it += NGW) {
                int r = it;
                if (r < I_IN) { p0_transpose_item(w_in, DM, INC, WINT, scr, r, lane, norm_w, norm_w, DM); continue; } r -= I_IN;
                if (r < I_GLU) { p0_transpose_item(w_glu, 1024, 1024, WGLUT, scr, r, lane, nullptr, nullptr, 0); continue; } r -= I_GLU;
                p0_transpose_item(w_out, 2048, 2048, WOUTT, scr, r, lane, aonw, sonw, 1024);
            }
        }
        for (int i = gw * 64 + lane; i < 128 * 32; i += NGW * 64) { const int pos = i >> 5, f = i & 31;
            const float inv = 1.0f / powf(10000.0f, (float)f * (1.0f / 32.0f)); const float ang = (float)pos * inv; f32x2 cs; cs.x = cosf(ang); cs.y = sinf(ang); TAB[i] = cs; }
        for (int it = gw; it < NG * 2 * 16; it += NGW) {
            const int g = __builtin_amdgcn_readfirstlane(it >> 5), d = __builtin_amdgcn_readfirstlane((it >> 4) & 1), tb = __builtin_amdgcn_readfirstlane(it & 15);
            const int tl = lane >> 4, co = lane & 15, tau = tb * 4 + tl;
            LAS f32x2* Es = (LAS f32x2*)scr;
            LAS f32x2* Cs = (LAS f32x2*)(scr + 512);
#pragma unroll
            for (int i = 0; i < 4; ++i) { const int p = co + 16 * i; f32x2 lb, bs; ssm_disc(lam_re, lam_im, log_step, d, g, p, lb, bs); const f32x2 pw = ssm_pow(lam_re, lam_im, log_step, d, g, p, tau); Es[tl * 64 + p] = cmul(pw, bs); }
#pragma unroll
            for (int k = 0; k < 16; ++k) { f32x2 c; c.x = c_re[((size_t)(d * NG + g) * NCH + k) * NPST + lane]; c.y = c_im[((size_t)(d * NG + g) * NCH + k) * NPST + lane]; Cs[k * 65 + lane] = c; }
            asm volatile("s_waitcnt lgkmcnt(0)" ::: "memory");
            float acc[16];
#pragma unroll
            for (int ci = 0; ci < 16; ++ci) acc[ci] = 0.f;
            for (int p = 0; p < NPST; ++p) { const f32x2 ce = cmul(Cs[co * 65 + p], Es[tl * 64 + p]);
                const float* br = b_re + ((size_t)g * NPST + p) * NCH; const float* bi = b_im + ((size_t)g * NPST + p) * NCH;
#pragma unroll
                for (int ci = 0; ci < 16; ++ci) acc[ci] += ce.x * br[ci] - ce.y * bi[ci]; }
            float* dst = K0T + (((size_t)(g * 2 + d) * CT + tau) * NCH + co) * NCH;
#pragma unroll
            for (int q = 0; q < 4; ++q) *(f32x4*)(dst + 4 * q) = (f32x4){acc[4 * q], acc[4 * q + 1], acc[4 * q + 2], acc[4 * q + 3]};
            asm volatile("s_waitcnt lgkmcnt(0)" ::: "memory");
        }
        for (int it = gw; it < NG * 2; it += NGW) {
            const int g = it >> 1, d = it & 1, p = lane; f32x2 lb, bs; ssm_disc(lam_re, lam_im, log_step, d, g, p, lb, bs);
            float br[16], bi[16];
#pragma unroll
            for (int ci = 0; ci < 16; ++ci) { br[ci] = b_re[((size_t)g * NPST + p) * NCH + ci]; bi[ci] = b_im[((size_t)g * NPST + p) * NCH + ci]; }
            f32x2 w = bs;
            bf16_t* rre = WLR + ((size_t)g * 256 + d * 128 + p) * 1024; bf16_t* rim = rre + (size_t)64 * 1024;
            for (int e = 0; e < CT; ++e) { const int jp = d == 0 ? (CT - 1 - e) : e; float vr[16], vi[16];
#pragma unroll
                for (int ci = 0; ci < 16; ++ci) { vr[ci] = w.x * br[ci] - w.y * bi[ci]; vi[ci] = w.x * bi[ci] + w.y * br[ci]; }
                u32x4 o0, o1, o2, o3;
                o0.x = cvt_pk_bf16(vr[0], vr[1]); o0.y = cvt_pk_bf16(vr[2], vr[3]); o0.z = cvt_pk_bf16(vr[4], vr[5]); o0.w = cvt_pk_bf16(vr[6], vr[7]);
                o1.x = cvt_pk_bf16(vr[8], vr[9]); o1.y = cvt_pk_bf16(vr[10], vr[11]); o1.z = cvt_pk_bf16(vr[12], vr[13]); o1.w = cvt_pk_bf16(vr[14], vr[15]);
                o2.x = cvt_pk_bf16(vi[0], vi[1]); o2.y = cvt_pk_bf16(vi[2], vi[3]); o2.z = cvt_pk_bf16(vi[4], vi[5]); o2.w = cvt_pk_bf16(vi[6], vi[7]);
                o3.x = cvt_pk_bf16(vi[8], vi[9]); o3.y = cvt_pk_bf16(vi[10], vi[11]); o3.z = cvt_pk_bf16(vi[12], vi[13]); o3.w = cvt_pk_bf16(vi[14], vi[15]);
                *(u32x4*)(rre + jp * 16) = o0; *(u32x4*)(rre + jp * 16 + 8) = o1; *(u32x4*)(rim + jp * 16) = o2; *(u32x4*)(rim + jp * 16 + 8) = o3;
                w = cmul(w, lb); }
        }
        for (int m = gw; m < NTOK; m += NGW) {
            const float* xrow = m < NPROMPT ? x_p + (size_t)m * DM : x_s + (size_t)(m - NPROMPT) * DM;
            const GAS f32x4* xr = (const GAS f32x4*)xrow + lane; f32x4 v[8]; float s = 0.f;
#pragma unroll
            for (int j = 0; j < 8; ++j) { v[j] = xr[64 * j]; s += (v[j].x * v[j].x + v[j].y * v[j].y) + (v[j].z * v[j].z + v[j].w * v[j].w); }
            s = wave_sum(s); if (lane == 0) RS[m] = 1.0f / sqrtf(s * (1.0f / DM) + EPS);
            GAS u32x2* o8 = (GAS u32x2*)(XB + (size_t)m * DM) + lane;
#pragma unroll
            for (int j = 0; j < 8; ++j) { u32x2 w; w.x = cvt_pk_bf16(v[j].x, v[j].y); w.y = cvt_pk_bf16(v[j].z, v[j].w); o8[64 * j] = w; }
        }
        if (BOTH(0)) GRID_BAR();
    }

    if (IN(1)) {
        pg8::Gemm g{XB, WINT, DM, DM, DM, 0, 0}; pg8::StaticOrder S; S.init(NTOK, INC, G, bx);
        pg8::EpiInProj E{RS, QB, KVB, GA, GS, AG};
        pg8::gemm_phase<pg8::EpiInProj, pg8::StaticOrder, true, true>(L + RING_OFF, g, S, E);
        if (BOTH(1)) GRID_BAR();
    }

    if (IN(2)) {
        for (int m = gw; m < NTOK; m += NGW) {
            const int pos = m < NPROMPT ? (m & (SP - 1)) : ((m - NPROMPT) & (SS - 1)); const int prow = pos >> 6, pcol = pos & 63;
            GAS u32x2* kp = (GAS u32x2*)(KVB + (size_t)m * 512) + lane; const u32x2 w = *kp;
            float v0 = bflo(w.x), v1 = bfhi(w.x), v2 = bflo(w.y), v3 = bfhi(w.y);
            float ss = (v0 * v0 + v1 * v1) + (v2 * v2 + v3 * v3);
            ss += __shfl_xor(ss, 1); ss += __shfl_xor(ss, 2); ss += __shfl_xor(ss, 4); ss += __shfl_xor(ss, 8); ss += __shfl_xor(ss, 16);
            const float rn = 1.0f / sqrtf(ss * (1.0f / 128.0f) + EPS);
            const int dl = (lane & 31) * 4;
            const f32x4 kw = *(const f32x4*)(k_norm_w + dl);
            v0 *= rn * kw[0]; v1 *= rn * kw[1]; v2 *= rn * kw[2]; v3 *= rn * kw[3];
            const int ax = dl >> 6, half = (dl >> 5) & 1, fi = dl & 31;
            const f32x2* tp = TAB + (ax == 0 ? prow : pcol) * 32 + fi;
            const f32x2 c0 = tp[0], c1 = tp[1], c2 = tp[2], c3 = tp[3];
            const float p0 = __shfl_xor(v0, 8), p1 = __shfl_xor(v1, 8), p2 = __shfl_xor(v2, 8), p3 = __shfl_xor(v3, 8);
            float o0, o1, o2, o3;
            if (half == 0) { o0 = v0 * c0.x - p0 * c0.y; o1 = v1 * c1.x - p1 * c1.y; o2 = v2 * c2.x - p2 * c2.y; o3 = v3 * c3.x - p3 * c3.y; }
            else           { o0 = v0 * c0.x + p0 * c0.y; o1 = v1 * c1.x + p1 * c1.y; o2 = v2 * c2.x + p2 * c2.y; o3 = v3 * c3.x + p3 * c3.y; }
            u32x2 ow; ow.x = cvt_pk_bf16(o0, o1); ow.y = cvt_pk_bf16(o2, o3); *kp = ow;
        }
        for (long pc = (long)gw * 64 + lane; pc < (long)NG * 1024 * 128; pc += (long)NGW * 64) {
            const int kp8 = (int)(pc & 127), n = (int)((pc >> 7) & 1023), g = (int)(pc >> 17);
            const int j = n >> 4, co = n & 15, jp = kp8 >> 1, ci0 = (kp8 & 1) * 8;
            const int dsel = j >= jp ? 0 : 1, tau = j >= jp ? j - jp : jp - j;
            const float* src = K0T + (((size_t)(g * 2 + dsel) * CT + tau) * NCH + co) * NCH + ci0;
            f32x4 a = *(const f32x4*)src, b = *(const f32x4*)(src + 4);
            if (j == jp) { const float* s2 = K0T + (((size_t)(g * 2 + 1) * CT) * NCH + co) * NCH + ci0; a += *(const f32x4*)s2; b += *(const f32x4*)(s2 + 4); }
            *(u32x4*)(BTM + ((size_t)g * 1024 + n) * KA + kp8 * 8) = pg8::pack8(a, b);
        }
        for (int it = gw; it < NG * 2 * NCH; it += NGW) {
            const int g = it >> 5, d = (it >> 4) & 1, co = it & 15, p = lane; f32x2 lb, bs; ssm_disc(lam_re, lam_im, log_step, d, g, p, lb, bs);
            f32x2 c; c.x = c_re[((size_t)(d * NG + g) * NCH + co) * NPST + p]; c.y = c_im[((size_t)(d * NG + g) * NCH + co) * NPST + p];
            f32x2 w = cmul(c, lb);
            for (int e = 1; e <= CT; ++e) { const int j = d == 0 ? e - 1 : CT - e;
                bf16_t* dst = BTM + ((size_t)g * 1024 + j * 16 + co) * KA + 1024 + d * 128 + p;
                dst[0] = (bf16_t)(cvt_pk_bf16(w.x, w.x) & 0xffffu); dst[64] = (bf16_t)(cvt_pk_bf16(-w.y, -w.y) & 0xffffu);
                w = cmul(w, lb); }
        }
        __syncthreads();
        {
            pg8::Gemm g{AG, WLR, KA, 1024, 1024, (size_t)NCHUNK * KA, (size_t)256 * 1024}; pg8::BatchOrder S; S.init(NG, 4, 1, G, vcu);
            pg8::EpiLR E{LR};
            pg8::gemm_phase<pg8::EpiLR, pg8::BatchOrder, true, true>(L + RING_OFF, g, S, E);
        }
        if (BOTH(2)) GRID_BAR();
    }

    if (IN(3)) {
        for (int it = gw; it < 20 * NG * 2; it += NGW) {
            int s, rest; if (it < 4 * NG * 2) { s = 16 + it / (NG * 2); rest = it % (NG * 2); } else { const int t2 = it - 4 * NG * 2; s = t2 / (NG * 2); rest = t2 % (NG * 2); }
            const int g = rest >> 1, d = rest & 1, p = lane;
            const int c0 = s < 16 ? 32 * s : 512 + 128 * (s - 16), nc = s < 16 ? 32 : 128;
            const f32x2 lT = ssm_pow(lam_re, lam_im, log_step, d, g, p, CT);
            const float* lr = LR + ((size_t)g * NCHUNK) * 256 + d * 128 + p; bf16_t* ag = AG + ((size_t)g * NCHUNK) * KA + 1024 + d * 128 + p;
            f32x2 h; h.x = 0.f; h.y = 0.f;
            for (int cb = 0; cb < nc; cb += 8) {
                float xr[8], xi[8];
#pragma unroll
                for (int q = 0; q < 8; ++q) { const int ch = d == 0 ? c0 + cb + q : c0 + nc - 1 - (cb + q); xr[q] = lr[(size_t)ch * 256]; xi[q] = lr[(size_t)ch * 256 + 64]; }
#pragma unroll
                for (int q = 0; q < 8; ++q) { const int ch = d == 0 ? c0 + cb + q : c0 + nc - 1 - (cb + q);
                    ag[(size_t)ch * KA] = (bf16_t)(cvt_pk_bf16(h.x, h.x) & 0xffffu); ag[(size_t)ch * KA + 64] = (bf16_t)(cvt_pk_bf16(h.y, h.y) & 0xffffu);
                    h = cmul(h, lT); h.x += xr[q]; h.y += xi[q]; }
            }
        }
        __syncthreads();
        for (int i = 0; i < 2048; ++i) {
            int seq_row0, seqlen, kvh, hq, qb;
            if (G == 256) {
                if (i >= 8) break;
                const int xcd = vcu >> 5, loc = vcu & 31;
                if (i < 4) { const int s = xcd >> 1; kvh = xcd & 1; const int idx = loc * 4 + i; hq = idx >> 5; qb = idx & 31; seq_row0 = NPROMPT + s * SS; seqlen = SS; }
                else { const int combo = xcd * 4 + (i - 4); const int s = combo >> 1; kvh = combo & 1; hq = loc >> 3; qb = loc & 7; seq_row0 = s * SP; seqlen = SP; }
            } else {
                const int u = i * G + bx; if (u >= 2048) break;
                if (u < 1024) { const int combo = u >> 7, idx = u & 127; const int s = combo >> 1; kvh = combo & 1; hq = idx >> 5; qb = idx & 31; seq_row0 = NPROMPT + s * SS; seqlen = SS; }
                else { const int u2 = u - 1024; const int combo = u2 >> 5, idx = u2 & 31; const int s = combo >> 1; kvh = combo & 1; hq = idx >> 3; qb = idx & 7; seq_row0 = s * SP; seqlen = SP; }
            }
            const int h = kvh * 4 + hq; const long r0 = (long)seq_row0 + qb * 256;
            attn::attn_dense_body(QB + r0 * 1024 + h * 128, (const attn::bf16*)(KVB + (long)seq_row0 * 512 + kvh * 128), (const attn::bf16*)(KVB + (long)seq_row0 * 512 + 256 + kvh * 128),
                                  GA + r0 * 1024 + h * 128, MG + r0 * 2048 + h * 128, SSQA + r0 * 8 + h, q_norm_w, TAB, qb * 256, seqlen, (char*)lds + RING_OFF);
        }
        if (BOTH(3)) GRID_BAR();
    }

    if (IN(4)) {
        pg8::Gemm g{AG, BTM, KA, KA, KA, (size_t)NCHUNK * KA, (size_t)1024 * KA}; pg8::BatchOrder S; S.init(NG, 4, 4, G, vcu);
        pg8::EpiSsm E{AG, d_skip, YB};
        pg8::gemm_phase<pg8::EpiSsm, pg8::BatchOrder, true, true>(L + RING_OFF, g, S, E);
        if (BOTH(4)) GRID_BAR();
    }

    if (IN(5)) {
        pg8::Gemm g{YB, WGLUT, 1024, 1024, 1024, 0, 0}; pg8::StaticOrder S; S.init(NTOK, 1024, G, bx);
        pg8::EpiGlu E{YB, GS, MG, SSQS};
        pg8::gemm_phase<pg8::EpiGlu, pg8::StaticOrder, true, true>(L + RING_OFF, g, S, E);
        if (BOTH(5)) GRID_BAR();
    }

    if (IN(6)) {
        for (int r = (vcu * NWAVES * 64) + tid; r < NTOK; r += G * NWAVES * 64) {
            const f32x4 a0 = *(const f32x4*)(SSQA + (size_t)r * 8), a1 = *(const f32x4*)(SSQA + (size_t)r * 8 + 4);
            const float sa = ((a0[0] + a0[1]) + (a0[2] + a0[3])) + ((a1[0] + a1[1]) + (a1[2] + a1[3]));
            float sb = 0.f;
#pragma unroll
            for (int q = 0; q < 4; ++q) { const f32x4 b = *(const f32x4*)(SSQS + (size_t)r * 16 + 4 * q); sb += (b[0] + b[1]) + (b[2] + b[3]); }
            const float ra = 1.0f / sqrtf(sa * (1.0f / 1024.0f) + EPS), rsv = 1.0f / sqrtf(sb * (1.0f / 1024.0f) + EPS);
            RATIO[r] = ra / rsv; RSN[r] = rsv;
        }
        if (BOTH(6)) GRID_BAR();
    }

    if (IN(7)) {
        pg8::Gemm g{MG, WOUTT, 2048, 2048, 2048, 0, 0}; pg8::StaticOrder S; S.init(NTOK, DM, G, bx);
        pg8::EpiOut E{x_p, x_s, args.out, RATIO, RSN};
        pg8::gemm_phase<pg8::EpiOut, pg8::StaticOrder, true, true>(L + RING_OFF, g, S, E);
    }
#undef IN
#undef BOTH
#undef GRID_BAR
}

extern "C" void kernel_launch(void* const* d_in, const int* in_sizes, int n_in, void* d_out, int out_size, void* d_ws, size_t ws_size, hipStream_t stream) {
    static int grid = 0;
    if (grid == 0) {
        if (n_in != 18 || out_size != NTOK * DM || ws_size < WS_NEED) { fprintf(stderr, "kernel_launch: unexpected shapes (n_in %d out %d ws %zu)\n", n_in, out_size, ws_size); grid = -1; return; }
        int dev = 0, cus = 0, per_cu = 0;
        if (hipGetDevice(&dev) != hipSuccess || hipDeviceGetAttribute(&cus, hipDeviceAttributeMultiprocessorCount, dev) != hipSuccess) { grid = -1; return; }
        if (hipFuncSetAttribute((const void*)enc_fwd, hipFuncAttributeMaxDynamicSharedMemorySize, LDS_BYTES) != hipSuccess) { fprintf(stderr, "kernel_launch: hipFuncSetAttribute failed\n"); grid = -1; return; }
        if (hipOccupancyMaxActiveBlocksPerMultiprocessor(&per_cu, (const void*)enc_fwd, NWAVES * 64, LDS_BYTES) != hipSuccess || per_cu < 1) { fprintf(stderr, "kernel_launch: occupancy query says %d\n", per_cu); }
        (void)hipGetLastError();
        grid = cus;
    }
    if (grid < 0) return;
    (void)hipMemsetAsync((char*)d_ws + WS_CTL, 0, CTL_ZERO_BYTES, stream);
    Args a{};
    for (int i = 0; i < 18; ++i) a.in[i] = (const float*)d_in[i];
    a.out = (float*)d_out; a.ws = (unsigned char*)d_ws;
    for (int li = 0; li < N_LAUNCHES; ++li) {
        a.ph_lo = (N_LAUNCHES == NPH) ? li : 0; a.ph_hi = (N_LAUNCHES == NPH) ? li + 1 : NPH; a.li = (N_LAUNCHES == NPH) ? 0 : li;
        hipLaunchKernelGGL(enc_fwd, dim3(grid), dim3(NWAVES * 64), LDS_BYTES, stream, a);
    }
}
```

```cpp
#include <hip/hip_runtime.h>
#include <hip/hip_bf16.h>
#include <cstdio>
#include <cstdint>
#include <cmath>

#ifndef MK_N_LAUNCHES
#define MK_N_LAUNCHES 1
#endif
constexpr int NPH = 8;
constexpr int N_LAUNCHES = MK_N_LAUNCHES;

constexpr int DM = 2048, NTOK = 65536, NPROMPT = 32768, SP = 2048, SS = 8192;
constexpr int INC = 4608;
constexpr int NG = 64, NPST = 64, NCH = 16, CT = 64, NCHUNK = NTOK / CT;
constexpr int KA = CT * NCH + 4 * NPST;
constexpr float EPS = 1e-6f;

#define GAS __attribute__((address_space(1)))
#define LAS __attribute__((address_space(3)))
typedef unsigned short bf16_t;
typedef short bf16x8 __attribute__((ext_vector_type(8)));
typedef float f32x4 __attribute__((ext_vector_type(4)));
typedef float f32x2 __attribute__((ext_vector_type(2)));
typedef unsigned u32x4 __attribute__((ext_vector_type(4)));
typedef unsigned u32x2 __attribute__((ext_vector_type(2)));
typedef GAS unsigned gu32;

__device__ __forceinline__ unsigned cvt_pk_bf16(float lo, float hi) { unsigned r; asm volatile("v_cvt_pk_bf16_f32 %0, %1, %2" : "=v"(r) : "v"(lo), "v"(hi)); return r; }
__device__ __forceinline__ float bf2f(unsigned short b) { return __uint_as_float(((unsigned)b) << 16); }
__device__ __forceinline__ float bflo(unsigned w) { return __uint_as_float(w << 16); }
__device__ __forceinline__ float bfhi(unsigned w) { return __uint_as_float(w & 0xffff0000u); }
__device__ __forceinline__ float fast_sigmoid(float x) { return __builtin_amdgcn_rcpf(1.0f + __builtin_amdgcn_exp2f(-1.4426950408889634f * x)); }
__device__ __forceinline__ float silu_f(float x) { return x * fast_sigmoid(x); }
__device__ __forceinline__ float gelu_tanh(float x) { const float z = 0.7978845608028654f * (x + 0.044715f * x * x * x); return x * fast_sigmoid(2.0f * z); }

namespace pg8 {
#define PG8_LAS __attribute__((address_space(3)))
constexpr int BM = 256, BK = 64, HALF = 128, HTB = HALF * BK * 2, STAGE_BYTES = 8 * HTB, NXCD = 8, WGM = 8;
__host__ __device__ __forceinline__ int lds_byte(int r, int c) { const int st = (r >> 4) * 2 + (c >> 5), rr = r & 15, cc = c & 31, ob = rr * 64 + cc * 2; return st * 1024 + (ob ^ (((ob >> 9) & 1) << 5)); }
__host__ __device__ __forceinline__ void stage_rc(int b, int& R, int& C) { const int st = b / 1024, sb = b % 1024, swz = sb ^ (((sb >> 9) & 1) << 5); R = (st >> 1) * 16 + swz / 64; C = (st & 1) * 32 + (swz % 64) / 2; }
__host__ __device__ __forceinline__ int perm32(int rho) { const int n = rho >> 4, i = rho & 15; return 8 * (i >> 2) + 4 * n + (i & 3); }

struct Unit { int pm, pn, g; };
struct Gemm { const bf16_t* A; const bf16_t* Bt; int lda, ldb, K; size_t gsA, gsB; };

struct StaticOrder {
    int nM, nN, nwg, G, c;
    __host__ __device__ void init(int M, int N, int G_, int c_) { nM = M / BM; nN = N / BM; nwg = nM * nN; G = G_; c = c_; }
    __host__ __device__ bool next(int i, Unit& u) const {
        const long L = (long)i * G + c; if (L >= nwg) return false;
        int wgid = (int)L; { const int q = nwg / NXCD, r = nwg % NXCD, xcd = wgid % NXCD, off = wgid / NXCD; wgid = (xcd < r ? xcd * (q + 1) : r * (q + 1) + (xcd - r) * q) + off; }
        const int nig = WGM * nN, gid = wgid / nig, fm = gid * WGM, gsz = (nM - fm) < WGM ? (nM - fm) : WGM;
        u.pm = fm + ((wgid % nig) % gsz); u.pn = (wgid % nig) / gsz; u.g = 0; return true;
    }
};
struct BatchOrder {
    int nPm, nPn, ntot, G, vcu;
    __host__ __device__ void init(int nb, int nPm_, int nPn_, int G_, int vcu_) { nPm = nPm_; nPn = nPn_; ntot = nb * nPm_ * nPn_; G = G_; vcu = vcu_; }
    __host__ __device__ bool next(int i, Unit& u) const {
        const long L = (long)i * G + vcu; if (L >= ntot) return false;
        const int per = nPm * nPn, l = (int)L; u.g = l / per; const int t = l % per; u.pm = t / nPn; u.pn = t % nPn; return true;
    }
};

template <class Epi, class Sched, bool ALIGN_EPI = false, bool SP2 = true>
__device__ __forceinline__ void gemm_phase(PG8_LAS unsigned char* lds, const Gemm g, const Sched& S, const Epi& E) {
    const int tid = threadIdx.x, wid = __builtin_amdgcn_readfirstlane(tid >> 6), lane = tid & 63, wr = wid >> 2, wc = wid & 3, fr = lane & 15, fq = lane >> 4;
    const int K = g.K, nt = K / BK;
    unsigned voffA[2], voffB[2];
#pragma unroll
    for (int i = 0; i < 2; ++i) { int R, C; stage_rc(tid * 16 + i * 8192, R, C); const int Rb = Epi::PERM ? ((R & ~31) + perm32(R & 31)) : R;
        voffA[i] = (unsigned)(R * g.lda + C) * 2u; voffB[i] = (unsigned)(Rb * g.ldb + C) * 2u; }
    const size_t kstep = (size_t)(BK * 2);
    const size_t hstepA = (size_t)HALF * g.lda * 2, hstepB = (size_t)HALF * g.ldb * 2;
    const size_t tstepA = 2 * hstepA, tstepB = 2 * hstepB;
    const unsigned ldsw = (unsigned)wid * 1024u;
    const int aoff = lds_byte(wr * 64 + fr, fq * 8), boff = lds_byte(wc * 32 + fr, fq * 8);
#define PG8_SA(b, h) (((b) * 2 + (h)) * HTB)
#define PG8_SB(b, h) ((4 + (b) * 2 + (h)) * HTB)
#define PG8_STAGE(bufoff, gbase, voff) do { _Pragma("unroll") for (int _i = 0; _i < 2; ++_i) \
        __builtin_amdgcn_global_load_lds((const unsigned*)((const char*)(gbase) + (voff)[_i]), (PG8_LAS unsigned*)(lds + (bufoff) + ldsw + _i * 8192), 16, 0, 0); } while (0)
#define PG8_LDA(dst, b, h) do { _Pragma("unroll") for (int m = 0; m < 4; ++m) _Pragma("unroll") for (int k = 0; k < 2; ++k) dst[m][k] = *(const PG8_LAS bf16x8*)(lds + PG8_SA(b, h) + aoff + m * 2048 + k * 1024); } while (0)
#define PG8_LDB(dst, b, h) do { _Pragma("unroll") for (int n = 0; n < 2; ++n) _Pragma("unroll") for (int k = 0; k < 2; ++k) dst[n][k] = *(const PG8_LAS bf16x8*)(lds + PG8_SB(b, h) + boff + n * 2048 + k * 1024); } while (0)
#define PG8_MMA(ai, bj, At, Bt) do { __builtin_amdgcn_s_setprio(1); _Pragma("unroll") for (int m = 0; m < 4; ++m) _Pragma("unroll") for (int n = 0; n < 2; ++n) _Pragma("unroll") for (int k = 0; k < 2; ++k) \
        acc[ai][bj][m][n] = __builtin_amdgcn_mfma_f32_16x16x32_bf16(Bt[n][k], At[m][k], acc[ai][bj][m][n], 0, 0, 0); __builtin_amdgcn_s_setprio(0); } while (0)
#define PG8_WAIT_V(n) asm volatile("s_waitcnt vmcnt(" #n ")" ::: "memory")
#define PG8_WAIT_L(n) asm volatile("s_waitcnt lgkmcnt(" #n ")" ::: "memory")
#define PG8_BAR __builtin_amdgcn_s_barrier()
#define PG8_SCHED __builtin_amdgcn_sched_barrier(0)
    Unit cur, nxt; int ui = 0;
    if (!S.next(0, cur)) return;
    f32x4 acc[2][2][4][2];
#pragma unroll
    for (int a = 0; a < 2; ++a)
#pragma unroll
        for (int b = 0; b < 2; ++b)
#pragma unroll
            for (int m = 0; m < 4; ++m)
#pragma unroll
                for (int n = 0; n < 2; ++n) acc[a][b][m][n] = (f32x4){0.f, 0.f, 0.f, 0.f};
    bf16x8 At[4][2], B0[2][2], B1[2][2];
    const char* cA = (const char*)(g.A + (size_t)cur.g * g.gsA) + (size_t)cur.pm * tstepA; const char* cB = (const char*)(g.Bt + (size_t)cur.g * g.gsB) + (size_t)cur.pn * tstepB;
    static_assert(SP2, "only the SP2 loop is kept in this file");
    PG8_STAGE(PG8_SB(0, 0), cB, voffB); PG8_STAGE(PG8_SB(0, 1), cB + hstepB, voffB); PG8_STAGE(PG8_SA(0, 0), cA, voffA); PG8_STAGE(PG8_SA(0, 1), cA + hstepA, voffA);
    if (wr == 1) PG8_BAR;
    PG8_WAIT_V(2); PG8_BAR;
    PG8_STAGE(PG8_SB(1, 0), cB + kstep, voffB); PG8_STAGE(PG8_SA(1, 0), cA + kstep, voffA); PG8_STAGE(PG8_SB(1, 1), cB + hstepB + kstep, voffB);
    PG8_WAIT_V(6); PG8_BAR;
    for (;;) {
        const bool has_next = S.next(ui + 1, nxt);
        const char* nA = has_next ? (const char*)(g.A + (size_t)nxt.g * g.gsA) + (size_t)nxt.pm * tstepA : cA;
        const char* nB = has_next ? (const char*)(g.Bt + (size_t)nxt.g * g.gsB) + (size_t)nxt.pn * tstepB : cB;
        for (int t = 0; t < nt; t += 2) {
            const bool last = (t == nt - 2);
            const char* a1 = cA + (size_t)(t + 1) * kstep;
            const char* a2 = last ? nA : cA + (size_t)(t + 2) * kstep; const char* b2 = last ? nB : cB + (size_t)(t + 2) * kstep;
            const char* a3 = a2 + kstep; const char* b3 = b2 + kstep;
            if constexpr (Epi::MIDK) { if (t == (nt >> 1)) E.midk(acc, cur, wr, wc, fr, fq); }
            PG8_LDB(B0, 0, 0); PG8_LDB(B1, 0, 1); PG8_SCHED; PG8_LDA(At, 0, 0); PG8_STAGE(PG8_SA(1, 1), a1 + hstepA, voffA);
            PG8_WAIT_V(8); PG8_WAIT_L(0); PG8_BAR; PG8_MMA(0, 0, At, B0); PG8_MMA(0, 1, At, B1); PG8_BAR; PG8_SCHED;
            PG8_LDA(At, 0, 1); PG8_STAGE(PG8_SB(0, 0), b2, voffB); PG8_STAGE(PG8_SB(0, 1), b2 + hstepB, voffB); PG8_STAGE(PG8_SA(0, 0), a2, voffA);
            PG8_WAIT_V(8); PG8_WAIT_L(0); PG8_BAR; PG8_MMA(1, 0, At, B0); PG8_MMA(1, 1, At, B1); PG8_BAR; PG8_SCHED;
            PG8_LDB(B0, 1, 0); PG8_LDB(B1, 1, 1); PG8_SCHED; PG8_LDA(At, 1, 0); PG8_STAGE(PG8_SA(0, 1), a2 + hstepA, voffA);
            PG8_WAIT_V(8); PG8_WAIT_L(0); PG8_BAR; PG8_MMA(0, 0, At, B0); PG8_MMA(0, 1, At, B1); PG8_BAR; PG8_SCHED;
            PG8_LDA(At, 1, 1); PG8_STAGE(PG8_SB(1, 0), b3, voffB); PG8_STAGE(PG8_SB(1, 1), b3 + hstepB, voffB); PG8_STAGE(PG8_SA(1, 0), a3, voffA);
            PG8_WAIT_V(8); PG8_WAIT_L(0); PG8_BAR; PG8_MMA(1, 0, At, B0); PG8_MMA(1, 1, At, B1); PG8_BAR; PG8_SCHED;
        }
        if constexpr (ALIGN_EPI) { if (wr == 0) PG8_BAR; }
        E(acc, cur, wr, wc, fr, fq);
        if (!has_next) break;
#pragma unroll
        for (int a = 0; a < 2; ++a)
#pragma unroll
            for (int b = 0; b < 2; ++b)
#pragma unroll
                for (int m = 0; m < 4; ++m)
#pragma unroll
                    for (int n = 0; n < 2; ++n) acc[a][b][m][n] = (f32x4){0.f, 0.f, 0.f, 0.f};
        cur = nxt; cA = nA; cB = nB; ++ui;
        if constexpr (ALIGN_EPI) { if (wr == 1) PG8_BAR; }
    }
    PG8_WAIT_V(0);
    if constexpr (!ALIGN_EPI) { if (wr == 0) PG8_BAR; }
    PG8_BAR;
#undef PG8_SA
#undef PG8_SB
#undef PG8_STAGE
#undef PG8_LDA
#undef PG8_LDB
#undef PG8_MMA
#undef PG8_WAIT_V
#undef PG8_WAIT_L
#undef PG8_BAR
#undef PG8_SCHED
}

__device__ __forceinline__ u32x4 pack8(const f32x4 v0, const f32x4 v1) { u32x4 w; w.x = cvt_pk_bf16(v0[0], v0[1]); w.y = cvt_pk_bf16(v0[2], v0[3]); w.z = cvt_pk_bf16(v1[0], v1[1]); w.w = cvt_pk_bf16(v1[2], v1[3]); return w; }

struct EpiInProj {
    static constexpr bool PERM = true, MIDK = false;
    const float* rs; bf16_t *Q, *KV, *GA, *GS, *AG;
    __device__ __forceinline__ void operator()(const f32x4 (&acc)[2][2][4][2], const Unit& u, int wr, int wc, int fr, int fq) const {
        const int pn = u.pn; const int row0 = u.pm * BM + wr * 64 + fr; const int colt = pn * BM + wc * 32 + 8 * fq;
        int kind = 0, ld = 1024, cb = colt; bf16_t* base = Q;
        if (pn >= 4 && pn < 6) { base = KV; ld = 512; cb = colt - 1024; }
        else if (pn >= 6 && pn < 10) { base = GA; cb = colt - 1536; kind = 1; }
        else if (pn >= 10 && pn < 14) { base = AG; cb = colt - 2560; kind = 2; }
        else if (pn >= 14) { base = GS; cb = colt - 3584; kind = 1; }
#pragma unroll
        for (int ai = 0; ai < 2; ++ai)
#pragma unroll
            for (int m = 0; m < 4; ++m) { const int r = row0 + ai * HALF + m * 16; const float s = rs[r];
#pragma unroll
                for (int bj = 0; bj < 2; ++bj) { f32x4 v0 = acc[ai][bj][m][0] * s, v1 = acc[ai][bj][m][1] * s;
                    if (kind == 1) {
#pragma unroll
                        for (int e = 0; e < 4; ++e) { v0[e] = silu_f(v0[e]); v1[e] = silu_f(v1[e]); } }
                    const int c = cb + bj * HALF; size_t off;
                    if (kind == 2) off = ((size_t)((c >> 4) * NCHUNK + (r >> 6))) * KA + (size_t)((r & 63) * 16 + (c & 15));
                    else off = (size_t)r * ld + c;
                    *(u32x4*)(base + off) = pack8(v0, v1); } }
    }
};
struct EpiLR {
    static constexpr bool PERM = false, MIDK = false;
    float* LR;
    __device__ __forceinline__ void operator()(const f32x4 (&acc)[2][2][4][2], const Unit& u, int wr, int wc, int fr, int fq) const {
        const int row0 = u.pm * BM + wr * 64 + fr, col0 = wc * 32 + 4 * fq;
#pragma unroll
        for (int ai = 0; ai < 2; ++ai)
#pragma unroll
            for (int m = 0; m < 4; ++m) { float* rowp = LR + ((size_t)u.g * NCHUNK + row0 + ai * HALF + m * 16) * 256 + col0;
#pragma unroll
                for (int bj = 0; bj < 2; ++bj)
#pragma unroll
                    for (int n = 0; n < 2; ++n) *(f32x4*)(rowp + bj * HALF + n * 16) = acc[ai][bj][m][n]; }
    }
};
struct EpiSsm {
    static constexpr bool PERM = true, MIDK = false;
    const bf16_t* AG; const float* dskip; bf16_t* Y;
    __device__ __forceinline__ void operator()(const f32x4 (&acc)[2][2][4][2], const Unit& u, int wr, int wc, int fr, int fq) const {
        const int ch0 = u.pm * BM + wr * 64 + fr, n00 = u.pn * BM + wc * 32 + 8 * fq; const int g = u.g;
        const int co0 = n00 & 15;
        const f32x4 d0 = *(const f32x4*)(dskip + g * 16 + co0), d1 = *(const f32x4*)(dskip + g * 16 + co0 + 4);
#pragma unroll
        for (int ai = 0; ai < 2; ++ai)
#pragma unroll
            for (int m = 0; m < 4; ++m) { const int ch = ch0 + ai * HALF + m * 16;
#pragma unroll
                for (int bj = 0; bj < 2; ++bj) { const int n0 = n00 + bj * HALF, j = n0 >> 4;
                    const u32x4 uw = *(const u32x4*)(AG + ((size_t)g * NCHUNK + ch) * KA + n0);
                    f32x4 v0 = acc[ai][bj][m][0], v1 = acc[ai][bj][m][1];
                    v0[0] += d0[0] * bflo(uw.x); v0[1] += d0[1] * bfhi(uw.x); v0[2] += d0[2] * bflo(uw.y); v0[3] += d0[3] * bfhi(uw.y);
                    v1[0] += d1[0] * bflo(uw.z); v1[1] += d1[1] * bfhi(uw.z); v1[2] += d1[2] * bflo(uw.w); v1[3] += d1[3] * bfhi(uw.w);
#pragma unroll
                    for (int e = 0; e < 4; ++e) { v0[e] = gelu_tanh(v0[e]); v1[e] = gelu_tanh(v1[e]); }
                    *(u32x4*)(Y + ((size_t)ch * CT + j) * 1024 + g * 16 + co0) = pack8(v0, v1); } }
    }
};
struct EpiGlu {
    static constexpr bool PERM = true, MIDK = false;
    const bf16_t* Y; const bf16_t* GS; bf16_t* MG; float* SSQS;
    __device__ __forceinline__ void operator()(const f32x4 (&acc)[2][2][4][2], const Unit& u, int wr, int wc, int fr, int fq) const {
        const int row0 = u.pm * BM + wr * 64 + fr, c00 = u.pn * BM + wc * 32 + 8 * fq;
#pragma unroll
        for (int ai = 0; ai < 2; ++ai)
#pragma unroll
            for (int m = 0; m < 4; ++m) { const int r = row0 + ai * HALF + m * 16; float ss = 0.f;
#pragma unroll
                for (int bj = 0; bj < 2; ++bj) { const int c = c00 + bj * HALF;
                    const u32x4 yw = *(const u32x4*)(Y + (size_t)r * 1024 + c), gw = *(const u32x4*)(GS + (size_t)r * 1024 + c);
                    const f32x4 a0 = acc[ai][bj][m][0], a1 = acc[ai][bj][m][1]; f32x4 v0, v1;
                    v0[0] = bflo(yw.x) * fast_sigmoid(a0[0]) * bflo(gw.x); v0[1] = bfhi(yw.x) * fast_sigmoid(a0[1]) * bfhi(gw.x);
                    v0[2] = bflo(yw.y) * fast_sigmoid(a0[2]) * bflo(gw.y); v0[3] = bfhi(yw.y) * fast_sigmoid(a0[3]) * bfhi(gw.y);
                    v1[0] = bflo(yw.z) * fast_sigmoid(a1[0]) * bflo(gw.z); v1[1] = bfhi(yw.z) * fast_sigmoid(a1[1]) * bfhi(gw.z);
                    v1[2] = bflo(yw.w) * fast_sigmoid(a1[2]) * bflo(gw.w); v1[3] = bfhi(yw.w) * fast_sigmoid(a1[3]) * bfhi(gw.w);
#pragma unroll
                    for (int e = 0; e < 4; ++e) ss += v0[e] * v0[e] + v1[e] * v1[e];
                    *(u32x4*)(MG + (size_t)r * 2048 + 1024 + c) = pack8(v0, v1); }
                ss += __shfl_xor(ss, 16); ss += __shfl_xor(ss, 32);
                if (fq == 0) SSQS[(size_t)r * 16 + u.pn * 4 + wc] = ss; }
    }
};
struct EpiOut {
    static constexpr bool PERM = false, MIDK = true;
    const float* xp; const float* xs; float* out; const float* ratio; const float* rsn;
    __device__ __forceinline__ void midk(f32x4 (&acc)[2][2][4][2], const Unit& u, int wr, int wc, int fr, int fq) const {
        const int row0 = u.pm * BM + wr * 64 + fr;
#pragma unroll
        for (int ai = 0; ai < 2; ++ai)
#pragma unroll
            for (int m = 0; m < 4; ++m) { const float s = ratio[row0 + ai * HALF + m * 16];
#pragma unroll
                for (int bj = 0; bj < 2; ++bj)
#pragma unroll
                    for (int n = 0; n < 2; ++n) acc[ai][bj][m][n] *= s; }
    }
    __device__ __forceinline__ void operator()(const f32x4 (&acc)[2][2][4][2], const Unit& u, int wr, int wc, int fr, int fq) const {
        const int row0 = u.pm * BM + wr * 64 + fr, col0 = u.pn * BM + wc * 32 + 4 * fq;
#pragma unroll
        for (int ai = 0; ai < 2; ++ai)
#pragma unroll
            for (int m = 0; m < 4; ++m) { const int r = row0 + ai * HALF + m * 16; const float s = rsn[r];
                const float* xr = (r < NPROMPT ? xp + (size_t)r * DM : xs + (size_t)(r - NPROMPT) * DM) + col0; float* orow = out + (size_t)r * DM + col0;
#pragma unroll
                for (int bj = 0; bj < 2; ++bj)
#pragma unroll
                    for (int n = 0; n < 2; ++n) { const f32x4 xv = *(const f32x4*)(xr + bj * HALF + n * 16); *(f32x4*)(orow + bj * HALF + n * 16) = xv + acc[ai][bj][m][n] * s; } }
    }
};
}

namespace attn {
using bf16 = __hip_bfloat16;
constexpr int D = 128, NW = 8, QBLK = 32, KVBLK = 64;
constexpr float SCALE = 0.088388347648318440f;
constexpr float THR = 8.f;
constexpr int SDEPTH = 2;
constexpr int LDQ = 1024, LDK = 512, LDO = 2048;
constexpr size_t SHM_V = KVBLK * D * 2, SHM_K = KVBLK * D * 2, SHM_ATTN = 2 * SHM_V + 2 * SHM_K + NW * 64 * 4;
using s16x4 = __attribute__((ext_vector_type(4))) short;
using f32x16 = __attribute__((ext_vector_type(16))) float;
#define KSWZ(row, colB) ((row) * 256 + ((colB) ^ (((row) & 7) << 4)))
#define SBAR() __builtin_amdgcn_sched_barrier(0)
__device__ __forceinline__ int crow(int r, int hi) { return (r & 3) + 8 * (r >> 2) + 4 * hi; }
__device__ __forceinline__ unsigned cvtpk(float lo, float hi) { unsigned r; asm volatile("v_cvt_pk_bf16_f32 %0, %1, %2" : "=v"(r) : "v"(lo), "v"(hi)); return r; }
__device__ __forceinline__ void partialSM(f32x16& p0, f32x16& p1, float& m_reg, float& mn, float& alpha) {
  constexpr float C = SCALE * 1.4426950408889634f;
  float pmax = p0[0]; for (int r = 1; r < 16; ++r) pmax = fmaxf(pmax, p0[r]); for (int r = 0; r < 16; ++r) pmax = fmaxf(pmax, p1[r]);
  { auto rr = __builtin_amdgcn_permlane32_swap(__float_as_uint(pmax), __float_as_uint(pmax), false, false);
    pmax = fmaxf(__uint_as_float(rr[0]), __uint_as_float(rr[1])); }
  if (__builtin_expect(__all(pmax - m_reg <= THR / SCALE), 1)) { mn = m_reg; alpha = 1.f; }
  else { mn = fmaxf(m_reg, pmax); alpha = __builtin_amdgcn_exp2f((m_reg - mn) * C); m_reg = mn; }
  float mnC = -mn * C;
  for (int r = 0; r < 16; ++r) p0[r] = fmaf(p0[r], C, mnC); for (int r = 0; r < 16; ++r) p1[r] = fmaf(p1[r], C, mnC);
  for (int r = 0; r < 16; ++r) p0[r] = __builtin_amdgcn_exp2f(p0[r]);
}
__device__ __forceinline__ void finishSM(f32x16& p0, f32x16& p1, float alpha, float& l_reg, bf16x8& pa0, bf16x8& pa1, bf16x8& pa2, bf16x8& pa3) {
  for (int r = 0; r < 16; ++r) p1[r] = __builtin_amdgcn_exp2f(p1[r]);
  float ps = 0; for (int r = 0; r < 16; ++r) ps += p0[r]; for (int r = 0; r < 16; ++r) ps += p1[r];
  { auto rr = __builtin_amdgcn_permlane32_swap(__float_as_uint(ps), __float_as_uint(ps), false, false);
    ps = __uint_as_float(rr[0]) + __uint_as_float(rr[1]); }
  l_reg = l_reg * alpha + ps;
#define PK4(P, BASE, OUT) do { unsigned a0 = cvtpk(P[BASE + 0], P[BASE + 1]), a1 = cvtpk(P[BASE + 2], P[BASE + 3]);   \
    unsigned b0 = cvtpk(P[BASE + 4], P[BASE + 5]), b1 = cvtpk(P[BASE + 6], P[BASE + 7]);                              \
    auto r0 = __builtin_amdgcn_permlane32_swap(a0, b0, false, false); auto r1 = __builtin_amdgcn_permlane32_swap(a1, b1, false, false); \
    u32x4 w = {r0[0], r1[0], r0[1], r1[1]}; OUT = *reinterpret_cast<bf16x8*>(&w); } while (0)
  PK4(p0, 0, pa0); PK4(p0, 8, pa1); PK4(p1, 0, pa2); PK4(p1, 8, pa3);
#undef PK4
}
__device__ __forceinline__ void qkt(f32x16& p0, f32x16& p1, const bf16* Ks, const bf16x8* qr, int r32, int hi) {
  p0 = f32x16{}; p1 = f32x16{};
  for (int d0 = 0; d0 < 8; ++d0) { int cb = (d0 * 16 + hi * 8) * 2;
    bf16x8 b0 = *reinterpret_cast<const bf16x8*>((const char*)Ks + KSWZ(r32, cb));
    bf16x8 b1 = *reinterpret_cast<const bf16x8*>((const char*)Ks + KSWZ(32 + r32, cb));
    p0 = __builtin_amdgcn_mfma_f32_32x32x16_bf16(b0, qr[d0], p0, 0, 0, 0);
    p1 = __builtin_amdgcn_mfma_f32_32x32x16_bf16(b1, qr[d0], p1, 0, 0, 0); }
}
__device__ __forceinline__ int v_st(int k, int c) { const int kk = (k & ~0xC) | ((k & 4) << 1) | ((k & 8) >> 1); return ((kk >> 3) * 4 + (c >> 5)) * 512 + ((kk & 7) * 32 + (c & 31)) * 2; }
__device__ __forceinline__ int v_rd_base(int lane) { return ((lane & 3) << 3) | (((lane >> 2) & 3) << 6) | (((lane >> 4) & 1) << 5) | (((lane >> 5) & 1) << 8); }
constexpr int v_rd_off(int d0, int ks, int half) { return d0 * 512 + ks * 4096 + half * 2048; }
template <int OFF> __device__ __forceinline__ s16x4 tr_read(int vb) {
  s16x4 r; asm volatile("ds_read_b64_tr_b16 %0, %1 offset:%2" : "=&v"(r) : "v"(vb), "i"(OFF) : "memory"); return r;
}
template <int D0> __device__ __forceinline__ void pv_one(f32x16& od, int vb, bf16x8 pa0, bf16x8 pa1, bf16x8 pa2, bf16x8 pa3) {
  const s16x4 l0 = tr_read<v_rd_off(D0, 0, 0)>(vb), h0 = tr_read<v_rd_off(D0, 0, 1)>(vb), l1 = tr_read<v_rd_off(D0, 1, 0)>(vb), h1 = tr_read<v_rd_off(D0, 1, 1)>(vb);
  const s16x4 l2 = tr_read<v_rd_off(D0, 2, 0)>(vb), h2 = tr_read<v_rd_off(D0, 2, 1)>(vb), l3 = tr_read<v_rd_off(D0, 3, 0)>(vb), h3 = tr_read<v_rd_off(D0, 3, 1)>(vb);
  asm volatile("s_waitcnt lgkmcnt(0)" ::: "memory"); SBAR();
#define PK(L, H) (bf16x8){L[0], L[1], L[2], L[3], H[0], H[1], H[2], H[3]}
  od = __builtin_amdgcn_mfma_f32_32x32x16_bf16(pa0, PK(l0, h0), od, 0, 0, 0);
  od = __builtin_amdgcn_mfma_f32_32x32x16_bf16(pa1, PK(l1, h1), od, 0, 0, 0);
  od = __builtin_amdgcn_mfma_f32_32x32x16_bf16(pa2, PK(l2, h2), od, 0, 0, 0);
  od = __builtin_amdgcn_mfma_f32_32x32x16_bf16(pa3, PK(l3, h3), od, 0, 0, 0);
#undef PK
}
__device__ __forceinline__ void pv_d0(f32x16* o, int vb, bf16x8 pa0, bf16x8 pa1, bf16x8 pa2, bf16x8 pa3) {
  pv_one<0>(o[0], vb, pa0, pa1, pa2, pa3); pv_one<1>(o[1], vb, pa0, pa1, pa2, pa3); pv_one<2>(o[2], vb, pa0, pa1, pa2, pa3); pv_one<3>(o[3], vb, pa0, pa1, pa2, pa3);
}

__device__ __forceinline__ void attn_dense_body(const bf16_t* __restrict__ Qb, const bf16* __restrict__ Kh, const bf16* __restrict__ Vh,
                                                const bf16_t* __restrict__ GAb, bf16_t* __restrict__ Ob, float* __restrict__ ssq,
                                                const float* __restrict__ qnw, const f32x2* __restrict__ tab, int pos0, int seq, char* lds) {
  const int tid = threadIdx.x, wid = tid >> 6, lane = tid & 63, r32 = lane & 31, hi = lane >> 5;
  bf16* V_lds = (bf16*)lds; bf16* K_lds = (bf16*)(lds + 2 * SHM_V);
  float* ws = (float*)(lds + 2 * SHM_V + 2 * SHM_K) + wid * 64; float* li_l = ws; float* al_l = ws + 32;
  bf16x8 qr[8];
  {
    const bf16_t* Qw = Qb + (long)(wid * QBLK + r32) * LDQ + hi * 8;
    u32x4 raw[8]; float ss = 0.f;
#pragma unroll
    for (int d0 = 0; d0 < 8; ++d0) raw[d0] = *reinterpret_cast<const u32x4*>(Qw + d0 * 16);
#pragma unroll
    for (int d0 = 0; d0 < 8; ++d0) {
#pragma unroll
      for (int q = 0; q < 4; ++q) { const float a = bflo(raw[d0][q]), b = bfhi(raw[d0][q]); ss += a * a + b * b; } }
    { auto rr = __builtin_amdgcn_permlane32_swap(__float_as_uint(ss), __float_as_uint(ss), false, false); ss = __uint_as_float(rr[0]) + __uint_as_float(rr[1]); }
    const float rn = 1.0f / sqrtf(ss * (1.0f / 128.0f) + EPS);
    const int pos = pos0 + wid * QBLK + r32, prow = pos >> 6, pcol = pos & 63;
#pragma unroll
    for (int pg = 0; pg < 4; ++pg) { const int dd = pg & 1, ax = pg >> 1, d0 = ax * 4 + dd;
      const f32x2* tp = tab + (ax == 0 ? prow : pcol) * 32 + hi * 8 + dd * 16;
      const float* wa = qnw + d0 * 16 + hi * 8; const float* wb = wa + 32;
      float na[8], nb[8];
#pragma unroll
      for (int q = 0; q < 4; ++q) {
        const f32x2 c0 = tp[2 * q], c1 = tp[2 * q + 1];
        const float a0 = bflo(raw[d0][q]) * (rn * wa[2 * q]), a1 = bfhi(raw[d0][q]) * (rn * wa[2 * q + 1]);
        const float b0 = bflo(raw[d0 + 2][q]) * (rn * wb[2 * q]), b1 = bfhi(raw[d0 + 2][q]) * (rn * wb[2 * q + 1]);
        na[2 * q] = a0 * c0.x - b0 * c0.y; nb[2 * q] = b0 * c0.x + a0 * c0.y;
        na[2 * q + 1] = a1 * c1.x - b1 * c1.y; nb[2 * q + 1] = b1 * c1.x + a1 * c1.y; }
      { u32x4 w = {cvtpk(na[0], na[1]), cvtpk(na[2], na[3]), cvtpk(na[4], na[5]), cvtpk(na[6], na[7])}; qr[d0] = *reinterpret_cast<bf16x8*>(&w); }
      { u32x4 w = {cvtpk(nb[0], nb[1]), cvtpk(nb[2], nb[3]), cvtpk(nb[4], nb[5]), cvtpk(nb[6], nb[7])}; qr[d0 + 2] = *reinterpret_cast<bf16x8*>(&w); }
      asm volatile("" ::: "memory"); }
  }
  float m_reg = -1e30f, l_reg = 0; f32x16 o[4] = {};
  const int sr = tid >> 4, sc = (tid & 15) * 8, vst0 = v_st(sr, sc), vst1 = v_st(32 + sr, sc);
  const int vb0 = (int)(uintptr_t)V_lds + v_rd_base(lane);
  struct { bf16x8 vs0, vs1, ks0, ks1; } sr_[SDEPTH];
#define SLD8(p) (*reinterpret_cast<const bf16x8*>(p))
#define SLOAD(i, k0) do { sr_[i].vs0 = SLD8(&Vh[(long)((k0) + sr) * LDK + sc]); sr_[i].vs1 = SLD8(&Vh[(long)((k0) + 32 + sr) * LDK + sc]); \
    sr_[i].ks0 = SLD8(&Kh[(long)((k0) + sr) * LDK + sc]); sr_[i].ks1 = SLD8(&Kh[(long)((k0) + 32 + sr) * LDK + sc]); } while (0)
#define SWRITE(b, i) do { *(bf16x8*)((char*)V_lds + (b) * SHM_V + vst0) = sr_[i].vs0;          \
    *(bf16x8*)((char*)V_lds + (b) * SHM_V + vst1) = sr_[i].vs1; int kc = sc * 2;               \
    *(bf16x8*)((char*)K_lds + (b) * SHM_K + KSWZ(sr, kc)) = sr_[i].ks0;                       \
    *(bf16x8*)((char*)K_lds + (b) * SHM_K + KSWZ(32 + sr, kc)) = sr_[i].ks1; } while (0)
#define SWAIT() do { asm volatile("s_waitcnt vmcnt(4)" ::: "memory"); } while (0)
#define RESC(a) do { if (__any((a) < 1.f)) { if (hi == 0) al_l[r32] = (a); asm volatile("s_waitcnt lgkmcnt(0)" ::: "memory"); \
    for (int d = 0; d < 4; ++d) for (int r = 0; r < 16; ++r) o[d][r] *= al_l[crow(r, hi)]; } } while (0)
  f32x16 pA0, pA1, pB0, pB1; float mnA, mnB, alA, alB; bf16x8 pa0, pa1, pa2, pa3; const int NT = seq / KVBLK;
  constexpr int SE = 0, SO = SDEPTH - 1;
  SLOAD(SE, 0); asm volatile("s_waitcnt vmcnt(0)" ::: "memory"); SWRITE(0, SE); __syncthreads();
  qkt(pA0, pA1, K_lds, qr, r32, hi); partialSM(pA0, pA1, m_reg, mnA, alA);
  SLOAD(SO, KVBLK); if (2 < NT) SLOAD(SE, 2 * KVBLK);
  SWAIT(); SWRITE(1, SO); __syncthreads();
  for (int j = 1; j + 1 < NT; j += 2) {
    SBAR(); qkt(pB0, pB1, (bf16*)((char*)K_lds + SHM_K), qr, r32, hi);
    finishSM(pA0, pA1, alA, l_reg, pa0, pa1, pa2, pa3); SBAR();
    SLOAD(SO, (j + SDEPTH) * KVBLK); SBAR();
    pv_d0(o, vb0, pa0, pa1, pa2, pa3); partialSM(pB0, pB1, m_reg, mnB, alB);
    __syncthreads(); SWAIT(); SWRITE(0, SE);
    RESC(alB); __syncthreads();
    SBAR(); qkt(pA0, pA1, K_lds, qr, r32, hi);
    finishSM(pB0, pB1, alB, l_reg, pa0, pa1, pa2, pa3); SBAR();
    if (j + 3 < NT) SLOAD(SE, (j + 1 + SDEPTH) * KVBLK); SBAR();
    pv_d0(o, vb0 + (int)SHM_V, pa0, pa1, pa2, pa3); partialSM(pA0, pA1, m_reg, mnA, alA);
    __syncthreads(); SWAIT(); SWRITE(1, SO);
    RESC(alA); __syncthreads();
  }
  SBAR(); qkt(pB0, pB1, (bf16*)((char*)K_lds + SHM_K), qr, r32, hi);
  finishSM(pA0, pA1, alA, l_reg, pa0, pa1, pa2, pa3); SBAR();
  pv_d0(o, vb0, pa0, pa1, pa2, pa3); partialSM(pB0, pB1, m_reg, mnB, alB);
  __syncthreads(); RESC(alB);
  finishSM(pB0, pB1, alB, l_reg, pa0, pa1, pa2, pa3); SBAR();
  pv_d0(o, vb0 + (int)SHM_V, pa0, pa1, pa2, pa3);
  if (hi == 0) li_l[r32] = l_reg; asm volatile("s_waitcnt lgkmcnt(0)" ::: "memory");
  { int te = threadIdx.x; asm volatile("" : "+v"(te));
    const int ew = te >> 6, er = te & 31, eh = (te >> 5) & 1;
    const long rbase = (long)(ew * QBLK + 4 * eh) ;
#pragma unroll
    for (int r = 0; r < 16; ++r) { const int orow = (r & 3) + 8 * (r >> 2); const float rl = __builtin_amdgcn_rcpf(li_l[orow + 4 * eh]); float s2 = 0.f;
      const bf16_t* gp = GAb + (rbase + orow) * 1024 + er; bf16_t* op = Ob + (rbase + orow) * LDO + er;
#pragma unroll
      for (int d0 = 0; d0 < 4; ++d0) { const float gv = bf2f(gp[d0 * 32]); const float v = o[d0][r] * rl * gv; s2 += v * v;
        op[d0 * 32] = (bf16_t)(cvtpk(v, v) & 0xffffu); }
      s2 += __shfl_xor(s2, 1); s2 += __shfl_xor(s2, 2); s2 += __shfl_xor(s2, 4); s2 += __shfl_xor(s2, 8); s2 += __shfl_xor(s2, 16);
      if (er == 0) ssq[(rbase + orow) * 8] = s2; } }
  __syncthreads();
#undef SLD8
#undef SLOAD
#undef SWRITE
#undef SWAIT
#undef RESC
}
#undef KSWZ
#undef SBAR
}

constexpr size_t MiB = 1u << 20;
constexpr size_t WS_CTL = 0, CTL_ZERO_BYTES = 1 * MiB;
constexpr size_t WS_RS = 1 * MiB;
constexpr size_t WS_RATIO = 2 * MiB;
constexpr size_t WS_RSN = 3 * MiB;
constexpr size_t WS_SSQA = 4 * MiB;
constexpr size_t WS_SSQS = 6 * MiB;
constexpr size_t WS_TAB = 10 * MiB;
constexpr size_t WS_WINT = 16 * MiB;
constexpr size_t WS_WGLUT = 34 * MiB;
constexpr size_t WS_WOUTT = 36 * MiB;
constexpr size_t WS_Q = 64 * MiB;
constexpr size_t WS_KV = 192 * MiB;
constexpr size_t WS_GA = 256 * MiB;
constexpr size_t WS_GS = 384 * MiB;
constexpr size_t WS_MG = 512 * MiB;
constexpr size_t WS_Y = 768 * MiB;
constexpr size_t WS_END = 896 * MiB;
constexpr size_t OU_XB = 0;
constexpr size_t OU_BTM = 0;
constexpr size_t OU_AG = 256 * MiB;
constexpr size_t OU_WLR = 416 * MiB;
constexpr size_t OU_K0 = 448 * MiB;
constexpr size_t OU_LR = 456 * MiB;
constexpr size_t WS_LR = 896 * MiB;
constexpr size_t WS_BTM = 960 * MiB;
constexpr size_t WS_NEED = 960 * MiB;

constexpr int CW_TMO = 0, CW_BAR = 4096;

#define XB_TMO      128
#define XB_XCNT(j)  (256  + 64 * (j))
#define XB_XSUB(j)  (1280 + 64 * (j))
#define XB_XGEN(j)  (2304 + 64 * (j))
#define XB_TOP      3328
#define XB_TOPGEN   3392
#define XCD_BAR_WORDS 3456
#define XB_SPIN_CAP (1u << 20)
__device__ __forceinline__ unsigned xb_ld(unsigned* p)              { return __hip_atomic_load(p, __ATOMIC_RELAXED, __HIP_MEMORY_SCOPE_AGENT); }
__device__ __forceinline__ unsigned xb_add(unsigned* p, unsigned v) { return __hip_atomic_fetch_add(p, v, __ATOMIC_RELAXED, __HIP_MEMORY_SCOPE_AGENT); }
__device__ __forceinline__ unsigned xb_xcc_id() { return (unsigned)__builtin_amdgcn_s_getreg((3 << 11) | 20) & 0xFu; }
#define XB_SPIN(cond, bar) do { unsigned _sp = 0; while (cond) { __builtin_amdgcn_s_sleep(1); \
    if ((++_sp & 255u) == 0u) { if (xb_ld(&(bar)[XB_TMO])) break; if (_sp > XB_SPIN_CAP) { atomicAdd(&(bar)[XB_TMO], 1u); break; } } } } while (0)
struct XcdBarrier { unsigned* bar; unsigned x; volatile LAS unsigned* st; };
__device__ __forceinline__ XcdBarrier xcd_barrier_post(unsigned* bar, volatile LAS unsigned* st) {
    XcdBarrier b; b.bar = bar; b.x = xb_xcc_id(); b.st = st;
    if (threadIdx.x == 0) (void)xb_add(&bar[XB_XCNT(b.x)], 1u);
    return b;
}
__device__ __forceinline__ void xcd_barrier_complete(unsigned* bar, unsigned x, unsigned& nloc, unsigned& nx) {
    const unsigned G = gridDim.x * gridDim.y * gridDim.z;
    unsigned sum, cnt, mine, sp = 0u;
    for (;;) {
        sum = 0u; cnt = 0u; mine = 0u;
#pragma unroll
        for (unsigned j = 0; j < 16; ++j) { const unsigned c = xb_ld(&bar[XB_XCNT(j)]); sum += c; cnt += (c > 0u) ? 1u : 0u; mine = (j == x) ? c : mine; }
        if (sum == G) break;
        __builtin_amdgcn_s_sleep(1);
        if ((++sp & 255u) == 0u) { if (xb_ld(&bar[XB_TMO])) break; if (sp > XB_SPIN_CAP) { atomicAdd(&bar[XB_TMO], 1u); break; } }
    }
    nloc = mine > 0u ? mine : 1u; nx = cnt > 0u ? cnt : 1u;
}
__device__ __forceinline__ void xcd_barrier(const XcdBarrier& b) {
    asm volatile("s_waitcnt vmcnt(0)" ::: "memory");
    __syncthreads();
    if (threadIdx.x == 0) {
        unsigned* bar = b.bar;
        __builtin_amdgcn_s_waitcnt(0);
        unsigned nloc = b.st[0], nx = b.st[1];
        if (nloc == 0u) { xcd_barrier_complete(bar, b.x, nloc, nx); b.st[0] = nloc; b.st[1] = nx; }
        const unsigned old = xb_add(&bar[XB_XSUB(b.x)], 1u);
        const unsigned gen = old / nloc;
        if (old + 1u == (gen + 1u) * nloc) {
            __builtin_amdgcn_fence(__ATOMIC_RELEASE, "agent");
            asm volatile("s_waitcnt vmcnt(0)" ::: "memory");
            const unsigned og = xb_add(&bar[XB_TOP], 1u);
            const unsigned tg = og / nx;
            if (og + 1u == (tg + 1u) * nx) xb_add(&bar[XB_TOPGEN], 1u);
            else XB_SPIN(xb_ld(&bar[XB_TOPGEN]) == tg, bar);
            __builtin_amdgcn_fence(__ATOMIC_ACQUIRE, "agent");
            xb_add(&bar[XB_XGEN(b.x)], 1u);
            asm volatile("s_waitcnt vmcnt(0)" ::: "memory");
        } else {
            XB_SPIN(xb_ld(&bar[XB_XGEN(b.x)]) == gen, bar);
            __builtin_amdgcn_fence(__ATOMIC_ACQUIRE, "agent");
            asm volatile("s_waitcnt vmcnt(0)" ::: "memory");
        }
    }
    __syncthreads();
}

constexpr int RING_OFF = 0, RING_BYTES = 131072;
constexpr int LDSCTL_OFF = RING_BYTES, MISC_OFF = LDSCTL_OFF + 320;
constexpr int LDS_BYTES = 147456;
constexpr int NWAVES = 8;

struct Args {
    const float* in[18]; float* out; unsigned char* ws; int ph_lo, ph_hi, li, pad;
};

__device__ __forceinline__ float wave_sum(float v) {
#pragma unroll
    for (int o = 1; o < 64; o <<= 1) v += __shfl_xor(v, o);
    return v;
}
__device__ __forceinline__ void p0_transpose_item(const float* W, int K, int N, bf16_t* WT, LAS float* scr, int item, int lane, const float* ks1, const float* ks2, int ksplit) {
    const int nblk = N / 32, kb = item / nblk, nb = item % nblk, k0 = 64 * kb, n0 = 32 * nb;
#pragma unroll 8
    for (int i = 0; i < 32; ++i) { const int kk = 2 * i + (lane >> 5), k = k0 + kk; float s = 1.f; if (ks1) s = (k < ksplit) ? ks1[k] : ks2[k - ksplit];
        scr[kk * 33 + (lane & 31)] = W[(size_t)k * N + n0 + (lane & 31)] * s; }
    asm volatile("s_waitcnt lgkmcnt(0)" ::: "memory");
    const int c = lane & 7;
#pragma unroll
    for (int j = 0; j < 4; ++j) { const int n = (lane >> 3) + 8 * j; const LAS float* s = scr + (8 * c) * 33 + n;
        u32x4 o; o.x = cvt_pk_bf16(s[0 * 33], s[1 * 33]); o.y = cvt_pk_bf16(s[2 * 33], s[3 * 33]); o.z = cvt_pk_bf16(s[4 * 33], s[5 * 33]); o.w = cvt_pk_bf16(s[6 * 33], s[7 * 33]);
        *(GAS u32x4*)(WT + (size_t)(n0 + n) * K + k0 + 8 * c) = o; }
    asm volatile("s_waitcnt lgkmcnt(0)" ::: "memory");
}
__device__ __forceinline__ void ssm_disc(const float* lre, const float* lim, const float* lstep, int d, int g, int p, f32x2& lb, f32x2& bs) {
    const float lr = lre[(d * NG + g) * NPST + p], li = lim[(d * NG + g) * NPST + p], dt = expf(lstep[d * NG + g]);
    const float mag = expf(lr * dt), ang = li * dt; lb.x = mag * cosf(ang); lb.y = mag * sinf(ang);
    const float nr = lb.x - 1.0f, ni = lb.y, den = 1.0f / (lr * lr + li * li);
    bs.x = (nr * lr + ni * li) * den; bs.y = (ni * lr - nr * li) * den;
}
__device__ __forceinline__ f32x2 ssm_pow(const float* lre, const float* lim, const float* lstep, int d, int g, int p, int e) {
    const float lr = lre[(d * NG + g) * NPST + p], li = lim[(d * NG + g) * NPST + p], dt = expf(lstep[d * NG + g]);
    const float mag = expf(lr * dt * (float)e), ang = li * dt * (float)e; f32x2 r; r.x = mag * cosf(ang); r.y = mag * sinf(ang); return r;
}
__device__ __forceinline__ f32x2 cmul(f32x2 a, f32x2 b) { f32x2 r; r.x = a.x * b.x - a.y * b.y; r.y = a.x * b.y + a.y * b.x; return r; }

__global__ void __launch_bounds__(NWAVES * 64, 2) enc_fwd(Args args) {
    extern __shared__ __attribute__((aligned(16))) unsigned char lds[];
    LAS unsigned char* const L = (LAS unsigned char*)lds;
    volatile LAS unsigned* const MISC = (volatile LAS unsigned*)(L + MISC_OFF);
    const int tid = threadIdx.x, lane = tid & 63, wave = __builtin_amdgcn_readfirstlane(tid >> 6);
    const int G = gridDim.x; const int bx = blockIdx.x; const int vcu = (G % 8 == 0) ? (bx % 8) * (G / 8) + bx / 8 : bx;
    unsigned char* const ws = args.ws; unsigned char* const ou = (unsigned char*)args.out;
    gu32* const ctl = (gu32*)(ws + WS_CTL);
    const float* x_p = args.in[0]; const float* x_s = args.in[1]; const float* norm_w = args.in[2]; const float* w_in = args.in[3];
    const float* q_norm_w = args.in[4]; const float* k_norm_w = args.in[5]; const float* lam_re = args.in[6]; const float* lam_im = args.in[7]; const float* log_step = args.in[8];
    const float* b_re = args.in[9]; const float* b_im = args.in[10]; const float* c_re = args.in[11]; const float* c_im = args.in[12]; const float* d_skip = args.in[13];
    const float* w_glu = args.in[14]; const float* aonw = args.in[15]; const float* sonw = args.in[16]; const float* w_out = args.in[17];
    float* const RS = (float*)(ws + WS_RS); float* const RATIO = (float*)(ws + WS_RATIO); float* const RSN = (float*)(ws + WS_RSN);
    float* const SSQA = (float*)(ws + WS_SSQA); float* const SSQS = (float*)(ws + WS_SSQS); f32x2* const TAB = (f32x2*)(ws + WS_TAB);
    bf16_t* const WINT = (bf16_t*)(ws + WS_WINT); bf16_t* const WGLUT = (bf16_t*)(ws + WS_WGLUT); bf16_t* const WOUTT = (bf16_t*)(ws + WS_WOUTT);
    bf16_t* const QB = (bf16_t*)(ws + WS_Q); bf16_t* const KVB = (bf16_t*)(ws + WS_KV); bf16_t* const GA = (bf16_t*)(ws + WS_GA); bf16_t* const GS = (bf16_t*)(ws + WS_GS);
    bf16_t* const MG = (bf16_t*)(ws + WS_MG); bf16_t* const YB = (bf16_t*)(ws + WS_Y); float* const LR = (float*)(ws + WS_LR);
    bf16_t* const XB = (bf16_t*)(ou + OU_XB); bf16_t* const BTM = (bf16_t*)(ou + OU_BTM); bf16_t* const AG = (bf16_t*)(ou + OU_AG);
    bf16_t* const WLR = (bf16_t*)(ou + OU_WLR); float* const K0T = (float*)(ou + OU_K0);

    for (int u = tid; u < (LDS_BYTES - LDSCTL_OFF) / 4; u += NWAVES * 64) ((LAS unsigned*)(L + LDSCTL_OFF))[u] = 0u;
    __syncthreads();
    XcdBarrier bar; bar.bar = (unsigned*)(ctl + CW_BAR) + args.li * XCD_BAR_WORDS; bar.x = 0; bar.st = nullptr;
    if (N_LAUNCHES != NPH) bar = xcd_barrier_post((unsigned*)(ctl + CW_BAR) + args.li * XCD_BAR_WORDS, MISC + 8);
#define GRID_BAR() do { if (N_LAUNCHES == NPH) { if (tid == 0) __hip_atomic_store(ctl + CW_TMO, 0xBADBA0u, __ATOMIC_RELAXED, __HIP_MEMORY_SCOPE_AGENT); } else { xcd_barrier(bar); } } while (0)
    const int lo = args.ph_lo, hi = args.ph_hi;
#ifndef PH_ONLY
#define PH_ONLY -1
#endif
#define IN(k) ((PH_ONLY < 0 || PH_ONLY == (k)) && lo <= (k) && (k) < hi)
#define BOTH(k) (IN(k) && IN((k) + 1))
    const int gw = vcu * NWAVES + wave, NGW = G * NWAVES;
    LAS float* const scr = (LAS float*)(L + RING_OFF + wave * 16384);

    if (IN(0)) {
        {
            constexpr int I_IN = (DM / 64) * (INC / 32), I_GLU = (1024 / 64) * (1024 / 32), I_OUT = (2048 / 64) * (2048 / 32);
            for (int it = gw; it < I_IN + I_GLU + I_OUT; it += NGW) {
                int r = it;
                if (r < I_IN) { p0_transpose_item(w_in, DM, INC, WINT, scr, r, lane, norm_w, norm_w, DM); continue; } r -= I_IN;
                if (r < I_GLU) { p0_transpose_item(w_glu, 1024, 1024, WGLUT, scr, r, lane, nullptr, nullptr, 0); continue; } r -= I_GLU;
                p0_transpose_item(w_out, 2048, 2048, WOUTT, scr, r, lane, aonw, sonw, 1024);
            }
        }
        for (int i = gw * 64 + lane; i < 128 * 32; i += NGW * 64) { const int pos = i >> 5, f = i & 31;
            const float inv = 1.0f / powf(10000.0f, (float)f * (1.0f / 32.0f)); const float ang = (float)pos * inv; f32x2 cs; cs.x = cosf(ang); cs.y = sinf(ang); TAB[i] = cs; }
        for (int it = gw; it < NG * 2 * 16; it += NGW) {
            const int g = __builtin_amdgcn_readfirstlane(it >> 5), d = __builtin_amdgcn_readfirstlane((it >> 4) & 1), tb = __builtin_amdgcn_readfirstlane(it & 15);
            const int tl = lane >> 4, co = lane & 15, tau = tb * 4 + tl;
            LAS f32x2* Es = (LAS f32x2*)scr;
            LAS f32x2* Cs = (LAS f32x2*)(scr + 512);
#pragma unroll
            for (int i = 0; i < 4; ++i) { const int p = co + 16 * i; f32x2 lb, bs; ssm_disc(lam_re, lam_im, log_step, d, g, p, lb, bs); const f32x2 pw = ssm_pow(lam_re, lam_im, log_step, d, g, p, tau); Es[tl * 64 + p] = cmul(pw, bs); }
#pragma unroll
            for (int k = 0; k < 16; ++k) { f32x2 c; c.x = c_re[((size_t)(d * NG + g) * NCH + k) * NPST + lane]; c.y = c_im[((size_t)(d * NG + g) * NCH + k) * NPST + lane]; Cs[k * 65 + lane] = c; }
            asm volatile("s_waitcnt lgkmcnt(0)" ::: "memory");
            float acc[16];
#pragma unroll
            for (int ci = 0; ci < 16; ++ci) acc[ci] = 0.f;
            for (int p = 0; p < NPST; ++p) { const f32x2 ce = cmul(Cs[co * 65 + p], Es[tl * 64 + p]);
                const float* br = b_re + ((size_t)g * NPST + p) * NCH; const float* bi = b_im + ((size_t)g * NPST + p) * NCH;
#pragma unroll
                for (int ci = 0; ci < 16; ++ci) acc[ci] += ce.x * br[ci] - ce.y * bi[ci]; }
            float* dst = K0T + (((size_t)(g * 2 + d) * CT + tau) * NCH + co) * NCH;
#pragma unroll
            for (int q = 0; q < 4; ++q) *(f32x4*)(dst + 4 * q) = (f32x4){acc[4 * q], acc[4 * q + 1], acc[4 * q + 2], acc[4 * q + 3]};
            asm volatile("s_waitcnt lgkmcnt(0)" ::: "memory");
        }
        for (int it = gw; it < NG * 2; it += NGW) {
            const int g = it >> 1, d = it & 1, p = lane; f32x2 lb, bs; ssm_disc(lam_re, lam_im, log_step, d, g, p, lb, bs);
            float br[16], bi[16];
#pragma unroll
            for (int ci = 0; ci < 16; ++ci) { br[ci] = b_re[((size_t)g * NPST + p) * NCH + ci]; bi[ci] = b_im[((size_t)g * NPST + p) * NCH + ci]; }
            f32x2 w = bs;
            bf16_t* rre = WLR + ((size_t)g * 256 + d * 128 + p) * 1024; bf16_t* rim = rre + (size_t)64 * 1024;
            for (int e = 0; e < CT; ++e) { const int jp = d == 0 ? (CT - 1 - e) : e; float vr[16], vi[16];
#pragma unroll
                for (int ci = 0; ci < 16; ++ci) { vr[ci] = w.x * br[ci] - w.y * bi[ci]; vi[ci] = w.x * bi[ci] + w.y * br[ci]; }
                u32x4 o0, o1, o2, o3;
                o0.x = cvt_pk_bf16(vr[0], vr[1]); o0.y = cvt_pk_bf16(vr[2], vr[3]); o0.z = cvt_pk_bf16(vr[4], vr[5]); o0.w = cvt_pk_bf16(vr[6], vr[7]);
                o1.x = cvt_pk_bf16(vr[8], vr[9]); o1.y = cvt_pk_bf16(vr[10], vr[11]); o1.z = cvt_pk_bf16(vr[12], vr[13]); o1.w = cvt_pk_bf16(vr[14], vr[15]);
                o2.x = cvt_pk_bf16(vi[0], vi[1]); o2.y = cvt_pk_bf16(vi[2], vi[3]); o2.z = cvt_pk_bf16(vi[4], vi[5]); o2.w = cvt_pk_bf16(vi[6], vi[7]);
                o3.x = cvt_pk_bf16(vi[8], vi[9]); o3.y = cvt_pk_bf16(vi[10], vi[11]); o3.z = cvt_pk_bf16(vi[12], vi[13]); o3.w = cvt_pk_bf16(vi[14], vi[15]);
                *(u32x4*)(rre + jp * 16) = o0; *(u32x4*)(rre + jp * 16 + 8) = o1; *(u32x4*)(rim + jp * 16) = o2; *(u32x4*)(rim + jp * 16 + 8) = o3;
                w = cmul(w, lb); }
        }
        for (int m = gw; m < NTOK; m += NGW) {
            const float* xrow = m < NPROMPT ? x_p + (size_t)m * DM : x_s + (size_t)(m - NPROMPT) * DM;
            const GAS f32x4* xr = (const GAS f32x4*)xrow + lane; f32x4 v[8]; float s = 0.f;
#pragma unroll
            for (int j = 0; j < 8; ++j) { v[j] = xr[64 * j]; s += (v[j].x * v[j].x + v[j].y * v[j].y) + (v[j].z * v[j].z + v[j].w * v[j].w); }
            s = wave_sum(s); if (lane == 0) RS[m] = 1.0f / sqrtf(s * (1.0f / DM) + EPS);
            GAS u32x2* o8 = (GAS u32x2*)(XB + (size_t)m * DM) + lane;
#pragma unroll
            for (int j = 0; j < 8; ++j) { u32x2 w; w.x = cvt_pk_bf16(v[j].x, v[j].y); w.y = cvt_pk_bf16(v[j].z, v[j].w); o8[64 * j] = w; }
        }
        if (BOTH(0)) GRID_BAR();
    }

    if (IN(1)) {
        pg8::Gemm g{XB, WINT, DM, DM, DM, 0, 0}; pg8::StaticOrder S; S.init(NTOK, INC, G, bx);
        pg8::EpiInProj E{RS, QB, KVB, GA, GS, AG};
        pg8::gemm_phase<pg8::EpiInProj, pg8::StaticOrder, true, true>(L + RING_OFF, g, S, E);
        if (BOTH(1)) GRID_BAR();
    }

    if (IN(2)) {
        for (int m = gw; m < NTOK; m += NGW) {
            const int pos = m < NPROMPT ? (m & (SP - 1)) : ((m - NPROMPT) & (SS - 1)); const int prow = pos >> 6, pcol = pos & 63;
            GAS u32x2* kp = (GAS u32x2*)(KVB + (size_t)m * 512) + lane; const u32x2 w = *kp;
            float v0 = bflo(w.x), v1 = bfhi(w.x), v2 = bflo(w.y), v3 = bfhi(w.y);
            float ss = (v0 * v0 + v1 * v1) + (v2 * v2 + v3 * v3);
            ss += __shfl_xor(ss, 1); ss += __shfl_xor(ss, 2); ss += __shfl_xor(ss, 4); ss += __shfl_xor(ss, 8); ss += __shfl_xor(ss, 16);
            const float rn = 1.0f / sqrtf(ss * (1.0f / 128.0f) + EPS);
            const int dl = (lane & 31) * 4;
            const f32x4 kw = *(const f32x4*)(k_norm_w + dl);
            v0 *= rn * kw[0]; v1 *= rn * kw[1]; v2 *= rn * kw[2]; v3 *= rn * kw[3];
            const int ax = dl >> 6, half = (dl >> 5) & 1, fi = dl & 31;
            const f32x2* tp = TAB + (ax == 0 ? prow : pcol) * 32 + fi;
            const f32x2 c0 = tp[0], c1 = tp[1], c2 = tp[2], c3 = tp[3];
            const float p0 = __shfl_xor(v0, 8), p1 = __shfl_xor(v1, 8), p2 = __shfl_xor(v2, 8), p3 = __shfl_xor(v3, 8);
            float o0, o1, o2, o3;
            if (half == 0) { o0 = v0 * c0.x - p0 * c0.y; o1 = v1 * c1.x - p1 * c1.y; o2 = v2 * c2.x - p2 * c2.y; o3 = v3 * c3.x - p3 * c3.y; }
            else           { o0 = v0 * c0.x + p0 * c0.y; o1 = v1 * c1.x + p1 * c1.y; o2 = v2 * c2.x + p2 * c2.y; o3 = v3 * c3.x + p3 * c3.y; }
            u32x2 ow; ow.x = cvt_pk_bf16(o0, o1); ow.y = cvt_pk_bf16(o2, o3); *kp = ow;
        }
        for (long pc = (long)gw * 64 + lane; pc < (long)NG * 1024 * 128; pc += (long)NGW * 64) {
            const int kp8 = (int)(pc & 127), n = (int)((pc >> 7) & 1023), g = (int)(pc >> 17);
            const int j = n >> 4, co = n & 15, jp = kp8 >> 1, ci0 = (kp8 & 1) * 8;
            const int dsel = j >= jp ? 0 : 1, tau = j >= jp ? j - jp : jp - j;
            const float* src = K0T + (((size_t)(g * 2 + dsel) * CT + tau) * NCH + co) * NCH + ci0;
            f32x4 a = *(const f32x4*)src, b = *(const f32x4*)(src + 4);
            if (j == jp) { const float* s2 = K0T + (((size_t)(g * 2 + 1) * CT) * NCH + co) * NCH + ci0; a += *(const f32x4*)s2; b += *(const f32x4*)(s2 + 4); }
            *(u32x4*)(BTM + ((size_t)g * 1024 + n) * KA + kp8 * 8) = pg8::pack8(a, b);
        }
        for (int it = gw; it < NG * 2 * NCH; it += NGW) {
            const int g = it >> 5, d = (it >> 4) & 1, co = it & 15, p = lane; f32x2 lb, bs; ssm_disc(lam_re, lam_im, log_step, d, g, p, lb, bs);
            f32x2 c; c.x = c_re[((size_t)(d * NG + g) * NCH + co) * NPST + p]; c.y = c_im[((size_t)(d * NG + g) * NCH + co) * NPST + p];
            f32x2 w = cmul(c, lb);
            for (int e = 1; e <= CT; ++e) { const int j = d == 0 ? e - 1 : CT - e;
                bf16_t* dst = BTM + ((size_t)g * 1024 + j * 16 + co) * KA + 1024 + d * 128 + p;
                dst[0] = (bf16_t)(cvt_pk_bf16(w.x, w.x) & 0xffffu); dst[64] = (bf16_t)(cvt_pk_bf16(-w.y, -w.y) & 0xffffu);
                w = cmul(w, lb); }
        }
        __syncthreads();
        {
            pg8::Gemm g{AG, WLR, KA, 1024, 1024, (size_t)NCHUNK * KA, (size_t)256 * 1024}; pg8::BatchOrder S; S.init(NG, 4, 1, G, vcu);
            pg8::EpiLR E{LR};
            pg8::gemm_phase<pg8::EpiLR, pg8::BatchOrder, true, true>(L + RING_OFF, g, S, E);
        }
        if (BOTH(2)) GRID_BAR();
    }

    if (IN(3)) {
        for (int it = gw; it < 20 * NG * 2; it += NGW) {
            int s, rest; if (it < 4 * NG * 2) { s = 16 + it / (NG * 2); rest = it % (NG * 2); } else { const int t2 = it - 4 * NG * 2; s = t2 / (NG * 2); rest = t2 % (NG * 2); }
            const int g = rest >> 1, d = rest & 1, p = lane;
            const int c0 = s < 16 ? 32 * s : 512 + 128 * (s - 16), nc = s < 16 ? 32 : 128;
            const f32x2 lT = ssm_pow(lam_re, lam_im, log_step, d, g, p, CT);
            const float* lr = LR + ((size_t)g * NCHUNK) * 256 + d * 128 + p; bf16_t* ag = AG + ((size_t)g * NCHUNK) * KA + 1024 + d * 128 + p;
            f32x2 h; h.x = 0.f; h.y = 0.f;
            for (int cb = 0; cb < nc; cb += 8) {
                float xr[8], xi[8];
#pragma unroll
                for (int q = 0; q < 8; ++q) { const int ch = d == 0 ? c0 + cb + q : c0 + nc - 1 - (cb + q); xr[q] = lr[(size_t)ch * 256]; xi[q] = lr[(size_t)ch * 256 + 64]; }
#pragma unroll
                for (int q = 0; q < 8; ++q) { const int ch = d == 0 ? c0 + cb + q : c0 + nc - 1 - (cb + q);
                    ag[(size_t)ch * KA] = (bf16_t)(cvt_pk_bf16(h.x, h.x) & 0xffffu); ag[(size_t)ch * KA + 64] = (bf16_t)(cvt_pk_bf16(h.y, h.y) & 0xffffu);
                    h = cmul(h, lT); h.x += xr[q]; h.y += xi[q]; }
            }
        }
        __syncthreads();
        for (int i = 0; i < 2048; ++i) {
            int seq_row0, seqlen, kvh, hq, qb;
            if (G == 256) {
                if (i >= 8) break;
                const int xcd = vcu >> 5, loc = vcu & 31;
                if (i < 4) { const int s = xcd >> 1; kvh = xcd & 1; const int idx = loc * 4 + i; hq = idx >> 5; qb = idx & 31; seq_row0 = NPROMPT + s * SS; seqlen = SS; }
                else { const int combo = xcd * 4 + (i - 4); const int s = combo >> 1; kvh = combo & 1; hq = loc >> 3; qb = loc & 7; seq_row0 = s * SP; seqlen = SP; }
            } else {
                const int u = i * G + bx; if (u >= 2048) break;
                if (u < 1024) { const int combo = u >> 7, idx = u & 127; const int s = combo >> 1; kvh = combo & 1; hq = idx >> 5; qb = idx & 31; seq_row0 = NPROMPT + s * SS; seqlen = SS; }
                else { const int u2 = u - 1024; const int combo = u2 >> 5, idx = u2 & 31; const int s = combo >> 1; kvh = combo & 1; hq = idx >> 3; qb = idx & 7; seq_row0 = s * SP; seqlen = SP; }
            }
            const int h = kvh * 4 + hq; const long r0 = (long)seq_row0 + qb * 256;
            attn::attn_dense_body(QB + r0 * 1024 + h * 128, (const attn::bf16*)(KVB + (long)seq_row0 * 512 + kvh * 128), (const attn::bf16*)(KVB + (long)seq_row0 * 512 + 256 + kvh * 128),
                                  GA + r0 * 1024 + h * 128, MG + r0 * 2048 + h * 128, SSQA + r0 * 8 + h, q_norm_w, TAB, qb * 256, seqlen, (char*)lds + RING_OFF);
        }
        if (BOTH(3)) GRID_BAR();
    }

    if (IN(4)) {
        pg8::Gemm g{AG, BTM, KA, KA, KA, (size_t)NCHUNK * KA, (size_t)1024 * KA}; pg8::BatchOrder S; S.init(NG, 4, 4, G, vcu);
        pg8::EpiSsm E{AG, d_skip, YB};
        pg8::gemm_phase<pg8::EpiSsm, pg8::BatchOrder, true, true>(L + RING_OFF, g, S, E);
        if (BOTH(4)) GRID_BAR();
    }

    if (IN(5)) {
        pg8::Gemm g{YB, WGLUT, 1024, 1024, 1024, 0, 0}; pg8::StaticOrder S; S.init(NTOK, 1024, G, bx);
        pg8::EpiGlu E{YB, GS, MG, SSQS};
        pg8::gemm_phase<pg8::EpiGlu, pg8::StaticOrder, true, true>(L + RING_OFF, g, S, E);
        if (BOTH(5)) GRID_BAR();
    }

    if (IN(6)) {
        for (int r = (vcu * NWAVES * 64) + tid; r < NTOK; r += G * NWAVES * 64) {
            const f32x4 a0 = *(const f32x4*)(SSQA + (size_t)r * 8), a1 = *(const f32x4*)(SSQA + (size_t)r * 8 + 4);
            const float sa = ((a0[0] + a0[1]) + (a0[2] + a0[3])) + ((a1[0] + a1[1]) + (a1[2] + a1[3]));
            float sb = 0.f;
#pragma unroll
            for (int q = 0; q < 4; ++q) { const f32x4 b = *(const f32x4*)(SSQS + (size_t)r * 16 + 4 * q); sb += (b[0] + b[1]) + (b[2] + b[3]); }
            const float ra = 1.0f / sqrtf(sa * (1.0f / 1024.0f) + EPS), rsv = 1.0f / sqrtf(sb * (1.0f / 1024.0f) + EPS);
            RATIO[r] = ra / rsv; RSN[r] = rsv;
        }
        if (BOTH(6)) GRID_BAR();
    }

    if (IN(7)) {
        pg8::Gemm g{MG, WOUTT, 2048, 2048, 2048, 0, 0}; pg8::StaticOrder S; S.init(NTOK, DM, G, bx);
        pg8::EpiOut E{x_p, x_s, args.out, RATIO, RSN};
        pg8::gemm_phase<pg8::EpiOut, pg8::StaticOrder, true, true>(L + RING_OFF, g, S, E);
    }
#undef IN
#undef BOTH
#undef GRID_BAR
}

extern "C" void kernel_launch(void* const* d_in, const int* in_sizes, int n_in, void* d_out, int out_size, void* d_ws, size_t ws_size, hipStream_t stream) {
    static int grid = 0;
    if (grid == 0) {
        if (n_in != 18 || out_size != NTOK * DM || ws_size < WS_NEED) { fprintf(stderr, "kernel_launch: unexpected shapes (n_in %d out %d ws %zu)\n", n_in, out_size, ws_size); grid = -1; return; }
        int dev = 0, cus = 0, per_cu = 0;
        if (hipGetDevice(&dev) != hipSuccess || hipDeviceGetAttribute(&cus, hipDeviceAttributeMultiprocessorCount, dev) != hipSuccess) { grid = -1; return; }
        if (hipFuncSetAttribute((const void*)enc_fwd, hipFuncAttributeMaxDynamicSharedMemorySize, LDS_BYTES) != hipSuccess) { fprintf(stderr, "kernel_launch: hipFuncSetAttribute failed\n"); grid = -1; return; }
        if (hipOccupancyMaxActiveBlocksPerMultiprocessor(&per_cu, (const void*)enc_fwd, NWAVES * 64, LDS_BYTES) != hipSuccess || per_cu < 1) { fprintf(stderr, "kernel_launch: occupancy query says %d\n", per_cu); }
        (void)hipGetLastError();
        grid = cus;
    }
    if (grid < 0) return;
    (void)hipMemsetAsync((char*)d_ws + WS_CTL, 0, CTL_ZERO_BYTES, stream);
    Args a{};
    for (int i = 0; i < 18; ++i) a.in[i] = (const float*)d_in[i];
    a.out = (float*)d_out; a.ws = (unsigned char*)d_ws;
    for (int li = 0; li < N_LAUNCHES; ++li) {
        a.ph_lo = (N_LAUNCHES == NPH) ? li : 0; a.ph_hi = (N_LAUNCHES == NPH) ? li + 1 : NPH; a.li = (N_LAUNCHES == NPH) ? 0 : li;
        hipLaunchKernelGGL(enc_fwd, dim3(grid), dim3(NWAVES * 64), LDS_BYTES, stream, a);
    }
}
```

```cpp
#include <hip/hip_runtime.h>
#include <hip/hip_bf16.h>
#include <cstdio>
#include <cstdint>
#include <cmath>

#ifndef MK_N_LAUNCHES
#define MK_N_LAUNCHES 1
#endif
constexpr int NPH = 8;
constexpr int N_LAUNCHES = MK_N_LAUNCHES;

constexpr int DM = 2048, NTOK = 65536, NPROMPT = 32768, SP = 2048, SS = 8192;
constexpr int INC = 4608;
constexpr int NG = 64, NPST = 64, NCH = 16, CT = 64, NCHUNK = NTOK / CT;
constexpr int KA = CT * NCH + 4 * NPST;
constexpr float EPS = 1e-6f;

#define GAS __attribute__((address_space(1)))
#define LAS __attribute__((address_space(3)))
typedef unsigned short bf16_t;
typedef short bf16x8 __attribute__((ext_vector_type(8)));
typedef float f32x4 __attribute__((ext_vector_type(4)));
typedef float f32x2 __attribute__((ext_vector_type(2)));
typedef unsigned u32x4 __attribute__((ext_vector_type(4)));
typedef unsigned u32x2 __attribute__((ext_vector_type(2)));
typedef GAS unsigned gu32;

__device__ __forceinline__ unsigned cvt_pk_bf16(float lo, float hi) { unsigned r; asm volatile("v_cvt_pk_bf16_f32 %0, %1, %2" : "=v"(r) : "v"(lo), "v"(hi)); return r; }
__device__ __forceinline__ float bf2f(unsigned short b) { return __uint_as_float(((unsigned)b) << 16); }
__device__ __forceinline__ float bflo(unsigned w) { return __uint_as_float(w << 16); }
__device__ __forceinline__ float bfhi(unsigned w) { return __uint_as_float(w & 0xffff0000u); }
__device__ __forceinline__ float fast_sigmoid(float x) { return __builtin_amdgcn_rcpf(1.0f + __builtin_amdgcn_exp2f(-1.4426950408889634f * x)); }
__device__ __forceinline__ float silu_f(float x) { return x * fast_sigmoid(x); }
__device__ __forceinline__ float gelu_tanh(float x) { const float z = 0.7978845608028654f * (x + 0.044715f * x * x * x); return x * fast_sigmoid(2.0f * z); }

__device__ __forceinline__ int fresh_lane() { int l; asm volatile("v_mbcnt_lo_u32_b32 %0, -1, 0\n\tv_mbcnt_hi_u32_b32 %0, -1, %0" : "=v"(l)); return l; }

namespace pg8 {
#define PG8_LAS __attribute__((address_space(3)))
constexpr int BM = 256, BK = 64, HALF = 128, HTB = HALF * BK * 2, STAGE_BYTES = 8 * HTB, NXCD = 8, WGM = 8;
__host__ __device__ __forceinline__ int lds_byte(int r, int c) { const int st = (r >> 4) * 2 + (c >> 5), rr = r & 15, cc = c & 31, ob = rr * 64 + cc * 2; return st * 1024 + (ob ^ (((ob >> 9) & 1) << 5)); }
__host__ __device__ __forceinline__ void stage_rc(int b, int& R, int& C) { const int st = b / 1024, sb = b % 1024, swz = sb ^ (((sb >> 9) & 1) << 5); R = (st >> 1) * 16 + swz / 64; C = (st & 1) * 32 + (swz % 64) / 2; }
__host__ __device__ __forceinline__ int perm32(int rho) { const int n = rho >> 4, i = rho & 15; return 8 * (i >> 2) + 4 * n + (i & 3); }

struct Unit { int pm, pn, g; };
struct Gemm { const bf16_t* A; const bf16_t* Bt; int lda, ldb, K; size_t gsA, gsB; };

struct StaticOrder {
    int nM, nN, nwg, G, c, rep;
    __host__ __device__ void init(int M, int N, int G_, int c_, int rep_ = 1) { nM = M / BM; nN = N / BM; nwg = nM * nN; G = G_; c = c_; rep = rep_; }
    __host__ __device__ bool next(int i, Unit& u) const {
        if (rep > 1) { const int rounds = (nwg + G - 1) / G; if (i >= rounds * rep) return false; i = i % rounds; }
        const long L = (long)i * G + c; if (L >= nwg) return false;
        int wgid = (int)L; { const int q = nwg / NXCD, r = nwg % NXCD, xcd = wgid % NXCD, off = wgid / NXCD; wgid = (xcd < r ? xcd * (q + 1) : r * (q + 1) + (xcd - r) * q) + off; }
        const int nig = WGM * nN, gid = wgid / nig, fm = gid * WGM, gsz = (nM - fm) < WGM ? (nM - fm) : WGM;
        u.pm = fm + ((wgid % nig) % gsz); u.pn = (wgid % nig) / gsz; u.g = 0; return true;
    }
};
struct BatchOrder {
    int nPm, nPn, ntot, G, vcu, rep;
    __host__ __device__ void init(int nb, int nPm_, int nPn_, int G_, int vcu_, int rep_ = 1) { nPm = nPm_; nPn = nPn_; ntot = nb * nPm_ * nPn_; G = G_; vcu = vcu_; rep = rep_; }
    __host__ __device__ bool next(int i, Unit& u) const {
        if (rep > 1) { const int rounds = (ntot + G - 1) / G; if (i >= rounds * rep) return false; i = i % rounds; }
        const long L = (long)i * G + vcu; if (L >= ntot) return false;
        const int per = nPm * nPn, l = (int)L; u.g = l / per; const int t = l % per; u.pm = t / nPn; u.pn = t % nPn; return true;
    }
};

template <class Epi, class Sched, bool ALIGN_EPI = false, bool SP2 = true>
__device__ __forceinline__ void gemm_phase(PG8_LAS unsigned char* lds, const Gemm g, const Sched& S, const Epi& E, int wave_s) {
    const int wid = wave_s, lane = fresh_lane(), tid = wid * 64 + lane, wr = wid >> 2, wc = wid & 3, fr = lane & 15, fq = lane >> 4;
    const int K = g.K, nt = K / BK;
    unsigned voffA[2], voffB[2];
#pragma unroll
    for (int i = 0; i < 2; ++i) { int R, C; stage_rc(tid * 16 + i * 8192, R, C); const int Rb = Epi::PERM ? ((R & ~31) + perm32(R & 31)) : R;
        voffA[i] = (unsigned)(R * g.lda + C) * 2u; voffB[i] = (unsigned)(Rb * g.ldb + C) * 2u; }
    const size_t kstep = (size_t)(BK * 2);
    const size_t hstepA = (size_t)HALF * g.lda * 2, hstepB = (size_t)HALF * g.ldb * 2;
    const size_t tstepA = 2 * hstepA, tstepB = 2 * hstepB;
    const unsigned ldsw = (unsigned)wid * 1024u;
    const int aoff = lds_byte(wr * 64 + fr, fq * 8), boff = lds_byte(wc * 32 + fr, fq * 8);
#define PG8_SA(b, h) (((b) * 2 + (h)) * HTB)
#define PG8_SB(b, h) ((4 + (b) * 2 + (h)) * HTB)
#define PG8_STAGE(bufoff, gbase, voff) do { _Pragma("unroll") for (int _i = 0; _i < 2; ++_i) \
        __builtin_amdgcn_global_load_lds((const unsigned*)((const char*)(gbase) + (voff)[_i]), (PG8_LAS unsigned*)(lds + (bufoff) + ldsw + _i * 8192), 16, 0, 0); } while (0)
#define PG8_LDA(dst, b, h) do { _Pragma("unroll") for (int m = 0; m < 4; ++m) _Pragma("unroll") for (int k = 0; k < 2; ++k) dst[m][k] = *(const PG8_LAS bf16x8*)(lds + PG8_SA(b, h) + aoff + m * 2048 + k * 1024); } while (0)
#define PG8_LDB(dst, b, h) do { _Pragma("unroll") for (int n = 0; n < 2; ++n) _Pragma("unroll") for (int k = 0; k < 2; ++k) dst[n][k] = *(const PG8_LAS bf16x8*)(lds + PG8_SB(b, h) + boff + n * 2048 + k * 1024); } while (0)
#define PG8_MMA(ai, bj, At, Bt) do { __builtin_amdgcn_s_setprio(1); _Pragma("unroll") for (int m = 0; m < 4; ++m) _Pragma("unroll") for (int n = 0; n < 2; ++n) _Pragma("unroll") for (int k = 0; k < 2; ++k) \
        acc[ai][bj][m][n] = __builtin_amdgcn_mfma_f32_16x16x32_bf16(Bt[n][k], At[m][k], acc[ai][bj][m][n], 0, 0, 0); __builtin_amdgcn_s_setprio(0); } while (0)
#define PG8_WAIT_V(n) asm volatile("s_waitcnt vmcnt(" #n ")" ::: "memory")
#define PG8_WAIT_L(n) asm volatile("s_waitcnt lgkmcnt(" #n ")" ::: "memory")
#define PG8_BAR __builtin_amdgcn_s_barrier()
#define PG8_SCHED __builtin_amdgcn_sched_barrier(0)
    Unit cur, nxt; int ui = 0;
    if (!S.next(0, cur)) return;
    f32x4 acc[2][2][4][2];
#pragma unroll
    for (int a = 0; a < 2; ++a)
#pragma unroll
        for (int b = 0; b < 2; ++b)
#pragma unroll
            for (int m = 0; m < 4; ++m)
#pragma unroll
                for (int n = 0; n < 2; ++n) acc[a][b][m][n] = (f32x4){0.f, 0.f, 0.f, 0.f};
    bf16x8 At[4][2], B0[2][2], B1[2][2];
    const char* cA = (const char*)(g.A + (size_t)cur.g * g.gsA) + (size_t)cur.pm * tstepA; const char* cB = (const char*)(g.Bt + (size_t)cur.g * g.gsB) + (size_t)cur.pn * tstepB;
    static_assert(SP2, "only the SP2 loop is kept in this file");
    PG8_STAGE(PG8_SB(0, 0), cB, voffB); PG8_STAGE(PG8_SB(0, 1), cB + hstepB, voffB); PG8_STAGE(PG8_SA(0, 0), cA, voffA); PG8_STAGE(PG8_SA(0, 1), cA + hstepA, voffA);
    if (wr == 1) PG8_BAR;
    PG8_WAIT_V(2); PG8_BAR;
    PG8_STAGE(PG8_SB(1, 0), cB + kstep, voffB); PG8_STAGE(PG8_SA(1, 0), cA + kstep, voffA); PG8_STAGE(PG8_SB(1, 1), cB + hstepB + kstep, voffB);
    PG8_WAIT_V(6); PG8_BAR;
    for (;;) {
        const bool has_next = S.next(ui + 1, nxt);
        const char* nA = has_next ? (const char*)(g.A + (size_t)nxt.g * g.gsA) + (size_t)nxt.pm * tstepA : cA;
        const char* nB = has_next ? (const char*)(g.Bt + (size_t)nxt.g * g.gsB) + (size_t)nxt.pn * tstepB : cB;
        for (int t = 0; t < nt; t += 2) {
            const bool last = (t == nt - 2);
            const char* a1 = cA + (size_t)(t + 1) * kstep;
            const char* a2 = last ? nA : cA + (size_t)(t + 2) * kstep; const char* b2 = last ? nB : cB + (size_t)(t + 2) * kstep;
            const char* a3 = a2 + kstep; const char* b3 = b2 + kstep;
            if constexpr (Epi::MIDK) { if (t == (nt >> 1)) E.midk(acc, cur, wr, wc, fr, fq); }
            PG8_LDB(B0, 0, 0); PG8_LDB(B1, 0, 1); PG8_SCHED; PG8_LDA(At, 0, 0); PG8_STAGE(PG8_SA(1, 1), a1 + hstepA, voffA);
            PG8_WAIT_V(8); PG8_WAIT_L(0); PG8_BAR; PG8_MMA(0, 0, At, B0); PG8_MMA(0, 1, At, B1); PG8_BAR; PG8_SCHED;
            PG8_LDA(At, 0, 1); PG8_STAGE(PG8_SB(0, 0), b2, voffB); PG8_STAGE(PG8_SB(0, 1), b2 + hstepB, voffB); PG8_STAGE(PG8_SA(0, 0), a2, voffA);
            PG8_WAIT_V(8); PG8_WAIT_L(0); PG8_BAR; PG8_MMA(1, 0, At, B0); PG8_MMA(1, 1, At, B1); PG8_BAR; PG8_SCHED;
            PG8_LDB(B0, 1, 0); PG8_LDB(B1, 1, 1); PG8_SCHED; PG8_LDA(At, 1, 0); PG8_STAGE(PG8_SA(0, 1), a2 + hstepA, voffA);
            PG8_WAIT_V(8); PG8_WAIT_L(0); PG8_BAR; PG8_MMA(0, 0, At, B0); PG8_MMA(0, 1, At, B1); PG8_BAR; PG8_SCHED;
            PG8_LDA(At, 1, 1); PG8_STAGE(PG8_SB(1, 0), b3, voffB); PG8_STAGE(PG8_SB(1, 1), b3 + hstepB, voffB); PG8_STAGE(PG8_SA(1, 0), a3, voffA);
            PG8_WAIT_V(8); PG8_WAIT_L(0); PG8_BAR; PG8_MMA(1, 0, At, B0); PG8_MMA(1, 1, At, B1); PG8_BAR; PG8_SCHED;
        }
        if constexpr (ALIGN_EPI) { if (wr == 0) PG8_BAR; }
        E(acc, cur, wr, wc, fr, fq);
#if defined(EPI_REP_PROBE)
        if (Epi::PROBE_ID == EPI_REP_PROBE) { asm volatile("" ::: "memory"); E(acc, cur, wr, wc, fr, fq); }
#endif
        if (!has_next) break;
#pragma unroll
        for (int a = 0; a < 2; ++a)
#pragma unroll
            for (int b = 0; b < 2; ++b)
#pragma unroll
                for (int m = 0; m < 4; ++m)
#pragma unroll
                    for (int n = 0; n < 2; ++n) acc[a][b][m][n] = (f32x4){0.f, 0.f, 0.f, 0.f};
        cur = nxt; cA = nA; cB = nB; ++ui;
        if constexpr (ALIGN_EPI) { if (wr == 1) PG8_BAR; }
    }
    PG8_WAIT_V(0);
    if constexpr (!ALIGN_EPI) { if (wr == 0) PG8_BAR; }
    PG8_BAR;
#undef PG8_SA
#undef PG8_SB
#undef PG8_STAGE
#undef PG8_LDA
#undef PG8_LDB
#undef PG8_MMA
#undef PG8_WAIT_V
#undef PG8_WAIT_L
#undef PG8_BAR
#undef PG8_SCHED
}

__device__ __forceinline__ u32x4 pack8(const f32x4 v0, const f32x4 v1) { u32x4 w; w.x = cvt_pk_bf16(v0[0], v0[1]); w.y = cvt_pk_bf16(v0[2], v0[3]); w.z = cvt_pk_bf16(v1[0], v1[1]); w.w = cvt_pk_bf16(v1[2], v1[3]); return w; }

struct EpiInProj {
    static constexpr int PROBE_ID = 1;
    static constexpr bool PERM = true, MIDK = false;
    const float* rs; bf16_t *Q, *KV, *GA, *GS, *AG;
    __device__ __forceinline__ void operator()(const f32x4 (&acc)[2][2][4][2], const Unit& u, int wr, int wc, int fr, int fq) const {
        const int pn = u.pn; const int row0 = u.pm * BM + wr * 64 + fr; const int colt = pn * BM + wc * 32 + 8 * fq;
        int kind = 0, ld = 1024, cb = colt; bf16_t* base = Q;
        if (pn >= 4 && pn < 6) { base = KV; ld = 512; cb = colt - 1024; }
        else if (pn >= 6 && pn < 10) { base = GA; cb = colt - 1536; kind = 1; }
        else if (pn >= 10 && pn < 14) { base = AG; cb = colt - 2560; kind = 2; }
        else if (pn >= 14) { base = GS; cb = colt - 3584; kind = 1; }
#pragma unroll
        for (int ai = 0; ai < 2; ++ai)
#pragma unroll
            for (int m = 0; m < 4; ++m) { const int r = row0 + ai * HALF + m * 16; const float s = rs[r];
#pragma unroll
                for (int bj = 0; bj < 2; ++bj) { f32x4 v0 = acc[ai][bj][m][0] * s, v1 = acc[ai][bj][m][1] * s;
                    if (kind == 1) {
#pragma unroll
                        for (int e = 0; e < 4; ++e) { v0[e] = silu_f(v0[e]); v1[e] = silu_f(v1[e]); } }
                    const int c = cb + bj * HALF; size_t off;
                    if (kind == 2) off = ((size_t)((c >> 4) * NCHUNK + (r >> 6))) * KA + (size_t)((r & 63) * 16 + (c & 15));
                    else off = (size_t)r * ld + c;
                    *(u32x4*)(base + off) = pack8(v0, v1); } }
    }
};
struct EpiLR {
    static constexpr int PROBE_ID = 2;
    static constexpr bool PERM = false, MIDK = false;
    float* LR;
    __device__ __forceinline__ void operator()(const f32x4 (&acc)[2][2][4][2], const Unit& u, int wr, int wc, int fr, int fq) const {
        const int row0 = u.pm * BM + wr * 64 + fr, col0 = wc * 32 + 4 * fq;
#pragma unroll
        for (int ai = 0; ai < 2; ++ai)
#pragma unroll
            for (int m = 0; m < 4; ++m) { float* rowp = LR + ((size_t)u.g * NCHUNK + row0 + ai * HALF + m * 16) * 256 + col0;
#pragma unroll
                for (int bj = 0; bj < 2; ++bj)
#pragma unroll
                    for (int n = 0; n < 2; ++n) *(f32x4*)(rowp + bj * HALF + n * 16) = acc[ai][bj][m][n]; }
    }
};
struct EpiSsm {
    static constexpr int PROBE_ID = 4;
    static constexpr bool PERM = true, MIDK = false;
    const bf16_t* AG; const float* dskip; bf16_t* Y;
    __device__ __forceinline__ void operator()(const f32x4 (&acc)[2][2][4][2], const Unit& u, int wr, int wc, int fr, int fq) const {
        const int ch0 = u.pm * BM + wr * 64 + fr, n00 = u.pn * BM + wc * 32 + 8 * fq; const int g = u.g;
        const int co0 = n00 & 15;
        const f32x4 d0 = *(const f32x4*)(dskip + g * 16 + co0), d1 = *(const f32x4*)(dskip + g * 16 + co0 + 4);
#pragma unroll
        for (int ai = 0; ai < 2; ++ai)
#pragma unroll
            for (int m = 0; m < 4; ++m) { const int ch = ch0 + ai * HALF + m * 16;
#pragma unroll
                for (int bj = 0; bj < 2; ++bj) { const int n0 = n00 + bj * HALF, j = n0 >> 4;
                    const u32x4 uw = *(const u32x4*)(AG + ((size_t)g * NCHUNK + ch) * KA + n0);
                    f32x4 v0 = acc[ai][bj][m][0], v1 = acc[ai][bj][m][1];
                    v0[0] += d0[0] * bflo(uw.x); v0[1] += d0[1] * bfhi(uw.x); v0[2] += d0[2] * bflo(uw.y); v0[3] += d0[3] * bfhi(uw.y);
                    v1[0] += d1[0] * bflo(uw.z); v1[1] += d1[1] * bfhi(uw.z); v1[2] += d1[2] * bflo(uw.w); v1[3] += d1[3] * bfhi(uw.w);
#pragma unroll
                    for (int e = 0; e < 4; ++e) { v0[e] = gelu_tanh(v0[e]); v1[e] = gelu_tanh(v1[e]); }
                    *(u32x4*)(Y + ((size_t)ch * CT + j) * 1024 + g * 16 + co0) = pack8(v0, v1); } }
    }
};
struct EpiGlu {
    static constexpr int PROBE_ID = 5;
    static constexpr bool PERM = true, MIDK = false;
    const bf16_t* Y; const bf16_t* GS; bf16_t* MG; float* SSQS;
    __device__ __forceinline__ void operator()(const f32x4 (&acc)[2][2][4][2], const Unit& u, int wr, int wc, int fr, int fq) const {
        const int row0 = u.pm * BM + wr * 64 + fr, c00 = u.pn * BM + wc * 32 + 8 * fq;
#pragma unroll
        for (int ai = 0; ai < 2; ++ai)
#pragma unroll
            for (int m = 0; m < 4; ++m) { const int r = row0 + ai * HALF + m * 16; float ss = 0.f;
#pragma unroll
                for (int bj = 0; bj < 2; ++bj) { const int c = c00 + bj * HALF;
                    const u32x4 yw = *(const u32x4*)(Y + (size_t)r * 1024 + c), gw = *(const u32x4*)(GS + (size_t)r * 1024 + c);
                    const f32x4 a0 = acc[ai][bj][m][0], a1 = acc[ai][bj][m][1]; f32x4 v0, v1;
                    v0[0] = bflo(yw.x) * fast_sigmoid(a0[0]) * bflo(gw.x); v0[1] = bfhi(yw.x) * fast_sigmoid(a0[1]) * bfhi(gw.x);
                    v0[2] = bflo(yw.y) * fast_sigmoid(a0[2]) * bflo(gw.y); v0[3] = bfhi(yw.y) * fast_sigmoid(a0[3]) * bfhi(gw.y);
                    v1[0] = bflo(yw.z) * fast_sigmoid(a1[0]) * bflo(gw.z); v1[1] = bfhi(yw.z) * fast_sigmoid(a1[1]) * bfhi(gw.z);
                    v1[2] = bflo(yw.w) * fast_sigmoid(a1[2]) * bflo(gw.w); v1[3] = bfhi(yw.w) * fast_sigmoid(a1[3]) * bfhi(gw.w);
#pragma unroll
                    for (int e = 0; e < 4; ++e) ss += v0[e] * v0[e] + v1[e] * v1[e];
                    *(u32x4*)(MG + (size_t)r * 2048 + 1024 + c) = pack8(v0, v1); }
                ss += __shfl_xor(ss, 16); ss += __shfl_xor(ss, 32);
                if (fq == 0) SSQS[(size_t)r * 16 + u.pn * 4 + wc] = ss; }
    }
};
struct EpiOut {
    static constexpr int PROBE_ID = 7;
    static constexpr bool PERM = false, MIDK = true;
    const float* xp; const float* xs; float* out; const float* ratio; const float* rsn;
    __device__ __forceinline__ void midk(f32x4 (&acc)[2][2][4][2], const Unit& u, int wr, int wc, int fr, int fq) const {
        const int row0 = u.pm * BM + wr * 64 + fr;
#pragma unroll
        for (int ai = 0; ai < 2; ++ai)
#pragma unroll
            for (int m = 0; m < 4; ++m) { const float s = ratio[row0 + ai * HALF + m * 16];
#pragma unroll
                for (int bj = 0; bj < 2; ++bj)
#pragma unroll
                    for (int n = 0; n < 2; ++n) acc[ai][bj][m][n] *= s; }
    }
    __device__ __forceinline__ void operator()(const f32x4 (&acc)[2][2][4][2], const Unit& u, int wr, int wc, int fr, int fq) const {
        const int row0 = u.pm * BM + wr * 64 + fr, col0 = u.pn * BM + wc * 32 + 4 * fq;
#pragma unroll
        for (int ai = 0; ai < 2; ++ai)
#pragma unroll
            for (int m = 0; m < 4; ++m) { const int r = row0 + ai * HALF + m * 16; const float s = rsn[r];
                const float* xr = (r < NPROMPT ? xp + (size_t)r * DM : xs + (size_t)(r - NPROMPT) * DM) + col0; float* orow = out + (size_t)r * DM + col0;
#pragma unroll
                for (int bj = 0; bj < 2; ++bj)
#pragma unroll
                    for (int n = 0; n < 2; ++n) { const f32x4 xv = *(const f32x4*)(xr + bj * HALF + n * 16); *(f32x4*)(orow + bj * HALF + n * 16) = xv + acc[ai][bj][m][n] * s; } }
    }
};
}

namespace attn {
using bf16 = __hip_bfloat16;
constexpr int D = 128, NW = 8, QBLK = 32, KVBLK = 64;
constexpr float SCALE = 0.088388347648318440f;
constexpr float THR = 8.f;
constexpr int SDEPTH = 1;
constexpr int LDQ = 1024, LDK = 512, LDO = 2048;
constexpr size_t SHM_V = KVBLK * D * 2, SHM_K = KVBLK * D * 2, SHM_ATTN = 4 * SHM_V + 4 * SHM_K;
using s16x4 = __attribute__((ext_vector_type(4))) short;
using f32x16 = __attribute__((ext_vector_type(16))) float;
#define KSWZ(row, colB) ((row) * 256 + ((colB) ^ (((row) & 15) << 4)))
#define SBAR() __builtin_amdgcn_sched_barrier(0)
__device__ __forceinline__ int crow(int r, int hi) { return (r & 3) + 8 * (r >> 2) + 4 * hi; }
__device__ __forceinline__ unsigned cvtpk(float lo, float hi) { unsigned r; asm volatile("v_cvt_pk_bf16_f32 %0, %1, %2" : "=v"(r) : "v"(lo), "v"(hi)); return r; }
template <bool SHIFT> __device__ __forceinline__ void softmax_tile(f32x16& p0, f32x16& p1, float& l_part, bf16x8& pa0, bf16x8& pa1, bf16x8& pa2, bf16x8& pa3, float msub) {
  for (int r = 0; r < 16; ++r) p0[r] = __builtin_amdgcn_exp2f(SHIFT ? p0[r] - msub : p0[r]);
  for (int r = 0; r < 16; ++r) p1[r] = __builtin_amdgcn_exp2f(SHIFT ? p1[r] - msub : p1[r]);
  float ps = 0; for (int r = 0; r < 16; ++r) ps += p0[r]; for (int r = 0; r < 16; ++r) ps += p1[r];
  l_part += ps;
#define PK4(P, BASE, OUT) do { unsigned a0 = cvtpk(P[BASE + 0], P[BASE + 1]), a1 = cvtpk(P[BASE + 2], P[BASE + 3]);   \
    unsigned b0 = cvtpk(P[BASE + 4], P[BASE + 5]), b1 = cvtpk(P[BASE + 6], P[BASE + 7]);                              \
    auto r0 = __builtin_amdgcn_permlane32_swap(a0, b0, false, false); auto r1 = __builtin_amdgcn_permlane32_swap(a1, b1, false, false); \
    u32x4 w = {r0[0], r1[0], r0[1], r1[1]}; OUT = *reinterpret_cast<bf16x8*>(&w); } while (0)
  PK4(p0, 0, pa0); PK4(p0, 8, pa1); PK4(p1, 0, pa2); PK4(p1, 8, pa3);
#undef PK4
}
__device__ __forceinline__ int v_st(int k, int c) { const int kk = (k & ~0xC) | ((k & 4) << 1) | ((k & 8) >> 1); return ((kk >> 3) * 4 + (c >> 5)) * 512 + ((kk & 7) * 32 + (c & 31)) * 2; }
__device__ __forceinline__ int v_rd_base(int lane) { return ((lane & 3) << 3) | (((lane >> 2) & 3) << 6) | (((lane >> 4) & 1) << 5) | (((lane >> 5) & 1) << 8); }
constexpr int v_rd_off(int d0, int ks, int half) { return d0 * 512 + ks * 4096 + half * 2048; }
__device__ __forceinline__ void glds16s(unsigned voff, const void* sbase, unsigned lds_dst) { unsigned keep;
  asm volatile("s_mov_b32 %0, m0\n\ts_mov_b32 m0, %3\n\ts_nop 0\n\tglobal_load_lds_dwordx4 %1, %2\n\ts_mov_b32 m0, %0" : "=&s"(keep) : "v"(voff), "s"(sbase), "s"(lds_dst) : "memory"); }
template <int OFF> __device__ __forceinline__ s16x4 tr_read(int vb) {
  s16x4 r; asm volatile("ds_read_b64_tr_b16 %0, %1 offset:%2" : "=&v"(r) : "v"(vb), "i"(OFF) : "memory"); return r;
}
template <int D0, int SO> __device__ __forceinline__ void pv_one(f32x16& od, int vb, bf16x8 pa0, bf16x8 pa1, bf16x8 pa2, bf16x8 pa3) {
  const s16x4 l0 = tr_read<SO + v_rd_off(D0, 0, 0)>(vb), h0 = tr_read<SO + v_rd_off(D0, 0, 1)>(vb), l1 = tr_read<SO + v_rd_off(D0, 1, 0)>(vb), h1 = tr_read<SO + v_rd_off(D0, 1, 1)>(vb);
  const s16x4 l2 = tr_read<SO + v_rd_off(D0, 2, 0)>(vb), h2 = tr_read<SO + v_rd_off(D0, 2, 1)>(vb), l3 = tr_read<SO + v_rd_off(D0, 3, 0)>(vb), h3 = tr_read<SO + v_rd_off(D0, 3, 1)>(vb);
  asm volatile("s_waitcnt lgkmcnt(0)" ::: "memory"); SBAR();
#define PK(L, H) (bf16x8){L[0], L[1], L[2], L[3], H[0], H[1], H[2], H[3]}
  od = __builtin_amdgcn_mfma_f32_32x32x16_bf16(pa0, PK(l0, h0), od, 0, 0, 0);
  od = __builtin_amdgcn_mfma_f32_32x32x16_bf16(pa1, PK(l1, h1), od, 0, 0, 0);
  od = __builtin_amdgcn_mfma_f32_32x32x16_bf16(pa2, PK(l2, h2), od, 0, 0, 0);
  od = __builtin_amdgcn_mfma_f32_32x32x16_bf16(pa3, PK(l3, h3), od, 0, 0, 0);
#undef PK
}
template <int SO> __device__ __forceinline__ void pv_d0(f32x16* o, int vb, bf16x8 pa0, bf16x8 pa1, bf16x8 pa2, bf16x8 pa3) {
  pv_one<0, SO>(o[0], vb, pa0, pa1, pa2, pa3); pv_one<1, SO>(o[1], vb, pa0, pa1, pa2, pa3); pv_one<2, SO>(o[2], vb, pa0, pa1, pa2, pa3); pv_one<3, SO>(o[3], vb, pa0, pa1, pa2, pa3);
}

__device__ __forceinline__ void attn_q_prologue(const bf16_t* __restrict__ Qb, const float* __restrict__ qnw, const f32x2* __restrict__ tab, float kmaxc, int pos0,
                                                int wid, int r32, int hi, bf16x8 (&qr)[8], float& mshift) {
    const bf16_t* Qw = Qb + (long)(wid * QBLK + r32) * LDQ + hi * 8;
    u32x4 raw[8]; float ss = 0.f;
#pragma unroll
    for (int d0 = 0; d0 < 8; ++d0) raw[d0] = *reinterpret_cast<const u32x4*>(Qw + d0 * 16);
#pragma unroll
    for (int d0 = 0; d0 < 8; ++d0) {
#pragma unroll
      for (int q = 0; q < 4; ++q) { const float a = bflo(raw[d0][q]), b = bfhi(raw[d0][q]); ss += a * a + b * b; } }
    { auto rr = __builtin_amdgcn_permlane32_swap(__float_as_uint(ss), __float_as_uint(ss), false, false); ss = __uint_as_float(rr[0]) + __uint_as_float(rr[1]); }
    const float rn = (SCALE * 1.4426950408889634f) / sqrtf(ss * (1.0f / 128.0f) + EPS);
    float qn2 = 0.f;
    const int pos = pos0 + wid * QBLK + r32, prow = pos >> 6, pcol = pos & 63;
#pragma unroll
    for (int pg = 0; pg < 4; ++pg) { const int dd = pg & 1, ax = pg >> 1, d0 = ax * 4 + dd;
      const f32x2* tp = tab + (ax == 0 ? prow : pcol) * 32 + hi * 8 + dd * 16;
      const float* wa = qnw + d0 * 16 + hi * 8; const float* wb = wa + 32;
      float na[8], nb[8];
#pragma unroll
      for (int q = 0; q < 4; ++q) {
        const f32x2 c0 = tp[2 * q], c1 = tp[2 * q + 1];
        const float a0 = bflo(raw[d0][q]) * (rn * wa[2 * q]), a1 = bfhi(raw[d0][q]) * (rn * wa[2 * q + 1]);
        const float b0 = bflo(raw[d0 + 2][q]) * (rn * wb[2 * q]), b1 = bfhi(raw[d0 + 2][q]) * (rn * wb[2 * q + 1]);
        na[2 * q] = a0 * c0.x - b0 * c0.y; nb[2 * q] = b0 * c0.x + a0 * c0.y;
        na[2 * q + 1] = a1 * c1.x - b1 * c1.y; nb[2 * q + 1] = b1 * c1.x + a1 * c1.y;
        qn2 += (na[2 * q] * na[2 * q] + nb[2 * q] * nb[2 * q]) + (na[2 * q + 1] * na[2 * q + 1] + nb[2 * q + 1] * nb[2 * q + 1]); }
      { u32x4 w = {cvtpk(na[0], na[1]), cvtpk(na[2], na[3]), cvtpk(na[4], na[5]), cvtpk(na[6], na[7])}; qr[d0] = *reinterpret_cast<bf16x8*>(&w); }
      { u32x4 w = {cvtpk(nb[0], nb[1]), cvtpk(nb[2], nb[3]), cvtpk(nb[4], nb[5]), cvtpk(nb[6], nb[7])}; qr[d0 + 2] = *reinterpret_cast<bf16x8*>(&w); }
      asm volatile("" ::: "memory"); }
    { auto rr = __builtin_amdgcn_permlane32_swap(__float_as_uint(qn2), __float_as_uint(qn2), false, false); qn2 = __uint_as_float(rr[0]) + __uint_as_float(rr[1]); }
    mshift = fmaxf(sqrtf(qn2) * kmaxc - 40.0f, 0.0f);
}
template <bool SHIFT>
__device__ __forceinline__ void attn_main(const bf16_t* __restrict__ Kh, const bf16_t* __restrict__ Vh, const bf16_t* __restrict__ GAb, bf16_t* __restrict__ Ob, float* __restrict__ ssq,
                                          int seq, LAS char* lds, LAS char* lscr, int wave_s, const bf16x8 (&qr)[8], float mshift) {
  const int lane = fresh_lane(), r32 = lane & 31, hi = lane >> 5;
  LAS char* const Vr = lds; LAS char* const Kr = lds + 4 * SHM_V;
  float l_reg = 0; f32x16 o[4] = {};
  unsigned ksrc[2], vsrc[2];
#pragma unroll
  for (int i = 0; i < 2; ++i) { const int p = 2 * wave_s + i;
    const int row = 4 * p + (lane >> 4), lc = (lane & 15) ^ (row & 15); ksrc[i] = (unsigned)(row * LDK + lc * 8) * 2u;
    const int st = 2 * p + (lane >> 5), q = lane & 31, kk = (st >> 2) * 8 + (q >> 2), k = (kk & ~0xC) | ((kk & 4) << 1) | ((kk & 8) >> 1), c = (st & 3) * 32 + (q & 3) * 8;
    vsrc[i] = (unsigned)(k * LDK + c) * 2u; }
  const unsigned ldsw = (unsigned)wave_s * 2048u;
  const int vb0 = (int)(uintptr_t)Vr + v_rd_base(lane);
  const LAS char* kp[8];
#pragma unroll
  for (int d0 = 0; d0 < 8; ++d0) kp[d0] = Kr + r32 * 256 + (((2 * d0 + hi) ^ (r32 & 15)) << 4);
#define DMA(T, TS) do { const char* kg = (const char*)Kh + (size_t)(T) * (KVBLK * LDK * 2); const char* vg = (const char*)Vh + (size_t)(T) * (KVBLK * LDK * 2); \
    const unsigned so = (unsigned)(uintptr_t)Vr + ((unsigned)(TS) & 3u) * (unsigned)SHM_K + ldsw; \
    glds16s(ksrc[0], kg, so + 4 * (unsigned)SHM_V); glds16s(vsrc[0], vg, so); glds16s(ksrc[1], kg, so + 4 * (unsigned)SHM_V + 1024u); glds16s(vsrc[1], vg, so + 1024u); } while (0)
#define WAITBAR(N) asm volatile("s_waitcnt vmcnt(" #N ") lgkmcnt(0)\n\ts_barrier" ::: "memory")
#define QKT(P0, P1, KSO) do { P0 = f32x16{}; P1 = f32x16{}; \
    _Pragma("unroll") for (int d0 = 0; d0 < 8; ++d0) { const LAS char* kq = kp[d0] + (KSO); \
      const bf16x8 b0 = *(const LAS bf16x8*)(kq), b1 = *(const LAS bf16x8*)(kq + 8192); \
      P0 = __builtin_amdgcn_mfma_f32_32x32x16_bf16(b0, qr[d0], P0, 0, 0, 0); P1 = __builtin_amdgcn_mfma_f32_32x32x16_bf16(b1, qr[d0], P1, 0, 0, 0); } } while (0)
#define NEXTDMA(T) do { const int t2 = (T) + 2; DMA(t2 < NT ? t2 : t2 - NT, t2); } while (0)
#define SOFT() softmax_tile<SHIFT>(p0, p1, l_reg, pa0, pa1, pa2, pa3, mshift)
#define PV(T) pv_d0<0>(o, vb0 + ((T) & 3) * (int)SHM_V, pa0, pa1, pa2, pa3)
  f32x16 p0, p1; bf16x8 pa0, pa1, pa2, pa3; const int NT = seq / KVBLK;
  DMA(0, 0); DMA(1, 1);
  if (wave_s < 4) {
    for (int j = 0; j < NT; ++j) {
      WAITBAR(4); NEXTDMA(j); SBAR();
      QKT(p0, p1, (j & 3) * (int)SHM_K); SBAR();
      SOFT(); SBAR();
      PV(j); SBAR();
    }
  } else {
    WAITBAR(4); NEXTDMA(0); SBAR();
    QKT(p0, p1, 0); SBAR();
    for (int j = 1; j < NT; ++j) {
      WAITBAR(4); NEXTDMA(j); SBAR();
      SOFT(); SBAR();
      PV(j - 1); SBAR();
      QKT(p0, p1, (j & 3) * (int)SHM_K); SBAR();
    }
    SOFT(); SBAR();
    PV(NT - 1); SBAR();
  }
  asm volatile("s_waitcnt vmcnt(0)" ::: "memory");
#undef NEXTDMA
#undef SOFT
#undef PV
  { auto rr = __builtin_amdgcn_permlane32_swap(__float_as_uint(l_reg), __float_as_uint(l_reg), false, false); l_reg = __uint_as_float(rr[0]) + __uint_as_float(rr[1]); }
  { const int le = fresh_lane(); LAS float* li_w = (LAS float*)lscr + wave_s * 64; if (le < 32) li_w[le] = l_reg; } asm volatile("s_waitcnt lgkmcnt(0)" ::: "memory");
  { const int te = fresh_lane(); const LAS float* li_l = (const LAS float*)lscr + wave_s * 64;
    const int ew = wave_s, er = te & 31, eh = (te >> 5) & 1;
    const long rbase = (long)(ew * QBLK + 4 * eh) ;
    const bf16_t* gp0 = GAb + rbase * 1024 + er; bf16_t* op0 = Ob + rbase * LDO + er;
#pragma unroll
    for (int rb = 0; rb < 4; ++rb) {
      unsigned short gv[4][4];
#pragma unroll
      for (int rr = 0; rr < 4; ++rr)
#pragma unroll
        for (int d0 = 0; d0 < 4; ++d0) gv[rr][d0] = gp0[(long)(8 * rb + rr) * 1024 + d0 * 32];
#pragma unroll
      for (int rr = 0; rr < 4; ++rr) { const int r = 4 * rb + rr, orow = 8 * rb + rr; const float rl = __builtin_amdgcn_rcpf(li_l[orow + 4 * eh]); float s2 = 0.f;
#pragma unroll
        for (int d0 = 0; d0 < 4; ++d0) { const float v = o[d0][r] * rl * bf2f(gv[rr][d0]); s2 += v * v; op0[(long)orow * LDO + d0 * 32] = (bf16_t)(cvtpk(v, v) & 0xffffu); }
        s2 += __shfl_xor(s2, 1); s2 += __shfl_xor(s2, 2); s2 += __shfl_xor(s2, 4); s2 += __shfl_xor(s2, 8); s2 += __shfl_xor(s2, 16);
        if (er == 0) ssq[(rbase + orow) * 8] = s2; } } }
#undef DMA
#undef WAITBAR
#undef QKT
}
__device__ __forceinline__ void attn_dense_body(const bf16_t* __restrict__ Qb, const bf16_t* __restrict__ Kh, const bf16_t* __restrict__ Vh,
                                                const bf16_t* __restrict__ GAb, bf16_t* __restrict__ Ob, float* __restrict__ ssq,
                                                const float* __restrict__ qnw, const f32x2* __restrict__ tab, float kwmax, int wave_s, int pos0, int seq, LAS char* lds, LAS char* lscr) {
  const int lane = fresh_lane(), wid = wave_s, r32 = lane & 31, hi = lane >> 5;
  unsigned kwb = __float_as_uint(kwmax); asm volatile("" : "+s"(kwb));
  const float kmaxc = __uint_as_float(kwb) * (11.313708498984761f * 1.01f);
  bf16x8 qr[8]; float mshift;
  attn_q_prologue(Qb, qnw, tab, kmaxc, pos0, wid, r32, hi, qr, mshift);
  if (__builtin_expect(__any(mshift > 0.0f), 0)) attn_main<true>(Kh, Vh, GAb, Ob, ssq, seq, lds, lscr, wave_s, qr, mshift);
  else attn_main<false>(Kh, Vh, GAb, Ob, ssq, seq, lds, lscr, wave_s, qr, mshift);
}
#undef KSWZ
#undef SBAR
}

constexpr size_t MiB = 1u << 20;
constexpr size_t WS_CTL = 0, CTL_ZERO_BYTES = 1 * MiB;
constexpr size_t WS_RS = 1 * MiB;
constexpr size_t WS_RATIO = 2 * MiB;
constexpr size_t WS_RSN = 3 * MiB;
constexpr size_t WS_SSQA = 4 * MiB;
constexpr size_t WS_SSQS = 6 * MiB;
constexpr size_t WS_TAB = 10 * MiB;
constexpr size_t WS_WINT = 16 * MiB;
constexpr size_t WS_WGLUT = 34 * MiB;
constexpr size_t WS_WOUTT = 36 * MiB;
constexpr size_t WS_Q = 64 * MiB;
constexpr size_t WS_KV = 192 * MiB;
constexpr size_t WS_GA = 256 * MiB;
constexpr size_t WS_GS = 384 * MiB;
constexpr size_t WS_MG = 512 * MiB;
constexpr size_t WS_Y = 768 * MiB;
constexpr size_t WS_END = 896 * MiB;
constexpr size_t OU_XB = 0;
constexpr size_t OU_BTM = 0;
constexpr size_t OU_AG = 256 * MiB;
constexpr size_t OU_WLR = 416 * MiB;
constexpr size_t OU_K0 = 448 * MiB;
constexpr size_t OU_LR = 456 * MiB;
constexpr size_t WS_LR = 896 * MiB;
constexpr size_t WS_BTM = 960 * MiB;
constexpr size_t WS_NEED = 960 * MiB;

constexpr int CW_TMO = 0, CW_BAR = 4096;

#define XB_TMO      128
#define XB_XCNT(j)  (256  + 64 * (j))
#define XB_XSUB(j)  (1280 + 64 * (j))
#define XB_XGEN(j)  (2304 + 64 * (j))
#define XB_TOP      3328
#define XB_TOPGEN   3392
#define XCD_BAR_WORDS 3456
#define XB_SPIN_CAP (1u << 20)
__device__ __forceinline__ unsigned xb_ld(unsigned* p)              { return __hip_atomic_load(p, __ATOMIC_RELAXED, __HIP_MEMORY_SCOPE_AGENT); }
__device__ __forceinline__ unsigned xb_add(unsigned* p, unsigned v) { return __hip_atomic_fetch_add(p, v, __ATOMIC_RELAXED, __HIP_MEMORY_SCOPE_AGENT); }
__device__ __forceinline__ unsigned xb_xcc_id() { return (unsigned)__builtin_amdgcn_s_getreg((3 << 11) | 20) & 0xFu; }
#define XB_SPIN(cond, bar) do { unsigned _sp = 0; while (cond) { __builtin_amdgcn_s_sleep(1); \
    if ((++_sp & 255u) == 0u) { if (xb_ld(&(bar)[XB_TMO])) break; if (_sp > XB_SPIN_CAP) { atomicAdd(&(bar)[XB_TMO], 1u); break; } } } } while (0)
struct XcdBarrier { unsigned* bar; unsigned x; volatile LAS unsigned* st; };
__device__ __forceinline__ XcdBarrier xcd_barrier_post(unsigned* bar, volatile LAS unsigned* st, bool leader) {
    XcdBarrier b; b.bar = bar; b.x = xb_xcc_id(); b.st = st;
    if (leader) (void)xb_add(&bar[XB_XCNT(b.x)], 1u);
    return b;
}
__device__ __forceinline__ void xcd_barrier_complete(unsigned* bar, unsigned x, unsigned& nloc, unsigned& nx) {
    const unsigned G = gridDim.x * gridDim.y * gridDim.z;
    unsigned sum, cnt, mine, sp = 0u;
    for (;;) {
        sum = 0u; cnt = 0u; mine = 0u;
#pragma unroll
        for (unsigned j = 0; j < 16; ++j) { const unsigned c = xb_ld(&bar[XB_XCNT(j)]); sum += c; cnt += (c > 0u) ? 1u : 0u; mine = (j == x) ? c : mine; }
        if (sum == G) break;
        __builtin_amdgcn_s_sleep(1);
        if ((++sp & 255u) == 0u) { if (xb_ld(&bar[XB_TMO])) break; if (sp > XB_SPIN_CAP) { atomicAdd(&bar[XB_TMO], 1u); break; } }
    }
    nloc = mine > 0u ? mine : 1u; nx = cnt > 0u ? cnt : 1u;
}
__device__ __forceinline__ void xcd_barrier(const XcdBarrier& b, bool leader) {
    asm volatile("s_waitcnt vmcnt(0)" ::: "memory");
    __syncthreads();
    if (leader) {
        unsigned* bar = b.bar;
        __builtin_amdgcn_s_waitcnt(0);
        unsigned nloc = b.st[0], nx = b.st[1];
        if (nloc == 0u) { xcd_barrier_complete(bar, b.x, nloc, nx); b.st[0] = nloc; b.st[1] = nx; }
        const unsigned old = xb_add(&bar[XB_XSUB(b.x)], 1u);
        const unsigned gen = old / nloc;
        if (old + 1u == (gen + 1u) * nloc) {
            __builtin_amdgcn_fence(__ATOMIC_RELEASE, "agent");
            asm volatile("s_waitcnt vmcnt(0)" ::: "memory");
            const unsigned og = xb_add(&bar[XB_TOP], 1u);
            const unsigned tg = og / nx;
            if (og + 1u == (tg + 1u) * nx) xb_add(&bar[XB_TOPGEN], 1u);
            else XB_SPIN(xb_ld(&bar[XB_TOPGEN]) == tg, bar);
            __builtin_amdgcn_fence(__ATOMIC_ACQUIRE, "agent");
            xb_add(&bar[XB_XGEN(b.x)], 1u);
            asm volatile("s_waitcnt vmcnt(0)" ::: "memory");
        } else {
            XB_SPIN(xb_ld(&bar[XB_XGEN(b.x)]) == gen, bar);
            __builtin_amdgcn_fence(__ATOMIC_ACQUIRE, "agent");
            asm volatile("s_waitcnt vmcnt(0)" ::: "memory");
        }
    }
    __syncthreads();
}

constexpr int RING_OFF = 0, RING_BYTES = 131072;
constexpr int LDSCTL_OFF = RING_BYTES, MISC_OFF = LDSCTL_OFF + 320;
constexpr int LDS_BYTES = 147456;
constexpr int NWAVES = 8;

struct Args {
    const float* in[18]; float* out; unsigned char* ws; int ph_lo, ph_hi, li, pad;
};

__device__ __forceinline__ float wave_sum(float v) {
#pragma unroll
    for (int o = 1; o < 64; o <<= 1) v += __shfl_xor(v, o);
    return v;
}
__device__ __forceinline__ void p0_transpose_item(const float* W, int K, int N, bf16_t* WT, LAS float* scr, int item, int lane, const float* ks1, const float* ks2, int ksplit) {
    const int nblk = N / 32, kb = item / nblk, nb = item % nblk, k0 = 64 * kb, n0 = 32 * nb;
#pragma unroll 8
    for (int i = 0; i < 32; ++i) { const int kk = 2 * i + (lane >> 5), k = k0 + kk; float s = 1.f; if (ks1) s = (k < ksplit) ? ks1[k] : ks2[k - ksplit];
        scr[kk * 33 + (lane & 31)] = W[(size_t)k * N + n0 + (lane & 31)] * s; }
    asm volatile("s_waitcnt lgkmcnt(0)" ::: "memory");
    const int c = lane & 7;
#pragma unroll
    for (int j = 0; j < 4; ++j) { const int n = (lane >> 3) + 8 * j; const LAS float* s = scr + (8 * c) * 33 + n;
        u32x4 o; o.x = cvt_pk_bf16(s[0 * 33], s[1 * 33]); o.y = cvt_pk_bf16(s[2 * 33], s[3 * 33]); o.z = cvt_pk_bf16(s[4 * 33], s[5 * 33]); o.w = cvt_pk_bf16(s[6 * 33], s[7 * 33]);
        *(GAS u32x4*)(WT + (size_t)(n0 + n) * K + k0 + 8 * c) = o; }
    asm volatile("s_waitcnt lgkmcnt(0)" ::: "memory");
}
__device__ __forceinline__ void ssm_disc(const float* lre, const float* lim, const float* lstep, int d, int g, int p, f32x2& lb, f32x2& bs) {
    const float lr = lre[(d * NG + g) * NPST + p], li = lim[(d * NG + g) * NPST + p], dt = expf(lstep[d * NG + g]);
    const float mag = expf(lr * dt), ang = li * dt; lb.x = mag * cosf(ang); lb.y = mag * sinf(ang);
    const float nr = lb.x - 1.0f, ni = lb.y, den = 1.0f / (lr * lr + li * li);
    bs.x = (nr * lr + ni * li) * den; bs.y = (ni * lr - nr * li) * den;
}
__device__ __forceinline__ f32x2 ssm_pow(const float* lre, const float* lim, const float* lstep, int d, int g, int p, int e) {
    const float lr = lre[(d * NG + g) * NPST + p], li = lim[(d * NG + g) * NPST + p], dt = expf(lstep[d * NG + g]);
    const float mag = expf(lr * dt * (float)e), ang = li * dt * (float)e; f32x2 r; r.x = mag * cosf(ang); r.y = mag * sinf(ang); return r;
}
__device__ __forceinline__ f32x2 cmul(f32x2 a, f32x2 b) { f32x2 r; r.x = a.x * b.x - a.y * b.y; r.y = a.x * b.y + a.y * b.x; return r; }

__global__ void __launch_bounds__(NWAVES * 64, 2) enc_fwd(Args args) {
    extern __shared__ __attribute__((aligned(16))) unsigned char lds[];
    LAS unsigned char* const L = (LAS unsigned char*)lds;
    volatile LAS unsigned* const MISC = (volatile LAS unsigned*)(L + MISC_OFF);
    const int wave = __builtin_amdgcn_readfirstlane((int)threadIdx.x >> 6);
#define LEADER() (wave == 0 && fresh_lane() == 0)
#define PHASE_IDS() const int lane = fresh_lane(); const int tid = wave * 64 + lane; (void)tid
    const int G = gridDim.x; const int bx = blockIdx.x; const int vcu = (G % 8 == 0) ? (bx % 8) * (G / 8) + bx / 8 : bx;
    unsigned char* const ws = args.ws; unsigned char* const ou = (unsigned char*)args.out;
    gu32* const ctl = (gu32*)(ws + WS_CTL);
    const float* x_p = args.in[0]; const float* x_s = args.in[1]; const float* norm_w = args.in[2]; const float* w_in = args.in[3];
    const float* q_norm_w = args.in[4]; const float* k_norm_w = args.in[5]; const float* lam_re = args.in[6]; const float* lam_im = args.in[7]; const float* log_step = args.in[8];
    const float* b_re = args.in[9]; const float* b_im = args.in[10]; const float* c_re = args.in[11]; const float* c_im = args.in[12]; const float* d_skip = args.in[13];
    const float* w_glu = args.in[14]; const float* aonw = args.in[15]; const float* sonw = args.in[16]; const float* w_out = args.in[17];
    float* const RS = (float*)(ws + WS_RS); float* const RATIO = (float*)(ws + WS_RATIO); float* const RSN = (float*)(ws + WS_RSN);
    float* const SSQA = (float*)(ws + WS_SSQA); float* const SSQS = (float*)(ws + WS_SSQS); f32x2* const TAB = (f32x2*)(ws + WS_TAB);
    bf16_t* const WINT = (bf16_t*)(ws + WS_WINT); bf16_t* const WGLUT = (bf16_t*)(ws + WS_WGLUT); bf16_t* const WOUTT = (bf16_t*)(ws + WS_WOUTT);
    bf16_t* const QB = (bf16_t*)(ws + WS_Q); bf16_t* const KVB = (bf16_t*)(ws + WS_KV); bf16_t* const GA = (bf16_t*)(ws + WS_GA); bf16_t* const GS = (bf16_t*)(ws + WS_GS);
    bf16_t* const MG = (bf16_t*)(ws + WS_MG); bf16_t* const YB = (bf16_t*)(ws + WS_Y); float* const LR = (float*)(ws + WS_LR);
    bf16_t* const XB = (bf16_t*)(ou + OU_XB); bf16_t* const BTM = (bf16_t*)(ou + OU_BTM); bf16_t* const AG = (bf16_t*)(ou + OU_AG);
    bf16_t* const WLR = (bf16_t*)(ou + OU_WLR); float* const K0T = (float*)(ou + OU_K0);

    { PHASE_IDS(); for (int u = tid; u < (LDS_BYTES - LDSCTL_OFF) / 4; u += NWAVES * 64) ((LAS unsigned*)(L + LDSCTL_OFF))[u] = 0u; }
    __syncthreads();
    XcdBarrier bar; bar.bar = (unsigned*)(ctl + CW_BAR) + args.li * XCD_BAR_WORDS; bar.x = 0; bar.st = nullptr;
    if (N_LAUNCHES != NPH) bar = xcd_barrier_post((unsigned*)(ctl + CW_BAR) + args.li * XCD_BAR_WORDS, MISC + 8, LEADER());
#define GRID_BAR() do { if (N_LAUNCHES == NPH) { if (LEADER()) __hip_atomic_store(ctl + CW_TMO, 0xBADBA0u, __ATOMIC_RELAXED, __HIP_MEMORY_SCOPE_AGENT); } else { xcd_barrier(bar, LEADER()); } } while (0)
    const int lo = args.ph_lo, hi = args.ph_hi;
#ifndef PH_ONLY
#define PH_ONLY -1
#endif
#define IN(k) ((PH_ONLY < 0 || PH_ONLY == (k)) && lo <= (k) && (k) < hi)
#define BOTH(k) (IN(k) && IN((k) + 1))
#ifndef REPMASK
#define REPMASK 0
#endif
#define REPF(k) (1 + ((REPMASK >> (k)) & 1))
#define THIN_REP(k) _Pragma("unroll") for (int rep_ = 0; rep_ < REPF(k); ++rep_)
    const int gw = vcu * NWAVES + wave, NGW = G * NWAVES;
    LAS float* const scr = (LAS float*)(L + RING_OFF + wave * 16384);

    if (IN(0)) {
        PHASE_IDS();
        THIN_REP(8) {
        {
            constexpr int I_IN = (DM / 64) * (INC / 32), I_GLU = (1024 / 64) * (1024 / 32), I_OUT = (2048 / 64) * (2048 / 32);
            for (int it = gw; it < I_IN + I_GLU + I_OUT; it += NGW) {
                int r = it;
                if (r < I_IN) { p0_transpose_item(w_in, DM, INC, WINT, scr, r, lane, norm_w, norm_w, DM); continue; } r -= I_IN;
                if (r < I_GLU) { p0_transpose_item(w_glu, 1024, 1024, WGLUT, scr, r, lane, nullptr, nullptr, 0); continue; } r -= I_GLU;
                p0_transpose_item(w_out, 2048, 2048, WOUTT, scr, r, lane, aonw, sonw, 1024);
            }
        }
        for (int i = gw * 64 + lane; i < 128 * 32; i += NGW * 64) { const int pos = i >> 5, f = i & 31;
            const float inv = 1.0f / powf(10000.0f, (float)f * (1.0f / 32.0f)); const float ang = (float)pos * inv; f32x2 cs; cs.x = cosf(ang); cs.y = sinf(ang); TAB[i] = cs; }
        for (int it = gw; it < NG * 2 * 16; it += NGW) {
            const int g = __builtin_amdgcn_readfirstlane(it >> 5), d = __builtin_amdgcn_readfirstlane((it >> 4) & 1), tb = __builtin_amdgcn_readfirstlane(it & 15);
            const int tl = lane >> 4, co = lane & 15, tau = tb * 4 + tl;
            LAS f32x2* Es = (LAS f32x2*)scr;
            LAS f32x2* Cs = (LAS f32x2*)(scr + 512);
#pragma unroll
            for (int i = 0; i < 4; ++i) { const int p = co + 16 * i; f32x2 lb, bs; ssm_disc(lam_re, lam_im, log_step, d, g, p, lb, bs); const f32x2 pw = ssm_pow(lam_re, lam_im, log_step, d, g, p, tau); Es[tl * 64 + p] = cmul(pw, bs); }
#pragma unroll
            for (int k = 0; k < 16; ++k) { f32x2 c; c.x = c_re[((size_t)(d * NG + g) * NCH + k) * NPST + lane]; c.y = c_im[((size_t)(d * NG + g) * NCH + k) * NPST + lane]; Cs[k * 65 + lane] = c; }
            asm volatile("s_waitcnt lgkmcnt(0)" ::: "memory");
            float acc[16];
#pragma unroll
            for (int ci = 0; ci < 16; ++ci) acc[ci] = 0.f;
            for (int p = 0; p < NPST; ++p) { const f32x2 ce = cmul(Cs[co * 65 + p], Es[tl * 64 + p]);
                const float* br = b_re + ((size_t)g * NPST + p) * NCH; const float* bi = b_im + ((size_t)g * NPST + p) * NCH;
#pragma unroll
                for (int ci = 0; ci < 16; ++ci) acc[ci] += ce.x * br[ci] - ce.y * bi[ci]; }
            float* dst = K0T + (((size_t)(g * 2 + d) * CT + tau) * NCH + co) * NCH;
#pragma unroll
            for (int q = 0; q < 4; ++q) *(f32x4*)(dst + 4 * q) = (f32x4){acc[4 * q], acc[4 * q + 1], acc[4 * q + 2], acc[4 * q + 3]};
            asm volatile("s_waitcnt lgkmcnt(0)" ::: "memory");
        }
        for (int it = gw; it < NG * 2; it += NGW) {
            const int g = it >> 1, d = it & 1, p = lane; f32x2 lb, bs; ssm_disc(lam_re, lam_im, log_step, d, g, p, lb, bs);
            float br[16], bi[16];
#pragma unroll
            for (int ci = 0; ci < 16; ++ci) { br[ci] = b_re[((size_t)g * NPST + p) * NCH + ci]; bi[ci] = b_im[((size_t)g * NPST + p) * NCH + ci]; }
            f32x2 w = bs;
            bf16_t* rre = WLR + ((size_t)g * 256 + d * 128 + p) * 1024; bf16_t* rim = rre + (size_t)64 * 1024;
            for (int e = 0; e < CT; ++e) { const int jp = d == 0 ? (CT - 1 - e) : e; float vr[16], vi[16];
#pragma unroll
                for (int ci = 0; ci < 16; ++ci) { vr[ci] = w.x * br[ci] - w.y * bi[ci]; vi[ci] = w.x * bi[ci] + w.y * br[ci]; }
                u32x4 o0, o1, o2, o3;
                o0.x = cvt_pk_bf16(vr[0], vr[1]); o0.y = cvt_pk_bf16(vr[2], vr[3]); o0.z = cvt_pk_bf16(vr[4], vr[5]); o0.w = cvt_pk_bf16(vr[6], vr[7]);
                o1.x = cvt_pk_bf16(vr[8], vr[9]); o1.y = cvt_pk_bf16(vr[10], vr[11]); o1.z = cvt_pk_bf16(vr[12], vr[13]); o1.w = cvt_pk_bf16(vr[14], vr[15]);
                o2.x = cvt_pk_bf16(vi[0], vi[1]); o2.y = cvt_pk_bf16(vi[2], vi[3]); o2.z = cvt_pk_bf16(vi[4], vi[5]); o2.w = cvt_pk_bf16(vi[6], vi[7]);
                o3.x = cvt_pk_bf16(vi[8], vi[9]); o3.y = cvt_pk_bf16(vi[10], vi[11]); o3.z = cvt_pk_bf16(vi[12], vi[13]); o3.w = cvt_pk_bf16(vi[14], vi[15]);
                *(u32x4*)(rre + jp * 16) = o0; *(u32x4*)(rre + jp * 16 + 8) = o1; *(u32x4*)(rim + jp * 16) = o2; *(u32x4*)(rim + jp * 16 + 8) = o3;
                w = cmul(w, lb); }
        }
        for (int m = gw * 2; m < NTOK; m += NGW * 2) {
            const float* xrow = m < NPROMPT ? x_p + (size_t)m * DM : x_s + (size_t)(m - NPROMPT) * DM;
            const f32x4* xr = (const f32x4*)xrow + lane; f32x4 v[2][8]; float s0 = 0.f, s1 = 0.f;
#pragma unroll
            for (int j = 0; j < 8; ++j) { v[0][j] = __builtin_nontemporal_load(xr + 64 * j); v[1][j] = __builtin_nontemporal_load(xr + 512 + 64 * j); }
#pragma unroll
            for (int j = 0; j < 8; ++j) { s0 += (v[0][j].x * v[0][j].x + v[0][j].y * v[0][j].y) + (v[0][j].z * v[0][j].z + v[0][j].w * v[0][j].w);
                                           s1 += (v[1][j].x * v[1][j].x + v[1][j].y * v[1][j].y) + (v[1][j].z * v[1][j].z + v[1][j].w * v[1][j].w); }
            s0 = wave_sum(s0); s1 = wave_sum(s1);
            if (lane == 0) { f32x2 r; r.x = 1.0f / sqrtf(s0 * (1.0f / DM) + EPS); r.y = 1.0f / sqrtf(s1 * (1.0f / DM) + EPS); *(f32x2*)(RS + m) = r; }
            GAS u32x2* o8 = (GAS u32x2*)(XB + (size_t)m * DM) + lane;
#pragma unroll
            for (int j = 0; j < 8; ++j) { u32x2 w; w.x = cvt_pk_bf16(v[0][j].x, v[0][j].y); w.y = cvt_pk_bf16(v[0][j].z, v[0][j].w); o8[64 * j] = w;
                                          u32x2 w1; w1.x = cvt_pk_bf16(v[1][j].x, v[1][j].y); w1.y = cvt_pk_bf16(v[1][j].z, v[1][j].w); o8[512 + 64 * j] = w1; }
        }
        }
        if (BOTH(0)) GRID_BAR();
    }

    if (IN(1)) {
        pg8::Gemm g{XB, WINT, DM, DM, DM, 0, 0}; pg8::StaticOrder S; S.init(NTOK, INC, G, bx, REPF(1));
        pg8::EpiInProj E{RS, QB, KVB, GA, GS, AG};
        pg8::gemm_phase<pg8::EpiInProj, pg8::StaticOrder, true, true>(L + RING_OFF, g, S, E, wave);
        if (BOTH(1)) GRID_BAR();
    }

    if (IN(2)) {
        PHASE_IDS();
        for (int m = gw; m < NTOK; m += NGW) {
            const int pos = m < NPROMPT ? (m & (SP - 1)) : ((m - NPROMPT) & (SS - 1)); const int prow = pos >> 6, pcol = pos & 63;
            GAS u32x2* kp = (GAS u32x2*)(KVB + (size_t)m * 512) + lane; const u32x2 w = *kp;
            float v0 = bflo(w.x), v1 = bfhi(w.x), v2 = bflo(w.y), v3 = bfhi(w.y);
            float ss = (v0 * v0 + v1 * v1) + (v2 * v2 + v3 * v3);
            ss += __shfl_xor(ss, 1); ss += __shfl_xor(ss, 2); ss += __shfl_xor(ss, 4); ss += __shfl_xor(ss, 8); ss += __shfl_xor(ss, 16);
            const float rn = 1.0f / sqrtf(ss * (1.0f / 128.0f) + EPS);
            const int dl = (lane & 31) * 4;
            const f32x4 kw = *(const f32x4*)(k_norm_w + dl);
            v0 *= rn * kw[0]; v1 *= rn * kw[1]; v2 *= rn * kw[2]; v3 *= rn * kw[3];
            const int ax = dl >> 6, half = (dl >> 5) & 1, fi = dl & 31;
            const f32x2* tp = TAB + (ax == 0 ? prow : pcol) * 32 + fi;
            const f32x2 c0 = tp[0], c1 = tp[1], c2 = tp[2], c3 = tp[3];
            const float p0 = __shfl_xor(v0, 8), p1 = __shfl_xor(v1, 8), p2 = __shfl_xor(v2, 8), p3 = __shfl_xor(v3, 8);
            float o0, o1, o2, o3;
            if (half == 0) { o0 = v0 * c0.x - p0 * c0.y; o1 = v1 * c1.x - p1 * c1.y; o2 = v2 * c2.x - p2 * c2.y; o3 = v3 * c3.x - p3 * c3.y; }
            else           { o0 = v0 * c0.x + p0 * c0.y; o1 = v1 * c1.x + p1 * c1.y; o2 = v2 * c2.x + p2 * c2.y; o3 = v3 * c3.x + p3 * c3.y; }
            u32x2 ow; ow.x = cvt_pk_bf16(o0, o1); ow.y = cvt_pk_bf16(o2, o3); *kp = ow;
        }
        THIN_REP(9) {
        for (long pc = (long)gw * 64 + lane; pc < (long)NG * 1024 * 128; pc += (long)NGW * 64) {
            const int kp8 = (int)(pc & 127), n = (int)((pc >> 7) & 1023), g = (int)(pc >> 17);
            const int j = n >> 4, co = n & 15, jp = kp8 >> 1, ci0 = (kp8 & 1) * 8;
            const int dsel = j >= jp ? 0 : 1, tau = j >= jp ? j - jp : jp - j;
            const float* src = K0T + (((size_t)(g * 2 + dsel) * CT + tau) * NCH + co) * NCH + ci0;
            f32x4 a = *(const f32x4*)src, b = *(const f32x4*)(src + 4);
            if (j == jp) { const float* s2 = K0T + (((size_t)(g * 2 + 1) * CT) * NCH + co) * NCH + ci0; a += *(const f32x4*)s2; b += *(const f32x4*)(s2 + 4); }
            *(u32x4*)(BTM + ((size_t)g * 1024 + n) * KA + kp8 * 8) = pg8::pack8(a, b);
        }
        for (int it = gw; it < NG * 2 * NCH; it += NGW) {
            const int g = it >> 5, d = (it >> 4) & 1, co = it & 15, p = lane; f32x2 lb, bs; ssm_disc(lam_re, lam_im, log_step, d, g, p, lb, bs);
            f32x2 c; c.x = c_re[((size_t)(d * NG + g) * NCH + co) * NPST + p]; c.y = c_im[((size_t)(d * NG + g) * NCH + co) * NPST + p];
            f32x2 w = cmul(c, lb);
            for (int e = 1; e <= CT; ++e) { const int j = d == 0 ? e - 1 : CT - e;
                bf16_t* dst = BTM + ((size_t)g * 1024 + j * 16 + co) * KA + 1024 + d * 128 + p;
                dst[0] = (bf16_t)(cvt_pk_bf16(w.x, w.x) & 0xffffu); dst[64] = (bf16_t)(cvt_pk_bf16(-w.y, -w.y) & 0xffffu);
                w = cmul(w, lb); }
        }
        }
        __syncthreads();
        {
            pg8::Gemm g{AG, WLR, KA, 1024, 1024, (size_t)NCHUNK * KA, (size_t)256 * 1024}; pg8::BatchOrder S; S.init(NG, 4, 1, G, vcu, REPF(2));
            pg8::EpiLR E{LR};
            pg8::gemm_phase<pg8::EpiLR, pg8::BatchOrder, true, true>(L + RING_OFF, g, S, E, wave);
        }
        if (BOTH(2)) GRID_BAR();
    }

    if (IN(3)) {
        PHASE_IDS();
        THIN_REP(10)
        for (int it = gw; it < 20 * NG * 2; it += NGW) {
            int s, rest; if (it < 4 * NG * 2) { s = 16 + it / (NG * 2); rest = it % (NG * 2); } else { const int t2 = it - 4 * NG * 2; s = t2 / (NG * 2); rest = t2 % (NG * 2); }
            const int g = rest >> 1, d = rest & 1, p = lane;
            const int c0 = s < 16 ? 32 * s : 512 + 128 * (s - 16), nc = s < 16 ? 32 : 128;
            const f32x2 lT = ssm_pow(lam_re, lam_im, log_step, d, g, p, CT);
            const float* lr = LR + ((size_t)g * NCHUNK) * 256 + d * 128 + p; bf16_t* ag = AG + ((size_t)g * NCHUNK) * KA + 1024 + d * 128 + p;
            f32x2 h; h.x = 0.f; h.y = 0.f;
            for (int cb = 0; cb < nc; cb += 8) {
                float xr[8], xi[8];
#pragma unroll
                for (int q = 0; q < 8; ++q) { const int ch = d == 0 ? c0 + cb + q : c0 + nc - 1 - (cb + q); xr[q] = lr[(size_t)ch * 256]; xi[q] = lr[(size_t)ch * 256 + 64]; }
#pragma unroll
                for (int q = 0; q < 8; ++q) { const int ch = d == 0 ? c0 + cb + q : c0 + nc - 1 - (cb + q);
                    ag[(size_t)ch * KA] = (bf16_t)(cvt_pk_bf16(h.x, h.x) & 0xffffu); ag[(size_t)ch * KA + 64] = (bf16_t)(cvt_pk_bf16(h.y, h.y) & 0xffffu);
                    h = cmul(h, lT); h.x += xr[q]; h.y += xi[q]; }
            }
        }
        __syncthreads();
        float kwmax;
        { float kw = fmaxf(fabsf(k_norm_w[lane]), fabsf(k_norm_w[lane + 64]));
#pragma unroll
          for (int o_ = 1; o_ < 64; o_ <<= 1) kw = fmaxf(kw, __shfl_xor(kw, o_));
          kwmax = __uint_as_float(__builtin_amdgcn_readfirstlane(__float_as_uint(kw))); }
        for (int i0 = 0; i0 < 2048; ++i0) {
            int seq_row0, seqlen, kvh, hq, qb; int i = i0;
            if (G == 256) {
                if (i0 >= 8 * REPF(3)) break; i = i0 & 7;
                const int xcd = vcu >> 5, loc = vcu & 31;
                if (i < 4) { const int s = xcd >> 1; kvh = xcd & 1; const int idx = loc * 4 + i; hq = idx >> 5; qb = idx & 31; seq_row0 = NPROMPT + s * SS; seqlen = SS; }
                else { const int combo = xcd * 4 + (i - 4); const int s = combo >> 1; kvh = combo & 1; hq = loc >> 3; qb = loc & 7; seq_row0 = s * SP; seqlen = SP; }
            } else {
                const int u = i * G + bx; if (u >= 2048) break;
                if (u < 1024) { const int combo = u >> 7, idx = u & 127; const int s = combo >> 1; kvh = combo & 1; hq = idx >> 5; qb = idx & 31; seq_row0 = NPROMPT + s * SS; seqlen = SS; }
                else { const int u2 = u - 1024; const int combo = u2 >> 5, idx = u2 & 31; const int s = combo >> 1; kvh = combo & 1; hq = idx >> 3; qb = idx & 7; seq_row0 = s * SP; seqlen = SP; }
            }
            const int h = kvh * 4 + hq; const long r0 = (long)seq_row0 + qb * 256;
            attn::attn_dense_body(QB + r0 * 1024 + h * 128, KVB + (long)seq_row0 * 512 + kvh * 128, KVB + (long)seq_row0 * 512 + 256 + kvh * 128,
                                  GA + r0 * 1024 + h * 128, MG + r0 * 2048 + h * 128, SSQA + r0 * 8 + h, q_norm_w, TAB, kwmax, wave, qb * 256, seqlen, (LAS char*)(L + RING_OFF), (LAS char*)(L + LDSCTL_OFF + 1024));
        }
        if (BOTH(3)) GRID_BAR();
    }

    if (IN(4)) {
        pg8::Gemm g{AG, BTM, KA, KA, KA, (size_t)NCHUNK * KA, (size_t)1024 * KA}; pg8::BatchOrder S; S.init(NG, 4, 4, G, vcu, REPF(4));
        pg8::EpiSsm E{AG, d_skip, YB};
        pg8::gemm_phase<pg8::EpiSsm, pg8::BatchOrder, true, true>(L + RING_OFF, g, S, E, wave);
        if (BOTH(4)) GRID_BAR();
    }

    if (IN(5)) {
        pg8::Gemm g{YB, WGLUT, 1024, 1024, 1024, 0, 0}; pg8::StaticOrder S; S.init(NTOK, 1024, G, bx, REPF(5));
        pg8::EpiGlu E{YB, GS, MG, SSQS};
        pg8::gemm_phase<pg8::EpiGlu, pg8::StaticOrder, true, true>(L + RING_OFF, g, S, E, wave);
        if (BOTH(5)) GRID_BAR();
    }

    if (IN(6)) {
        PHASE_IDS();
        for (int r = (vcu * NWAVES * 64) + tid; r < NTOK; r += G * NWAVES * 64) {
            const f32x4 a0 = *(const f32x4*)(SSQA + (size_t)r * 8), a1 = *(const f32x4*)(SSQA + (size_t)r * 8 + 4);
            const float sa = ((a0[0] + a0[1]) + (a0[2] + a0[3])) + ((a1[0] + a1[1]) + (a1[2] + a1[3]));
            float sb = 0.f;
#pragma unroll
            for (int q = 0; q < 4; ++q) { const f32x4 b = *(const f32x4*)(SSQS + (size_t)r * 16 + 4 * q); sb += (b[0] + b[1]) + (b[2] + b[3]); }
            const float ra = 1.0f / sqrtf(sa * (1.0f / 1024.0f) + EPS), rsv = 1.0f / sqrtf(sb * (1.0f / 1024.0f) + EPS);
            RATIO[r] = ra / rsv; RSN[r] = rsv;
        }
        if (BOTH(6)) GRID_BAR();
    }

    if (IN(7)) {
        pg8::Gemm g{MG, WOUTT, 2048, 2048, 2048, 0, 0}; pg8::StaticOrder S; S.init(NTOK, DM, G, bx, REPF(7));
        pg8::EpiOut E{x_p, x_s, args.out, RATIO, RSN};
        pg8::gemm_phase<pg8::EpiOut, pg8::StaticOrder, true, true>(L + RING_OFF, g, S, E, wave);
    }
#undef IN
#undef BOTH
#undef GRID_BAR
}

extern "C" void kernel_launch(void* const* d_in, const int* in_sizes, int n_in, void* d_out, int out_size, void* d_ws, size_t ws_size, hipStream_t stream) {
    static int grid = 0;
    if (grid == 0) {
        if (n_in != 18 || out_size != NTOK * DM || ws_size < WS_NEED) { fprintf(stderr, "kernel_launch: unexpected shapes (n_in %d out %d ws %zu)\n", n_in, out_size, ws_size); grid = -1; return; }
        int dev = 0, cus = 0, per_cu = 0;
        if (hipGetDevice(&dev) != hipSuccess || hipDeviceGetAttribute(&cus, hipDeviceAttributeMultiprocessorCount, dev) != hipSuccess) { grid = -1; return; }
        if (hipFuncSetAttribute((const void*)enc_fwd, hipFuncAttributeMaxDynamicSharedMemorySize, LDS_BYTES) != hipSuccess) { fprintf(stderr, "kernel_launch: hipFuncSetAttribute failed\n"); grid = -1; return; }
        if (hipOccupancyMaxActiveBlocksPerMultiprocessor(&per_cu, (const void*)enc_fwd, NWAVES * 64, LDS_BYTES) != hipSuccess || per_cu < 1) { fprintf(stderr, "kernel_launch: occupancy query says %d\n", per_cu); }
        (void)hipGetLastError();
        grid = cus;
    }
    if (grid < 0) return;
    (void)hipMemsetAsync((char*)d_ws + WS_CTL, 0, CTL_ZERO_BYTES, stream);
    Args a{};
    for (int i = 0; i < 18; ++i) a.in[i] = (const float*)d_in[i];
    a.out = (float*)d_out; a.ws = (unsigned char*)d_ws;
    for (int li = 0; li < N_LAUNCHES; ++li) {
        a.ph_lo = (N_LAUNCHES == NPH) ? li : 0; a.ph_hi = (N_LAUNCHES == NPH) ? li + 1 : NPH; a.li = (N_LAUNCHES == NPH) ? 0 : li;
        hipLaunchKernelGGL(enc_fwd, dim3(grid), dim3(NWAVES * 64), LDS_BYTES, stream, a);
    }
}
```

```cpp
#include <hip/hip_runtime.h>
#include <hip/hip_bf16.h>
#include <cstdio>
#include <cstdint>
#include <cmath>

#ifndef MK_N_LAUNCHES
#define MK_N_LAUNCHES 1
#endif
constexpr int NPH = 8;
constexpr int N_LAUNCHES = MK_N_LAUNCHES;

constexpr int DM = 2048, NTOK = 65536, NPROMPT = 32768, SP = 2048, SS = 8192;
constexpr int INC = 4608;
constexpr int NG = 64, NPST = 64, NCH = 16, CT = 64, NCHUNK = NTOK / CT;
constexpr int KA = CT * NCH + 4 * NPST;
constexpr float EPS = 1e-6f;

#define GAS __attribute__((address_space(1)))
#define LAS __attribute__((address_space(3)))
typedef unsigned short bf16_t;
typedef short bf16x8 __attribute__((ext_vector_type(8)));
typedef float f32x4 __attribute__((ext_vector_type(4)));
typedef float f32x2 __attribute__((ext_vector_type(2)));
typedef unsigned u32x4 __attribute__((ext_vector_type(4)));
typedef unsigned u32x2 __attribute__((ext_vector_type(2)));
typedef GAS unsigned gu32;

__device__ __forceinline__ unsigned cvt_pk_bf16(float lo, float hi) { unsigned r; asm volatile("v_cvt_pk_bf16_f32 %0, %1, %2" : "=v"(r) : "v"(lo), "v"(hi)); return r; }
__device__ __forceinline__ float bf2f(unsigned short b) { return __uint_as_float(((unsigned)b) << 16); }
__device__ __forceinline__ float bflo(unsigned w) { return __uint_as_float(w << 16); }
__device__ __forceinline__ float bfhi(unsigned w) { return __uint_as_float(w & 0xffff0000u); }
__device__ __forceinline__ float fast_sigmoid(float x) { return __builtin_amdgcn_rcpf(1.0f + __builtin_amdgcn_exp2f(-1.4426950408889634f * x)); }
__device__ __forceinline__ float silu_f(float x) { return x * fast_sigmoid(x); }
__device__ __forceinline__ float gelu_tanh(float x) { const float z = 0.7978845608028654f * (x + 0.044715f * x * x * x); return x * fast_sigmoid(2.0f * z); }

__device__ __forceinline__ int fresh_lane() { int l; asm volatile("v_mbcnt_lo_u32_b32 %0, -1, 0\n\tv_mbcnt_hi_u32_b32 %0, -1, %0" : "=v"(l)); return l; }

namespace pg8 {
#define PG8_LAS __attribute__((address_space(3)))
constexpr int BM = 256, BK = 64, HALF = 128, HTB = HALF * BK * 2, STAGE_BYTES = 8 * HTB, NXCD = 8, WGM = 8;
__host__ __device__ __forceinline__ int lds_byte(int r, int c) { const int st = (r >> 4) * 2 + (c >> 5), rr = r & 15, cc = c & 31, ob = rr * 64 + cc * 2; return st * 1024 + (ob ^ (((ob >> 9) & 1) << 5)); }
__host__ __device__ __forceinline__ void stage_rc(int b, int& R, int& C) { const int st = b / 1024, sb = b % 1024, swz = sb ^ (((sb >> 9) & 1) << 5); R = (st >> 1) * 16 + swz / 64; C = (st & 1) * 32 + (swz % 64) / 2; }
__host__ __device__ __forceinline__ int perm32(int rho) { const int n = rho >> 4, i = rho & 15; return 8 * (i >> 2) + 4 * n + (i & 3); }

struct Unit { int pm, pn, g; };
struct Gemm { const bf16_t* A; const bf16_t* Bt; int lda, ldb, K; size_t gsA, gsB; };

struct StaticOrder {
    int nM, nN, nwg, G, c, rep;
    __host__ __device__ void init(int M, int N, int G_, int c_, int rep_ = 1) { nM = M / BM; nN = N / BM; nwg = nM * nN; G = G_; c = c_; rep = rep_; }
    __host__ __device__ bool next(int i, Unit& u) const {
        if (rep > 1) { const int rounds = (nwg + G - 1) / G; if (i >= rounds * rep) return false; i = i % rounds; }
        const long L = (long)i * G + c; if (L >= nwg) return false;
        int wgid = (int)L; { const int q = nwg / NXCD, r = nwg % NXCD, xcd = wgid % NXCD, off = wgid / NXCD; wgid = (xcd < r ? xcd * (q + 1) : r * (q + 1) + (xcd - r) * q) + off; }
        const int nig = WGM * nN, gid = wgid / nig, fm = gid * WGM, gsz = (nM - fm) < WGM ? (nM - fm) : WGM;
        u.pm = fm + ((wgid % nig) % gsz); u.pn = (wgid % nig) / gsz; u.g = 0; return true;
    }
};
struct BatchOrder {
    int nPm, nPn, ntot, G, vcu, rep;
    __host__ __device__ void init(int nb, int nPm_, int nPn_, int G_, int vcu_, int rep_ = 1) { nPm = nPm_; nPn = nPn_; ntot = nb * nPm_ * nPn_; G = G_; vcu = vcu_; rep = rep_; }
    __host__ __device__ bool next(int i, Unit& u) const {
        if (rep > 1) { const int rounds = (ntot + G - 1) / G; if (i >= rounds * rep) return false; i = i % rounds; }
        const long L = (long)i * G + vcu; if (L >= ntot) return false;
        const int per = nPm * nPn, l = (int)L; u.g = l / per; const int t = l % per; u.pm = t / nPn; u.pn = t % nPn; return true;
    }
};

template <class Epi, class Sched, bool ALIGN_EPI = false, bool SP2 = true>
__device__ __forceinline__ void gemm_phase(PG8_LAS unsigned char* lds, const Gemm g, const Sched& S, const Epi& E, int wave_s) {
    const int wid = wave_s, lane = fresh_lane(), tid = wid * 64 + lane, wr = wid >> 2, wc = wid & 3, fr = lane & 15, fq = lane >> 4;
    const int K = g.K, nt = K / BK;
    unsigned voffA[2], voffB[2];
#pragma unroll
    for (int i = 0; i < 2; ++i) { int R, C; stage_rc(tid * 16 + i * 8192, R, C); const int Rb = Epi::PERM ? ((R & ~31) + perm32(R & 31)) : R;
        voffA[i] = (unsigned)(R * g.lda + C) * 2u; voffB[i] = (unsigned)(Rb * g.ldb + C) * 2u; }
    const size_t kstep = (size_t)(BK * 2);
    const size_t hstepA = (size_t)HALF * g.lda * 2, hstepB = (size_t)HALF * g.ldb * 2;
    const size_t tstepA = 2 * hstepA, tstepB = 2 * hstepB;
    const unsigned ldsw = (unsigned)wid * 1024u;
    const int aoff = lds_byte(wr * 64 + fr, fq * 8), boff = lds_byte(wc * 32 + fr, fq * 8);
#define PG8_SA(b, h) (((b) * 2 + (h)) * HTB)
#define PG8_SB(b, h) ((4 + (b) * 2 + (h)) * HTB)
#define PG8_STAGE(bufoff, gbase, voff) do { _Pragma("unroll") for (int _i = 0; _i < 2; ++_i) \
        __builtin_amdgcn_global_load_lds((const unsigned*)((const char*)(gbase) + (voff)[_i]), (PG8_LAS unsigned*)(lds + (bufoff) + ldsw + _i * 8192), 16, 0, 0); } while (0)
#define PG8_LDA(dst, b, h) do { _Pragma("unroll") for (int m = 0; m < 4; ++m) _Pragma("unroll") for (int k = 0; k < 2; ++k) dst[m][k] = *(const PG8_LAS bf16x8*)(lds + PG8_SA(b, h) + aoff + m * 2048 + k * 1024); } while (0)
#define PG8_LDB(dst, b, h) do { _Pragma("unroll") for (int n = 0; n < 2; ++n) _Pragma("unroll") for (int k = 0; k < 2; ++k) dst[n][k] = *(const PG8_LAS bf16x8*)(lds + PG8_SB(b, h) + boff + n * 2048 + k * 1024); } while (0)
#define PG8_MMA(ai, bj, At, Bt) do { __builtin_amdgcn_s_setprio(1); _Pragma("unroll") for (int m = 0; m < 4; ++m) _Pragma("unroll") for (int n = 0; n < 2; ++n) _Pragma("unroll") for (int k = 0; k < 2; ++k) \
        acc[ai][bj][m][n] = __builtin_amdgcn_mfma_f32_16x16x32_bf16(Bt[n][k], At[m][k], acc[ai][bj][m][n], 0, 0, 0); __builtin_amdgcn_s_setprio(0); } while (0)
#define PG8_WAIT_V(n) asm volatile("s_waitcnt vmcnt(" #n ")" ::: "memory")
#define PG8_WAIT_L(n) asm volatile("s_waitcnt lgkmcnt(" #n ")" ::: "memory")
#define PG8_BAR __builtin_amdgcn_s_barrier()
#define PG8_SCHED __builtin_amdgcn_sched_barrier(0)
    Unit cur, nxt; int ui = 0;
    if (!S.next(0, cur)) return;
    f32x4 acc[2][2][4][2];
#pragma unroll
    for (int a = 0; a < 2; ++a)
#pragma unroll
        for (int b = 0; b < 2; ++b)
#pragma unroll
            for (int m = 0; m < 4; ++m)
#pragma unroll
                for (int n = 0; n < 2; ++n) acc[a][b][m][n] = (f32x4){0.f, 0.f, 0.f, 0.f};
    bf16x8 At[4][2], B0[2][2], B1[2][2];
    const char* cA = (const char*)(g.A + (size_t)cur.g * g.gsA) + (size_t)cur.pm * tstepA; const char* cB = (const char*)(g.Bt + (size_t)cur.g * g.gsB) + (size_t)cur.pn * tstepB;
    static_assert(SP2, "only the SP2 loop is kept in this file");
    PG8_STAGE(PG8_SB(0, 0), cB, voffB); PG8_STAGE(PG8_SB(0, 1), cB + hstepB, voffB); PG8_STAGE(PG8_SA(0, 0), cA, voffA); PG8_STAGE(PG8_SA(0, 1), cA + hstepA, voffA);
    if (wr == 1) PG8_BAR;
    PG8_WAIT_V(2); PG8_BAR;
    PG8_STAGE(PG8_SB(1, 0), cB + kstep, voffB); PG8_STAGE(PG8_SA(1, 0), cA + kstep, voffA); PG8_STAGE(PG8_SB(1, 1), cB + hstepB + kstep, voffB);
    PG8_WAIT_V(6); PG8_BAR;
    for (;;) {
        const bool has_next = S.next(ui + 1, nxt);
        const char* nA = has_next ? (const char*)(g.A + (size_t)nxt.g * g.gsA) + (size_t)nxt.pm * tstepA : cA;
        const char* nB = has_next ? (const char*)(g.Bt + (size_t)nxt.g * g.gsB) + (size_t)nxt.pn * tstepB : cB;
        for (int t = 0; t < nt; t += 2) {
            const bool last = (t == nt - 2);
            const char* a1 = cA + (size_t)(t + 1) * kstep;
            const char* a2 = last ? nA : cA + (size_t)(t + 2) * kstep; const char* b2 = last ? nB : cB + (size_t)(t + 2) * kstep;
            const char* a3 = a2 + kstep; const char* b3 = b2 + kstep;
            if constexpr (Epi::MIDK) { if (t == (nt >> 1)) E.midk(acc, cur, wr, wc, fr, fq); }
            PG8_LDB(B0, 0, 0); PG8_LDB(B1, 0, 1); PG8_SCHED; PG8_LDA(At, 0, 0); PG8_STAGE(PG8_SA(1, 1), a1 + hstepA, voffA);
            PG8_WAIT_V(8); PG8_WAIT_L(0); PG8_BAR; PG8_MMA(0, 0, At, B0); PG8_MMA(0, 1, At, B1); PG8_BAR; PG8_SCHED;
            PG8_LDA(At, 0, 1); PG8_STAGE(PG8_SB(0, 0), b2, voffB); PG8_STAGE(PG8_SB(0, 1), b2 + hstepB, voffB); PG8_STAGE(PG8_SA(0, 0), a2, voffA);
            PG8_WAIT_V(8); PG8_WAIT_L(0); PG8_BAR; PG8_MMA(1, 0, At, B0); PG8_MMA(1, 1, At, B1); PG8_BAR; PG8_SCHED;
            PG8_LDB(B0, 1, 0); PG8_LDB(B1, 1, 1); PG8_SCHED; PG8_LDA(At, 1, 0); PG8_STAGE(PG8_SA(0, 1), a2 + hstepA, voffA);
            PG8_WAIT_V(8); PG8_WAIT_L(0); PG8_BAR; PG8_MMA(0, 0, At, B0); PG8_MMA(0, 1, At, B1); PG8_BAR; PG8_SCHED;
            PG8_LDA(At, 1, 1); PG8_STAGE(PG8_SB(1, 0), b3, voffB); PG8_STAGE(PG8_SB(1, 1), b3 + hstepB, voffB); PG8_STAGE(PG8_SA(1, 0), a3, voffA);
            PG8_WAIT_V(8); PG8_WAIT_L(0); PG8_BAR; PG8_MMA(1, 0, At, B0); PG8_MMA(1, 1, At, B1); PG8_BAR; PG8_SCHED;
        }
        if constexpr (ALIGN_EPI) { if (wr == 0) PG8_BAR; }
        E(acc, cur, wr, wc, fr, fq);
#if defined(EPI_REP_PROBE)
        if (Epi::PROBE_ID == EPI_REP_PROBE) { asm volatile("" ::: "memory"); E(acc, cur, wr, wc, fr, fq); }
#endif
        if (!has_next) break;
#pragma unroll
        for (int a = 0; a < 2; ++a)
#pragma unroll
            for (int b = 0; b < 2; ++b)
#pragma unroll
                for (int m = 0; m < 4; ++m)
#pragma unroll
                    for (int n = 0; n < 2; ++n) acc[a][b][m][n] = (f32x4){0.f, 0.f, 0.f, 0.f};
        cur = nxt; cA = nA; cB = nB; ++ui;
        if constexpr (ALIGN_EPI) { if (wr == 1) PG8_BAR; }
    }
    PG8_WAIT_V(0);
    if constexpr (!ALIGN_EPI) { if (wr == 0) PG8_BAR; }
    PG8_BAR;
#undef PG8_SA
#undef PG8_SB
#undef PG8_STAGE
#undef PG8_LDA
#undef PG8_LDB
#undef PG8_MMA
#undef PG8_WAIT_V
#undef PG8_WAIT_L
#undef PG8_BAR
#undef PG8_SCHED
}

__device__ __forceinline__ u32x4 pack8(const f32x4 v0, const f32x4 v1) { u32x4 w; w.x = cvt_pk_bf16(v0[0], v0[1]); w.y = cvt_pk_bf16(v0[2], v0[3]); w.z = cvt_pk_bf16(v1[0], v1[1]); w.w = cvt_pk_bf16(v1[2], v1[3]); return w; }

struct EpiInProj {
    static constexpr int PROBE_ID = 1;
    static constexpr bool PERM = true, MIDK = false;
    const float* rs; bf16_t *Q, *KV, *GA, *GS, *AG;
    __device__ __forceinline__ void operator()(const f32x4 (&acc)[2][2][4][2], const Unit& u, int wr, int wc, int fr, int fq) const {
        const int pn = u.pn; const int row0 = u.pm * BM + wr * 64 + fr; const int colt = pn * BM + wc * 32 + 8 * fq;
        int kind = 0, ld = 1024, cb = colt; bf16_t* base = Q;
        if (pn >= 4 && pn < 6) { base = KV; ld = 512; cb = colt - 1024; }
        else if (pn >= 6 && pn < 10) { base = GA; cb = colt - 1536; kind = 1; }
        else if (pn >= 10 && pn < 14) { base = AG; cb = colt - 2560; kind = 2; }
        else if (pn >= 14) { base = GS; cb = colt - 3584; kind = 1; }
        float rsv[2][4];
#pragma unroll
        for (int ai = 0; ai < 2; ++ai)
#pragma unroll
            for (int m = 0; m < 4; ++m) rsv[ai][m] = rs[row0 + ai * HALF + m * 16];
#pragma unroll
        for (int ai = 0; ai < 2; ++ai)
#pragma unroll
            for (int m = 0; m < 4; ++m) { const int r = row0 + ai * HALF + m * 16; const float s = rsv[ai][m];
#pragma unroll
                for (int bj = 0; bj < 2; ++bj) { f32x4 v0 = acc[ai][bj][m][0] * s, v1 = acc[ai][bj][m][1] * s;
                    if (kind == 1) {
#pragma unroll
                        for (int e = 0; e < 4; ++e) { v0[e] = silu_f(v0[e]); v1[e] = silu_f(v1[e]); } }
                    const int c = cb + bj * HALF; size_t off;
                    if (kind == 2) off = ((size_t)((c >> 4) * NCHUNK + (r >> 6))) * KA + (size_t)((r & 63) * 16 + (c & 15));
                    else off = (size_t)r * ld + c;
                    *(u32x4*)(base + off) = pack8(v0, v1); } }
    }
};
struct EpiLR {
    static constexpr int PROBE_ID = 2;
    static constexpr bool PERM = false, MIDK = false;
    float* LR;
    __device__ __forceinline__ void operator()(const f32x4 (&acc)[2][2][4][2], const Unit& u, int wr, int wc, int fr, int fq) const {
        const int row0 = u.pm * BM + wr * 64 + fr, col0 = wc * 32 + 4 * fq;
#pragma unroll
        for (int ai = 0; ai < 2; ++ai)
#pragma unroll
            for (int m = 0; m < 4; ++m) { float* rowp = LR + ((size_t)u.g * NCHUNK + row0 + ai * HALF + m * 16) * 256 + col0;
#pragma unroll
                for (int bj = 0; bj < 2; ++bj)
#pragma unroll
                    for (int n = 0; n < 2; ++n) *(f32x4*)(rowp + bj * HALF + n * 16) = acc[ai][bj][m][n]; }
    }
};
struct EpiSsm {
    static constexpr int PROBE_ID = 4;
    static constexpr bool PERM = true, MIDK = false;
    const bf16_t* AG; const float* dskip; bf16_t* Y;
    __device__ __forceinline__ void operator()(const f32x4 (&acc)[2][2][4][2], const Unit& u, int wr, int wc, int fr, int fq) const {
        const int ch0 = u.pm * BM + wr * 64 + fr, n00 = u.pn * BM + wc * 32 + 8 * fq; const int g = u.g;
        const int co0 = n00 & 15;
        const f32x4 d0 = *(const f32x4*)(dskip + g * 16 + co0), d1 = *(const f32x4*)(dskip + g * 16 + co0 + 4);
#pragma unroll
        for (int ai = 0; ai < 2; ++ai) {
            u32x4 uw4[4][2];
#pragma unroll
            for (int m = 0; m < 4; ++m) { const int ch = ch0 + ai * HALF + m * 16;
#pragma unroll
                for (int bj = 0; bj < 2; ++bj) uw4[m][bj] = *(const u32x4*)(AG + ((size_t)g * NCHUNK + ch) * KA + n00 + bj * HALF); }
#pragma unroll
            for (int m = 0; m < 4; ++m) { const int ch = ch0 + ai * HALF + m * 16;
#pragma unroll
                for (int bj = 0; bj < 2; ++bj) { const int n0 = n00 + bj * HALF, j = n0 >> 4; const u32x4 uw = uw4[m][bj];
                    f32x4 v0 = acc[ai][bj][m][0], v1 = acc[ai][bj][m][1];
                    v0[0] += d0[0] * bflo(uw.x); v0[1] += d0[1] * bfhi(uw.x); v0[2] += d0[2] * bflo(uw.y); v0[3] += d0[3] * bfhi(uw.y);
                    v1[0] += d1[0] * bflo(uw.z); v1[1] += d1[1] * bfhi(uw.z); v1[2] += d1[2] * bflo(uw.w); v1[3] += d1[3] * bfhi(uw.w);
#pragma unroll
                    for (int e = 0; e < 4; ++e) { v0[e] = gelu_tanh(v0[e]); v1[e] = gelu_tanh(v1[e]); }
                    *(u32x4*)(Y + ((size_t)ch * CT + j) * 1024 + g * 16 + co0) = pack8(v0, v1); } } }
    }
};
struct EpiGlu {
    static constexpr int PROBE_ID = 5;
    static constexpr bool PERM = true, MIDK = false;
    const bf16_t* Y; const bf16_t* GS; bf16_t* MG; float* SSQS;
    __device__ __forceinline__ void operator()(const f32x4 (&acc)[2][2][4][2], const Unit& u, int wr, int wc, int fr, int fq) const {
        const int row0 = u.pm * BM + wr * 64 + fr, c00 = u.pn * BM + wc * 32 + 8 * fq;
#pragma unroll
        for (int ai = 0; ai < 2; ++ai) {
            u32x4 yw[4][2], gw[4][2];
#pragma unroll
            for (int m = 0; m < 4; ++m) { const int r = row0 + ai * HALF + m * 16;
#pragma unroll
                for (int bj = 0; bj < 2; ++bj) { const int c = c00 + bj * HALF; yw[m][bj] = *(const u32x4*)(Y + (size_t)r * 1024 + c); gw[m][bj] = *(const u32x4*)(GS + (size_t)r * 1024 + c); } }
#pragma unroll
            for (int m = 0; m < 4; ++m) { const int r = row0 + ai * HALF + m * 16; float ss = 0.f;
#pragma unroll
                for (int bj = 0; bj < 2; ++bj) { const int c = c00 + bj * HALF; const u32x4 y4 = yw[m][bj], g4 = gw[m][bj];
                    const f32x4 a0 = acc[ai][bj][m][0], a1 = acc[ai][bj][m][1]; f32x4 v0, v1;
                    v0[0] = bflo(y4.x) * fast_sigmoid(a0[0]) * bflo(g4.x); v0[1] = bfhi(y4.x) * fast_sigmoid(a0[1]) * bfhi(g4.x);
                    v0[2] = bflo(y4.y) * fast_sigmoid(a0[2]) * bflo(g4.y); v0[3] = bfhi(y4.y) * fast_sigmoid(a0[3]) * bfhi(g4.y);
                    v1[0] = bflo(y4.z) * fast_sigmoid(a1[0]) * bflo(g4.z); v1[1] = bfhi(y4.z) * fast_sigmoid(a1[1]) * bfhi(g4.z);
                    v1[2] = bflo(y4.w) * fast_sigmoid(a1[2]) * bflo(g4.w); v1[3] = bfhi(y4.w) * fast_sigmoid(a1[3]) * bfhi(g4.w);
#pragma unroll
                    for (int e = 0; e < 4; ++e) ss += v0[e] * v0[e] + v1[e] * v1[e];
                    *(u32x4*)(MG + (size_t)r * 2048 + 1024 + c) = pack8(v0, v1); }
                ss += __shfl_xor(ss, 16); ss += __shfl_xor(ss, 32);
                if (fq == 0) SSQS[(size_t)r * 16 + u.pn * 4 + wc] = ss; } }
    }
};
struct EpiOut {
    static constexpr int PROBE_ID = 7;
    static constexpr bool PERM = false, MIDK = true;
    const float* xp; const float* xs; float* out; const float* ratio; const float* rsn;
    __device__ __forceinline__ void midk(f32x4 (&acc)[2][2][4][2], const Unit& u, int wr, int wc, int fr, int fq) const {
        const int row0 = u.pm * BM + wr * 64 + fr;
#pragma unroll
        for (int ai = 0; ai < 2; ++ai)
#pragma unroll
            for (int m = 0; m < 4; ++m) { const float s = ratio[row0 + ai * HALF + m * 16];
#pragma unroll
                for (int bj = 0; bj < 2; ++bj)
#pragma unroll
                    for (int n = 0; n < 2; ++n) acc[ai][bj][m][n] *= s; }
    }
    __device__ __forceinline__ void operator()(const f32x4 (&acc)[2][2][4][2], const Unit& u, int wr, int wc, int fr, int fq) const {
        const int row0 = u.pm * BM + wr * 64 + fr, col0 = u.pn * BM + wc * 32 + 4 * fq;
#pragma unroll
        for (int ai = 0; ai < 2; ++ai) {
            f32x4 xv[4][2][2]; float sv[4];
#pragma unroll
            for (int m = 0; m < 4; ++m) { const int r = row0 + ai * HALF + m * 16; sv[m] = rsn[r];
                const float* xr = (r < NPROMPT ? xp + (size_t)r * DM : xs + (size_t)(r - NPROMPT) * DM) + col0;
#pragma unroll
                for (int bj = 0; bj < 2; ++bj)
#pragma unroll
                    for (int n = 0; n < 2; ++n) xv[m][bj][n] = *(const f32x4*)(xr + bj * HALF + n * 16); }
#pragma unroll
            for (int m = 0; m < 4; ++m) { const int r = row0 + ai * HALF + m * 16; float* orow = out + (size_t)r * DM + col0;
#pragma unroll
                for (int bj = 0; bj < 2; ++bj)
#pragma unroll
                    for (int n = 0; n < 2; ++n) *(f32x4*)(orow + bj * HALF + n * 16) = xv[m][bj][n] + acc[ai][bj][m][n] * sv[m]; } }
    }
};
}

namespace attn {
using bf16 = __hip_bfloat16;
constexpr int D = 128, NW = 8, QBLK = 32, KVBLK = 64;
constexpr float SCALE = 0.088388347648318440f;
constexpr float THR = 8.f;
constexpr int SDEPTH = 1;
constexpr int LDQ = 1024, LDK = 512, LDO = 2048;
constexpr size_t SHM_V = KVBLK * D * 2, SHM_K = KVBLK * D * 2, SHM_ATTN = 4 * SHM_V + 4 * SHM_K;
using s16x4 = __attribute__((ext_vector_type(4))) short;
using f32x16 = __attribute__((ext_vector_type(16))) float;
#define KSWZ(row, colB) ((row) * 256 + ((colB) ^ (((row) & 15) << 4)))
#define SBAR() __builtin_amdgcn_sched_barrier(0)
__device__ __forceinline__ int crow(int r, int hi) { return (r & 3) + 8 * (r >> 2) + 4 * hi; }
__device__ __forceinline__ unsigned cvtpk(float lo, float hi) { unsigned r; asm volatile("v_cvt_pk_bf16_f32 %0, %1, %2" : "=v"(r) : "v"(lo), "v"(hi)); return r; }
template <bool SHIFT> __device__ __forceinline__ void softmax_tile(f32x16& p0, f32x16& p1, float& l_part, bf16x8& pa0, bf16x8& pa1, bf16x8& pa2, bf16x8& pa3, float msub) {
  for (int r = 0; r < 16; ++r) p0[r] = __builtin_amdgcn_exp2f(SHIFT ? p0[r] - msub : p0[r]);
  for (int r = 0; r < 16; ++r) p1[r] = __builtin_amdgcn_exp2f(SHIFT ? p1[r] - msub : p1[r]);
  float ps = 0; for (int r = 0; r < 16; ++r) ps += p0[r]; for (int r = 0; r < 16; ++r) ps += p1[r];
  l_part += ps;
#define PK4(P, BASE, OUT) do { unsigned a0 = cvtpk(P[BASE + 0], P[BASE + 1]), a1 = cvtpk(P[BASE + 2], P[BASE + 3]);   \
    unsigned b0 = cvtpk(P[BASE + 4], P[BASE + 5]), b1 = cvtpk(P[BASE + 6], P[BASE + 7]);                              \
    auto r0 = __builtin_amdgcn_permlane32_swap(a0, b0, false, false); auto r1 = __builtin_amdgcn_permlane32_swap(a1, b1, false, false); \
    u32x4 w = {r0[0], r1[0], r0[1], r1[1]}; OUT = *reinterpret_cast<bf16x8*>(&w); } while (0)
  PK4(p0, 0, pa0); PK4(p0, 8, pa1); PK4(p1, 0, pa2); PK4(p1, 8, pa3);
#undef PK4
}
__device__ __forceinline__ int v_st(int k, int c) { const int kk = (k & ~0xC) | ((k & 4) << 1) | ((k & 8) >> 1); return ((kk >> 3) * 4 + (c >> 5)) * 512 + ((kk & 7) * 32 + (c & 31)) * 2; }
__device__ __forceinline__ int v_rd_base(int lane) { return ((lane & 3) << 3) | (((lane >> 2) & 3) << 6) | (((lane >> 4) & 1) << 5) | (((lane >> 5) & 1) << 8); }
constexpr int v_rd_off(int d0, int ks, int half) { return d0 * 512 + ks * 4096 + half * 2048; }
__device__ __forceinline__ void glds16s(unsigned voff, const void* sbase, unsigned lds_dst) { unsigned keep;
  asm volatile("s_mov_b32 %0, m0\n\ts_mov_b32 m0, %3\n\ts_nop 0\n\tglobal_load_lds_dwordx4 %1, %2\n\ts_mov_b32 m0, %0" : "=&s"(keep) : "v"(voff), "s"(sbase), "s"(lds_dst) : "memory"); }
template <int OFF> __device__ __forceinline__ s16x4 tr_read(int vb) {
  s16x4 r; asm volatile("ds_read_b64_tr_b16 %0, %1 offset:%2" : "=&v"(r) : "v"(vb), "i"(OFF) : "memory"); return r;
}
struct VFrag { s16x4 l0, h0, l1, h1, l2, h2, l3, h3; };
template <int D0, int SO> __device__ __forceinline__ void v_read8(VFrag& f, int vb) {
  f.l0 = tr_read<SO + v_rd_off(D0, 0, 0)>(vb); f.h0 = tr_read<SO + v_rd_off(D0, 0, 1)>(vb); f.l1 = tr_read<SO + v_rd_off(D0, 1, 0)>(vb); f.h1 = tr_read<SO + v_rd_off(D0, 1, 1)>(vb);
  f.l2 = tr_read<SO + v_rd_off(D0, 2, 0)>(vb); f.h2 = tr_read<SO + v_rd_off(D0, 2, 1)>(vb); f.l3 = tr_read<SO + v_rd_off(D0, 3, 0)>(vb); f.h3 = tr_read<SO + v_rd_off(D0, 3, 1)>(vb);
}
__device__ __forceinline__ void pv_mma4(f32x16& od, const VFrag& f, bf16x8 pa0, bf16x8 pa1, bf16x8 pa2, bf16x8 pa3) {
#define PK(L, H) (bf16x8){L[0], L[1], L[2], L[3], H[0], H[1], H[2], H[3]}
  __builtin_amdgcn_s_setprio(1);
  od = __builtin_amdgcn_mfma_f32_32x32x16_bf16(pa0, PK(f.l0, f.h0), od, 0, 0, 0);
  od = __builtin_amdgcn_mfma_f32_32x32x16_bf16(pa1, PK(f.l1, f.h1), od, 0, 0, 0);
  od = __builtin_amdgcn_mfma_f32_32x32x16_bf16(pa2, PK(f.l2, f.h2), od, 0, 0, 0);
  od = __builtin_amdgcn_mfma_f32_32x32x16_bf16(pa3, PK(f.l3, f.h3), od, 0, 0, 0);
  __builtin_amdgcn_s_setprio(0);
#undef PK
}
template <int SO> __device__ __forceinline__ void pv_d0(f32x16* o, int vb, bf16x8 pa0, bf16x8 pa1, bf16x8 pa2, bf16x8 pa3) {
  VFrag fa, fb;
  v_read8<0, SO>(fa, vb);
  v_read8<1, SO>(fb, vb); asm volatile("s_waitcnt lgkmcnt(8)" ::: "memory"); SBAR(); pv_mma4(o[0], fa, pa0, pa1, pa2, pa3); SBAR();
  v_read8<2, SO>(fa, vb); asm volatile("s_waitcnt lgkmcnt(8)" ::: "memory"); SBAR(); pv_mma4(o[1], fb, pa0, pa1, pa2, pa3); SBAR();
  v_read8<3, SO>(fb, vb); asm volatile("s_waitcnt lgkmcnt(8)" ::: "memory"); SBAR(); pv_mma4(o[2], fa, pa0, pa1, pa2, pa3); SBAR();
  asm volatile("s_waitcnt lgkmcnt(0)" ::: "memory"); SBAR(); pv_mma4(o[3], fb, pa0, pa1, pa2, pa3);
}

__device__ __forceinline__ void attn_q_prologue(const bf16_t* __restrict__ Qb, const float* __restrict__ qnw, const f32x2* __restrict__ tab, float kmaxc, int pos0,
                                                int wid, int r32, int hi, bf16x8 (&qr)[8], float& mshift) {
    const bf16_t* Qw = Qb + (long)(wid * QBLK + r32) * LDQ + hi * 8;
    u32x4 raw[8]; float ss = 0.f;
#pragma unroll
    for (int d0 = 0; d0 < 8; ++d0) raw[d0] = *reinterpret_cast<const u32x4*>(Qw + d0 * 16);
#pragma unroll
    for (int d0 = 0; d0 < 8; ++d0) {
#pragma unroll
      for (int q = 0; q < 4; ++q) { const float a = bflo(raw[d0][q]), b = bfhi(raw[d0][q]); ss += a * a + b * b; } }
    { auto rr = __builtin_amdgcn_permlane32_swap(__float_as_uint(ss), __float_as_uint(ss), false, false); ss = __uint_as_float(rr[0]) + __uint_as_float(rr[1]); }
    const float rn = (SCALE * 1.4426950408889634f) / sqrtf(ss * (1.0f / 128.0f) + EPS);
    float qn2 = 0.f;
    const int pos = pos0 + wid * QBLK + r32, prow = pos >> 6, pcol = pos & 63;
#pragma unroll
    for (int pg = 0; pg < 4; ++pg) { const int dd = pg & 1, ax = pg >> 1, d0 = ax * 4 + dd;
      const f32x2* tp = tab + (ax == 0 ? prow : pcol) * 32 + hi * 8 + dd * 16;
      const float* wa = qnw + d0 * 16 + hi * 8; const float* wb = wa + 32;
      float na[8], nb[8];
#pragma unroll
      for (int q = 0; q < 4; ++q) {
        const f32x2 c0 = tp[2 * q], c1 = tp[2 * q + 1];
        const float a0 = bflo(raw[d0][q]) * (rn * wa[2 * q]), a1 = bfhi(raw[d0][q]) * (rn * wa[2 * q + 1]);
        const float b0 = bflo(raw[d0 + 2][q]) * (rn * wb[2 * q]), b1 = bfhi(raw[d0 + 2][q]) * (rn * wb[2 * q + 1]);
        na[2 * q] = a0 * c0.x - b0 * c0.y; nb[2 * q] = b0 * c0.x + a0 * c0.y;
        na[2 * q + 1] = a1 * c1.x - b1 * c1.y; nb[2 * q + 1] = b1 * c1.x + a1 * c1.y;
        qn2 += (na[2 * q] * na[2 * q] + nb[2 * q] * nb[2 * q]) + (na[2 * q + 1] * na[2 * q + 1] + nb[2 * q + 1] * nb[2 * q + 1]); }
      { u32x4 w = {cvtpk(na[0], na[1]), cvtpk(na[2], na[3]), cvtpk(na[4], na[5]), cvtpk(na[6], na[7])}; qr[d0] = *reinterpret_cast<bf16x8*>(&w); }
      { u32x4 w = {cvtpk(nb[0], nb[1]), cvtpk(nb[2], nb[3]), cvtpk(nb[4], nb[5]), cvtpk(nb[6], nb[7])}; qr[d0 + 2] = *reinterpret_cast<bf16x8*>(&w); }
      asm volatile("" ::: "memory"); }
    { auto rr = __builtin_amdgcn_permlane32_swap(__float_as_uint(qn2), __float_as_uint(qn2), false, false); qn2 = __uint_as_float(rr[0]) + __uint_as_float(rr[1]); }
    mshift = fmaxf(sqrtf(qn2) * kmaxc - 40.0f, 0.0f);
}
template <bool SHIFT>
__device__ __forceinline__ void attn_main(const bf16_t* __restrict__ Kh, const bf16_t* __restrict__ Vh, const bf16_t* __restrict__ GAb, bf16_t* __restrict__ Ob, float* __restrict__ ssq,
                                          int seq, LAS char* lds, LAS char* lscr, int wave_s, const bf16x8 (&qr)[8], float mshift) {
  const int lane = fresh_lane(), r32 = lane & 31, hi = lane >> 5;
  LAS char* const Vr = lds; LAS char* const Kr = lds + 4 * SHM_V;
  float l_reg = 0; f32x16 o[4] = {};
  unsigned ksrc[2], vsrc[2];
#pragma unroll
  for (int i = 0; i < 2; ++i) { const int p = 2 * wave_s + i;
    const int row = 4 * p + (lane >> 4), lc = (lane & 15) ^ (row & 15); ksrc[i] = (unsigned)(row * LDK + lc * 8) * 2u;
    const int st = 2 * p + (lane >> 5), q = lane & 31, kk = (st >> 2) * 8 + (q >> 2), k = (kk & ~0xC) | ((kk & 4) << 1) | ((kk & 8) >> 1), c = (st & 3) * 32 + (q & 3) * 8;
    vsrc[i] = (unsigned)(k * LDK + c) * 2u; }
  const unsigned ldsw = (unsigned)wave_s * 2048u;
  const int vb0 = (int)(uintptr_t)Vr + v_rd_base(lane);
  const LAS char* kp[8];
#pragma unroll
  for (int d0 = 0; d0 < 8; ++d0) kp[d0] = Kr + r32 * 256 + (((2 * d0 + hi) ^ (r32 & 15)) << 4);
#define DMA(T, TS) do { const char* kg = (const char*)Kh + (size_t)(T) * (KVBLK * LDK * 2); const char* vg = (const char*)Vh + (size_t)(T) * (KVBLK * LDK * 2); \
    const unsigned so = (unsigned)(uintptr_t)Vr + ((unsigned)(TS) & 3u) * (unsigned)SHM_K + ldsw; \
    glds16s(ksrc[0], kg, so + 4 * (unsigned)SHM_V); glds16s(vsrc[0], vg, so); glds16s(ksrc[1], kg, so + 4 * (unsigned)SHM_V + 1024u); glds16s(vsrc[1], vg, so + 1024u); } while (0)
#define WAITBAR(N) asm volatile("s_waitcnt vmcnt(" #N ") lgkmcnt(0)\n\ts_barrier" ::: "memory")
#define QKT(P0, P1, KSO) do { P0 = f32x16{}; P1 = f32x16{}; __builtin_amdgcn_s_setprio(1); \
    _Pragma("unroll") for (int d0 = 0; d0 < 8; ++d0) { const bf16x8 b0 = *(const LAS bf16x8*)(kp[d0] + (KSO)); \
      P0 = __builtin_amdgcn_mfma_f32_32x32x16_bf16(b0, qr[d0], P0, 0, 0, 0); } \
    _Pragma("unroll") for (int d0 = 0; d0 < 8; ++d0) { const bf16x8 b1 = *(const LAS bf16x8*)(kp[d0] + (KSO) + 8192); \
      P1 = __builtin_amdgcn_mfma_f32_32x32x16_bf16(b1, qr[d0], P1, 0, 0, 0); } __builtin_amdgcn_s_setprio(0); } while (0)
#define NEXTDMA(T) do { const int t2 = (T) + 2; DMA(t2 < NT ? t2 : t2 - NT, t2); } while (0)
#define SOFT() softmax_tile<SHIFT>(p0, p1, l_reg, pa0, pa1, pa2, pa3, mshift)
#define PV(T) pv_d0<0>(o, vb0 + ((T) & 3) * (int)SHM_V, pa0, pa1, pa2, pa3)
  f32x16 p0, p1; bf16x8 pa0, pa1, pa2, pa3; const int NT = seq / KVBLK;
  DMA(0, 0); DMA(1, 1);
  if (wave_s < 4) {
    for (int j = 0; j < NT; ++j) {
      WAITBAR(4); NEXTDMA(j); SBAR();
      QKT(p0, p1, (j & 3) * (int)SHM_K); SBAR();
      SOFT(); SBAR();
      PV(j); SBAR();
    }
  } else {
    WAITBAR(4); NEXTDMA(0); SBAR();
    QKT(p0, p1, 0); SBAR();
    for (int j = 1; j < NT; ++j) {
      WAITBAR(4); NEXTDMA(j); SBAR();
      SOFT(); SBAR();
      PV(j - 1); SBAR();
      QKT(p0, p1, (j & 3) * (int)SHM_K); SBAR();
    }
    SOFT(); SBAR();
    PV(NT - 1); SBAR();
  }
  asm volatile("s_waitcnt vmcnt(0)" ::: "memory");
#undef NEXTDMA
#undef SOFT
#undef PV
  { auto rr = __builtin_amdgcn_permlane32_swap(__float_as_uint(l_reg), __float_as_uint(l_reg), false, false); l_reg = __uint_as_float(rr[0]) + __uint_as_float(rr[1]); }
  { const int le = fresh_lane(); LAS float* li_w = (LAS float*)lscr + wave_s * 64; if (le < 32) li_w[le] = l_reg; } asm volatile("s_waitcnt lgkmcnt(0)" ::: "memory");
  { const int te = fresh_lane(); const LAS float* li_l = (const LAS float*)lscr + wave_s * 64;
    const int ew = wave_s, er = te & 31, eh = (te >> 5) & 1;
    const long rbase = (long)(ew * QBLK + 4 * eh) ;
    const bf16_t* gp0 = GAb + rbase * 1024 + er; bf16_t* op0 = Ob + rbase * LDO + er;
#pragma unroll
    for (int rb = 0; rb < 4; ++rb) {
      unsigned short gv[4][4];
#pragma unroll
      for (int rr = 0; rr < 4; ++rr)
#pragma unroll
        for (int d0 = 0; d0 < 4; ++d0) gv[rr][d0] = gp0[(long)(8 * rb + rr) * 1024 + d0 * 32];
#pragma unroll
      for (int rr = 0; rr < 4; ++rr) { const int r = 4 * rb + rr, orow = 8 * rb + rr; const float rl = __builtin_amdgcn_rcpf(li_l[orow + 4 * eh]); float s2 = 0.f;
#pragma unroll
        for (int d0 = 0; d0 < 4; ++d0) { const float v = o[d0][r] * rl * bf2f(gv[rr][d0]); s2 += v * v; op0[(long)orow * LDO + d0 * 32] = (bf16_t)(cvtpk(v, v) & 0xffffu); }
        s2 += __shfl_xor(s2, 1); s2 += __shfl_xor(s2, 2); s2 += __shfl_xor(s2, 4); s2 += __shfl_xor(s2, 8); s2 += __shfl_xor(s2, 16);
        if (er == 0) ssq[(rbase + orow) * 8] = s2; } } }
#undef DMA
#undef WAITBAR
#undef QKT
}
__device__ __forceinline__ void attn_dense_body(const bf16_t* __restrict__ Qb, const bf16_t* __restrict__ Kh, const bf16_t* __restrict__ Vh,
                                                const bf16_t* __restrict__ GAb, bf16_t* __restrict__ Ob, float* __restrict__ ssq,
                                                const float* __restrict__ qnw, const f32x2* __restrict__ tab, float kwmax, int wave_s, int pos0, int seq, LAS char* lds, LAS char* lscr) {
  const int lane = fresh_lane(), wid = wave_s, r32 = lane & 31, hi = lane >> 5;
  unsigned kwb = __float_as_uint(kwmax); asm volatile("" : "+s"(kwb));
  const float kmaxc = __uint_as_float(kwb) * (11.313708498984761f * 1.01f);
  bf16x8 qr[8]; float mshift;
  attn_q_prologue(Qb, qnw, tab, kmaxc, pos0, wid, r32, hi, qr, mshift);
  if (__builtin_expect(__any(mshift > 0.0f), 0)) attn_main<true>(Kh, Vh, GAb, Ob, ssq, seq, lds, lscr, wave_s, qr, mshift);
  else attn_main<false>(Kh, Vh, GAb, Ob, ssq, seq, lds, lscr, wave_s, qr, mshift);
}
#undef KSWZ
#undef SBAR
}

constexpr size_t MiB = 1u << 20;
constexpr size_t WS_CTL = 0, CTL_ZERO_BYTES = 1 * MiB;
constexpr size_t WS_RS = 1 * MiB;
constexpr size_t WS_RATIO = 2 * MiB;
constexpr size_t WS_RSN = 3 * MiB;
constexpr size_t WS_SSQA = 4 * MiB;
constexpr size_t WS_SSQS = 6 * MiB;
constexpr size_t WS_TAB = 10 * MiB;
constexpr size_t WS_WINT = 16 * MiB;
constexpr size_t WS_WGLUT = 34 * MiB;
constexpr size_t WS_WOUTT = 36 * MiB;
constexpr size_t WS_Q = 64 * MiB;
constexpr size_t WS_KV = 192 * MiB;
constexpr size_t WS_GA = 256 * MiB;
constexpr size_t WS_GS = 384 * MiB;
constexpr size_t WS_MG = 512 * MiB;
constexpr size_t WS_Y = 768 * MiB;
constexpr size_t WS_END = 896 * MiB;
constexpr size_t OU_XB = 0;
constexpr size_t OU_BTM = 0;
constexpr size_t OU_AG = 256 * MiB;
constexpr size_t OU_WLR = 416 * MiB;
constexpr size_t OU_K0 = 448 * MiB;
constexpr size_t OU_LR = 456 * MiB;
constexpr size_t WS_LR = 896 * MiB;
constexpr size_t WS_BTM = 960 * MiB;
constexpr size_t WS_NEED = 960 * MiB;

constexpr int CW_TMO = 0, CW_BAR = 4096;

#define XB_TMO      128
#define XB_XCNT(j)  (256  + 64 * (j))
#define XB_XSUB(j)  (1280 + 64 * (j))
#define XB_XGEN(j)  (2304 + 64 * (j))
#define XB_TOP      3328
#define XB_TOPGEN   3392
#define XCD_BAR_WORDS 3456
#define XB_SPIN_CAP (1u << 20)
__device__ __forceinline__ unsigned xb_ld(unsigned* p)              { return __hip_atomic_load(p, __ATOMIC_RELAXED, __HIP_MEMORY_SCOPE_AGENT); }
__device__ __forceinline__ unsigned xb_add(unsigned* p, unsigned v) { return __hip_atomic_fetch_add(p, v, __ATOMIC_RELAXED, __HIP_MEMORY_SCOPE_AGENT); }
__device__ __forceinline__ unsigned xb_xcc_id() { return (unsigned)__builtin_amdgcn_s_getreg((3 << 11) | 20) & 0xFu; }
#define XB_SPIN(cond, bar) do { unsigned _sp = 0; while (cond) { __builtin_amdgcn_s_sleep(1); \
    if ((++_sp & 255u) == 0u) { if (xb_ld(&(bar)[XB_TMO])) break; if (_sp > XB_SPIN_CAP) { atomicAdd(&(bar)[XB_TMO], 1u); break; } } } } while (0)
struct XcdBarrier { unsigned* bar; unsigned x; volatile LAS unsigned* st; };
__device__ __forceinline__ XcdBarrier xcd_barrier_post(unsigned* bar, volatile LAS unsigned* st, bool leader) {
    XcdBarrier b; b.bar = bar; b.x = xb_xcc_id(); b.st = st;
    if (leader) (void)xb_add(&bar[XB_XCNT(b.x)], 1u);
    return b;
}
__device__ __forceinline__ void xcd_barrier_complete(unsigned* bar, unsigned x, unsigned& nloc, unsigned& nx) {
    const unsigned G = gridDim.x * gridDim.y * gridDim.z;
    unsigned sum, cnt, mine, sp = 0u;
    for (;;) {
        sum = 0u; cnt = 0u; mine = 0u;
#pragma unroll
        for (unsigned j = 0; j < 16; ++j) { const unsigned c = xb_ld(&bar[XB_XCNT(j)]); sum += c; cnt += (c > 0u) ? 1u : 0u; mine = (j == x) ? c : mine; }
        if (sum == G) break;
        __builtin_amdgcn_s_sleep(1);
        if ((++sp & 255u) == 0u) { if (xb_ld(&bar[XB_TMO])) break; if (sp > XB_SPIN_CAP) { atomicAdd(&bar[XB_TMO], 1u); break; } }
    }
    nloc = mine > 0u ? mine : 1u; nx = cnt > 0u ? cnt : 1u;
}
__device__ __forceinline__ void xcd_barrier(const XcdBarrier& b, bool leader) {
    asm volatile("s_waitcnt vmcnt(0)" ::: "memory");
    __syncthreads();
    if (leader) {
        unsigned* bar = b.bar;
        __builtin_amdgcn_s_waitcnt(0);
        unsigned nloc = b.st[0], nx = b.st[1];
        if (nloc == 0u) { xcd_barrier_complete(bar, b.x, nloc, nx); b.st[0] = nloc; b.st[1] = nx; }
        const unsigned old = xb_add(&bar[XB_XSUB(b.x)], 1u);
        const unsigned gen = old / nloc;
        if (old + 1u == (gen + 1u) * nloc) {
            __builtin_amdgcn_fence(__ATOMIC_RELEASE, "agent");
            asm volatile("s_waitcnt vmcnt(0)" ::: "memory");
            const unsigned og = xb_add(&bar[XB_TOP], 1u);
            const unsigned tg = og / nx;
            if (og + 1u == (tg + 1u) * nx) xb_add(&bar[XB_TOPGEN], 1u);
            else XB_SPIN(xb_ld(&bar[XB_TOPGEN]) == tg, bar);
            __builtin_amdgcn_fence(__ATOMIC_ACQUIRE, "agent");
            xb_add(&bar[XB_XGEN(b.x)], 1u);
            asm volatile("s_waitcnt vmcnt(0)" ::: "memory");
        } else {
            XB_SPIN(xb_ld(&bar[XB_XGEN(b.x)]) == gen, bar);
            __builtin_amdgcn_fence(__ATOMIC_ACQUIRE, "agent");
            asm volatile("s_waitcnt vmcnt(0)" ::: "memory");
        }
    }
    __syncthreads();
}

constexpr int RING_OFF = 0, RING_BYTES = 131072;
constexpr int LDSCTL_OFF = RING_BYTES, MISC_OFF = LDSCTL_OFF + 320;
constexpr int LDS_BYTES = 147456;
constexpr int NWAVES = 8;

struct Args {
    const float* in[18]; float* out; unsigned char* ws; int ph_lo, ph_hi, li, pad;
};

__device__ __forceinline__ float wave_sum(float v) {
#pragma unroll
    for (int o = 1; o < 64; o <<= 1) v += __shfl_xor(v, o);
    return v;
}
__device__ __forceinline__ void p0_transpose_item(const float* W, int K, int N, bf16_t* WT, LAS float* scr, int item, int lane, const float* ks1, const float* ks2, int ksplit) {
    const int nblk = N / 32, kb = item / nblk, nb = item % nblk, k0 = 64 * kb, n0 = 32 * nb;
    f32x4 v[8]; float sc[8];
#pragma unroll
    for (int i = 0; i < 8; ++i) { const int kk = 8 * i + (lane >> 3), k = k0 + kk; sc[i] = 1.f; if (ks1) sc[i] = (k < ksplit) ? ks1[k] : ks2[k - ksplit];
        v[i] = *(const f32x4*)(W + (size_t)k * N + n0 + (lane & 7) * 4); }
#pragma unroll
    for (int i = 0; i < 8; ++i) { const int kk = 8 * i + (lane >> 3); LAS float* d = scr + kk * 33 + (lane & 7) * 4;
        d[0] = v[i].x * sc[i]; d[1] = v[i].y * sc[i]; d[2] = v[i].z * sc[i]; d[3] = v[i].w * sc[i]; }
    asm volatile("s_waitcnt lgkmcnt(0)" ::: "memory");
    const int c = lane & 7;
#pragma unroll
    for (int j = 0; j < 4; ++j) { const int n = (lane >> 3) + 8 * j; const LAS float* s = scr + (8 * c) * 33 + n;
        u32x4 o; o.x = cvt_pk_bf16(s[0 * 33], s[1 * 33]); o.y = cvt_pk_bf16(s[2 * 33], s[3 * 33]); o.z = cvt_pk_bf16(s[4 * 33], s[5 * 33]); o.w = cvt_pk_bf16(s[6 * 33], s[7 * 33]);
        *(GAS u32x4*)(WT + (size_t)(n0 + n) * K + k0 + 8 * c) = o; }
    asm volatile("s_waitcnt lgkmcnt(0)" ::: "memory");
}
__device__ __forceinline__ void ssm_disc(const float* lre, const float* lim, const float* lstep, int d, int g, int p, f32x2& lb, f32x2& bs) {
    const float lr = lre[(d * NG + g) * NPST + p], li = lim[(d * NG + g) * NPST + p], dt = expf(lstep[d * NG + g]);
    const float mag = expf(lr * dt), ang = li * dt; lb.x = mag * cosf(ang); lb.y = mag * sinf(ang);
    const float nr = lb.x - 1.0f, ni = lb.y, den = 1.0f / (lr * lr + li * li);
    bs.x = (nr * lr + ni * li) * den; bs.y = (ni * lr - nr * li) * den;
}
__device__ __forceinline__ f32x2 ssm_pow(const float* lre, const float* lim, const float* lstep, int d, int g, int p, int e) {
    const float lr = lre[(d * NG + g) * NPST + p], li = lim[(d * NG + g) * NPST + p], dt = expf(lstep[d * NG + g]);
    const float mag = expf(lr * dt * (float)e), ang = li * dt * (float)e; f32x2 r; r.x = mag * cosf(ang); r.y = mag * sinf(ang); return r;
}
__device__ __forceinline__ f32x2 cmul(f32x2 a, f32x2 b) { f32x2 r; r.x = a.x * b.x - a.y * b.y; r.y = a.x * b.y + a.y * b.x; return r; }

__global__ void __launch_bounds__(NWAVES * 64, 2) enc_fwd(Args args) {
    extern __shared__ __attribute__((aligned(16))) unsigned char lds[];
    LAS unsigned char* const L = (LAS unsigned char*)lds;
    volatile LAS unsigned* const MISC = (volatile LAS unsigned*)(L + MISC_OFF);
    const int wave = __builtin_amdgcn_readfirstlane((int)threadIdx.x >> 6);
#define LEADER() (wave == 0 && fresh_lane() == 0)
#define PHASE_IDS() const int lane = fresh_lane(); const int tid = wave * 64 + lane; (void)tid
    const int G = gridDim.x; const int bx = blockIdx.x; const int vcu = (G % 8 == 0) ? (bx % 8) * (G / 8) + bx / 8 : bx;
    unsigned char* const ws = args.ws; unsigned char* const ou = (unsigned char*)args.out;
    gu32* const ctl = (gu32*)(ws + WS_CTL);
    const float* x_p = args.in[0]; const float* x_s = args.in[1]; const float* norm_w = args.in[2]; const float* w_in = args.in[3];
    const float* q_norm_w = args.in[4]; const float* k_norm_w = args.in[5]; const float* lam_re = args.in[6]; const float* lam_im = args.in[7]; const float* log_step = args.in[8];
    const float* b_re = args.in[9]; const float* b_im = args.in[10]; const float* c_re = args.in[11]; const float* c_im = args.in[12]; const float* d_skip = args.in[13];
    const float* w_glu = args.in[14]; const float* aonw = args.in[15]; const float* sonw = args.in[16]; const float* w_out = args.in[17];
    float* const RS = (float*)(ws + WS_RS); float* const RATIO = (float*)(ws + WS_RATIO); float* const RSN = (float*)(ws + WS_RSN);
    float* const SSQA = (float*)(ws + WS_SSQA); float* const SSQS = (float*)(ws + WS_SSQS); f32x2* const TAB = (f32x2*)(ws + WS_TAB);
    bf16_t* const WINT = (bf16_t*)(ws + WS_WINT); bf16_t* const WGLUT = (bf16_t*)(ws + WS_WGLUT); bf16_t* const WOUTT = (bf16_t*)(ws + WS_WOUTT);
    bf16_t* const QB = (bf16_t*)(ws + WS_Q); bf16_t* const KVB = (bf16_t*)(ws + WS_KV); bf16_t* const GA = (bf16_t*)(ws + WS_GA); bf16_t* const GS = (bf16_t*)(ws + WS_GS);
    bf16_t* const MG = (bf16_t*)(ws + WS_MG); bf16_t* const YB = (bf16_t*)(ws + WS_Y); float* const LR = (float*)(ws + WS_LR);
    bf16_t* const XB = (bf16_t*)(ou + OU_XB); bf16_t* const BTM = (bf16_t*)(ou + OU_BTM); bf16_t* const AG = (bf16_t*)(ou + OU_AG);
    bf16_t* const WLR = (bf16_t*)(ou + OU_WLR); float* const K0T = (float*)(ou + OU_K0);

    { PHASE_IDS(); for (int u = tid; u < (LDS_BYTES - LDSCTL_OFF) / 4; u += NWAVES * 64) ((LAS unsigned*)(L + LDSCTL_OFF))[u] = 0u; }
    __syncthreads();
    XcdBarrier bar; bar.bar = (unsigned*)(ctl + CW_BAR) + args.li * XCD_BAR_WORDS; bar.x = 0; bar.st = nullptr;
    if (N_LAUNCHES != NPH) bar = xcd_barrier_post((unsigned*)(ctl + CW_BAR) + args.li * XCD_BAR_WORDS, MISC + 8, LEADER());
#define GRID_BAR() do { if (N_LAUNCHES == NPH) { if (LEADER()) __hip_atomic_store(ctl + CW_TMO, 0xBADBA0u, __ATOMIC_RELAXED, __HIP_MEMORY_SCOPE_AGENT); } else { xcd_barrier(bar, LEADER()); } } while (0)
    const int lo = args.ph_lo, hi = args.ph_hi;
#ifndef PH_ONLY
#define PH_ONLY -1
#endif
#define IN(k) ((PH_ONLY < 0 || PH_ONLY == (k)) && lo <= (k) && (k) < hi)
#define BOTH(k) (IN(k) && IN((k) + 1))
#ifndef REPMASK
#define REPMASK 0
#endif
#define REPF(k) (1 + ((REPMASK >> (k)) & 1))
#define THIN_REP(k) _Pragma("unroll") for (int rep_ = 0; rep_ < REPF(k); ++rep_)
    const int gw = vcu * NWAVES + wave, NGW = G * NWAVES;
    LAS float* const scr = (LAS float*)(L + RING_OFF + wave * 16384);

    if (IN(0)) {
        PHASE_IDS();
        THIN_REP(8) {
        {
            constexpr int I_IN = (DM / 64) * (INC / 32), I_GLU = (1024 / 64) * (1024 / 32), I_OUT = (2048 / 64) * (2048 / 32);
            for (int it = gw; it < I_IN + I_GLU + I_OUT; it += NGW) {
                int r = it;
                if (r < I_IN) { p0_transpose_item(w_in, DM, INC, WINT, scr, r, lane, norm_w, norm_w, DM); continue; } r -= I_IN;
                if (r < I_GLU) { p0_transpose_item(w_glu, 1024, 1024, WGLUT, scr, r, lane, nullptr, nullptr, 0); continue; } r -= I_GLU;
                p0_transpose_item(w_out, 2048, 2048, WOUTT, scr, r, lane, aonw, sonw, 1024);
            }
        }
        for (int i = gw * 64 + lane; i < 128 * 32; i += NGW * 64) { const int pos = i >> 5, f = i & 31;
            const float inv = 1.0f / powf(10000.0f, (float)f * (1.0f / 32.0f)); const float ang = (float)pos * inv; f32x2 cs; cs.x = cosf(ang); cs.y = sinf(ang); TAB[i] = cs; }
        for (int it = gw; it < NG * 2 * 16; it += NGW) {
            const int g = __builtin_amdgcn_readfirstlane(it >> 5), d = __builtin_amdgcn_readfirstlane((it >> 4) & 1), tb = __builtin_amdgcn_readfirstlane(it & 15);
            const int tl = lane >> 4, co = lane & 15, tau = tb * 4 + tl;
            LAS f32x2* Es = (LAS f32x2*)scr;
            LAS f32x2* Cs = (LAS f32x2*)(scr + 512);
#pragma unroll
            for (int i = 0; i < 4; ++i) { const int p = co + 16 * i; f32x2 lb, bs; ssm_disc(lam_re, lam_im, log_step, d, g, p, lb, bs); const f32x2 pw = ssm_pow(lam_re, lam_im, log_step, d, g, p, tau); Es[tl * 64 + p] = cmul(pw, bs); }
#pragma unroll
            for (int k = 0; k < 16; ++k) { f32x2 c; c.x = c_re[((size_t)(d * NG + g) * NCH + k) * NPST + lane]; c.y = c_im[((size_t)(d * NG + g) * NCH + k) * NPST + lane]; Cs[k * 65 + lane] = c; }
            asm volatile("s_waitcnt lgkmcnt(0)" ::: "memory");
            float acc[16];
#pragma unroll
            for (int ci = 0; ci < 16; ++ci) acc[ci] = 0.f;
            LAS float* Bs = scr + 512 + 2 * 16 * 65;
#pragma unroll
            for (int ph = 0; ph < 2; ++ph) {
                const float* brg = b_re + ((size_t)g * NPST + 32 * ph) * NCH; const float* big = b_im + ((size_t)g * NPST + 32 * ph) * NCH;
                const f32x4 r0 = *(const f32x4*)(brg + lane * 8), r1 = *(const f32x4*)(brg + lane * 8 + 4), i0 = *(const f32x4*)(big + lane * 8), i1 = *(const f32x4*)(big + lane * 8 + 4);
                asm volatile("s_waitcnt lgkmcnt(0)" ::: "memory");
                *(LAS f32x4*)(Bs + lane * 8) = r0; *(LAS f32x4*)(Bs + lane * 8 + 4) = r1; *(LAS f32x4*)(Bs + 512 + lane * 8) = i0; *(LAS f32x4*)(Bs + 512 + lane * 8 + 4) = i1;
                asm volatile("s_waitcnt lgkmcnt(0)" ::: "memory");
#pragma unroll 4
                for (int pp = 0; pp < 32; ++pp) { const int p = 32 * ph + pp; const f32x2 ce = cmul(Cs[co * 65 + p], Es[tl * 64 + p]);
                    const LAS f32x4* br = (const LAS f32x4*)(Bs + pp * 16); const LAS f32x4* bi = (const LAS f32x4*)(Bs + 512 + pp * 16);
#pragma unroll
                    for (int q = 0; q < 4; ++q) { const f32x4 a = br[q], b2 = bi[q];
                        acc[4 * q] += ce.x * a.x - ce.y * b2.x; acc[4 * q + 1] += ce.x * a.y - ce.y * b2.y; acc[4 * q + 2] += ce.x * a.z - ce.y * b2.z; acc[4 * q + 3] += ce.x * a.w - ce.y * b2.w; } }
            }
            float* dst = K0T + (((size_t)(g * 2 + d) * CT + tau) * NCH + co) * NCH;
#pragma unroll
            for (int q = 0; q < 4; ++q) *(f32x4*)(dst + 4 * q) = (f32x4){acc[4 * q], acc[4 * q + 1], acc[4 * q + 2], acc[4 * q + 3]};
            asm volatile("s_waitcnt lgkmcnt(0)" ::: "memory");
        }
        for (int it = gw; it < NG * 2 * 16; it += NGW) {
            const int g = it >> 5, d = (it >> 4) & 1, jb = it & 15, p = lane; f32x2 lb, bs; ssm_disc(lam_re, lam_im, log_step, d, g, p, lb, bs);
            float br[16], bi[16];
#pragma unroll
            for (int ci = 0; ci < 16; ++ci) { br[ci] = b_re[((size_t)g * NPST + p) * NCH + ci]; bi[ci] = b_im[((size_t)g * NPST + p) * NCH + ci]; }
            const int e0 = d == 0 ? (CT - 4 - 4 * jb) : 4 * jb;
            f32x2 w = cmul(bs, ssm_pow(lam_re, lam_im, log_step, d, g, p, e0));
            bf16_t* rre = WLR + ((size_t)g * 256 + d * 128 + p) * 1024; bf16_t* rim = rre + (size_t)64 * 1024;
#pragma unroll
            for (int es = 0; es < 4; ++es) { const int e = e0 + es, jp = d == 0 ? (CT - 1 - e) : e; float vr[16], vi[16];
#pragma unroll
                for (int ci = 0; ci < 16; ++ci) { vr[ci] = w.x * br[ci] - w.y * bi[ci]; vi[ci] = w.x * bi[ci] + w.y * br[ci]; }
                u32x4 o0, o1, o2, o3;
                o0.x = cvt_pk_bf16(vr[0], vr[1]); o0.y = cvt_pk_bf16(vr[2], vr[3]); o0.z = cvt_pk_bf16(vr[4], vr[5]); o0.w = cvt_pk_bf16(vr[6], vr[7]);
                o1.x = cvt_pk_bf16(vr[8], vr[9]); o1.y = cvt_pk_bf16(vr[10], vr[11]); o1.z = cvt_pk_bf16(vr[12], vr[13]); o1.w = cvt_pk_bf16(vr[14], vr[15]);
                o2.x = cvt_pk_bf16(vi[0], vi[1]); o2.y = cvt_pk_bf16(vi[2], vi[3]); o2.z = cvt_pk_bf16(vi[4], vi[5]); o2.w = cvt_pk_bf16(vi[6], vi[7]);
                o3.x = cvt_pk_bf16(vi[8], vi[9]); o3.y = cvt_pk_bf16(vi[10], vi[11]); o3.z = cvt_pk_bf16(vi[12], vi[13]); o3.w = cvt_pk_bf16(vi[14], vi[15]);
                *(u32x4*)(rre + jp * 16) = o0; *(u32x4*)(rre + jp * 16 + 8) = o1; *(u32x4*)(rim + jp * 16) = o2; *(u32x4*)(rim + jp * 16 + 8) = o3;
                w = cmul(w, lb); }
        }
        for (int m = gw * 2; m < NTOK; m += NGW * 2) {
            const float* xrow = m < NPROMPT ? x_p + (size_t)m * DM : x_s + (size_t)(m - NPROMPT) * DM;
            const f32x4* xr = (const f32x4*)xrow + lane; f32x4 v[2][8]; float s0 = 0.f, s1 = 0.f;
#pragma unroll
            for (int j = 0; j < 8; ++j) { v[0][j] = __builtin_nontemporal_load(xr + 64 * j); v[1][j] = __builtin_nontemporal_load(xr + 512 + 64 * j); }
#pragma unroll
            for (int j = 0; j < 8; ++j) { s0 += (v[0][j].x * v[0][j].x + v[0][j].y * v[0][j].y) + (v[0][j].z * v[0][j].z + v[0][j].w * v[0][j].w);
                                           s1 += (v[1][j].x * v[1][j].x + v[1][j].y * v[1][j].y) + (v[1][j].z * v[1][j].z + v[1][j].w * v[1][j].w); }
            s0 = wave_sum(s0); s1 = wave_sum(s1);
            if (lane == 0) { f32x2 r; r.x = 1.0f / sqrtf(s0 * (1.0f / DM) + EPS); r.y = 1.0f / sqrtf(s1 * (1.0f / DM) + EPS); *(f32x2*)(RS + m) = r; }
            GAS u32x2* o8 = (GAS u32x2*)(XB + (size_t)m * DM) + lane;
#pragma unroll
            for (int j = 0; j < 8; ++j) { u32x2 w; w.x = cvt_pk_bf16(v[0][j].x, v[0][j].y); w.y = cvt_pk_bf16(v[0][j].z, v[0][j].w); o8[64 * j] = w;
                                          u32x2 w1; w1.x = cvt_pk_bf16(v[1][j].x, v[1][j].y); w1.y = cvt_pk_bf16(v[1][j].z, v[1][j].w); o8[512 + 64 * j] = w1; }
        }
        }
        if (BOTH(0)) GRID_BAR();
    }

    if (IN(1)) {
        pg8::Gemm g{XB, WINT, DM, DM, DM, 0, 0}; pg8::StaticOrder S; S.init(NTOK, INC, G, bx, REPF(1));
        pg8::EpiInProj E{RS, QB, KVB, GA, GS, AG};
        pg8::gemm_phase<pg8::EpiInProj, pg8::StaticOrder, true, true>(L + RING_OFF, g, S, E, wave);
        if (BOTH(1)) GRID_BAR();
    }

    if (IN(2)) {
        PHASE_IDS();
        for (int m = gw; m < NTOK; m += NGW) {
            const int pos = m < NPROMPT ? (m & (SP - 1)) : ((m - NPROMPT) & (SS - 1)); const int prow = pos >> 6, pcol = pos & 63;
            GAS u32x2* kp = (GAS u32x2*)(KVB + (size_t)m * 512) + lane; const u32x2 w = *kp;
            float v0 = bflo(w.x), v1 = bfhi(w.x), v2 = bflo(w.y), v3 = bfhi(w.y);
            float ss = (v0 * v0 + v1 * v1) + (v2 * v2 + v3 * v3);
            ss += __shfl_xor(ss, 1); ss += __shfl_xor(ss, 2); ss += __shfl_xor(ss, 4); ss += __shfl_xor(ss, 8); ss += __shfl_xor(ss, 16);
            const float rn = 1.0f / sqrtf(ss * (1.0f / 128.0f) + EPS);
            const int dl = (lane & 31) * 4;
            const f32x4 kw = *(const f32x4*)(k_norm_w + dl);
            v0 *= rn * kw[0]; v1 *= rn * kw[1]; v2 *= rn * kw[2]; v3 *= rn * kw[3];
            const int ax = dl >> 6, half = (dl >> 5) & 1, fi = dl & 31;
            const f32x2* tp = TAB + (ax == 0 ? prow : pcol) * 32 + fi;
            const f32x2 c0 = tp[0], c1 = tp[1], c2 = tp[2], c3 = tp[3];
            const float p0 = __shfl_xor(v0, 8), p1 = __shfl_xor(v1, 8), p2 = __shfl_xor(v2, 8), p3 = __shfl_xor(v3, 8);
            float o0, o1, o2, o3;
            if (half == 0) { o0 = v0 * c0.x - p0 * c0.y; o1 = v1 * c1.x - p1 * c1.y; o2 = v2 * c2.x - p2 * c2.y; o3 = v3 * c3.x - p3 * c3.y; }
            else           { o0 = v0 * c0.x + p0 * c0.y; o1 = v1 * c1.x + p1 * c1.y; o2 = v2 * c2.x + p2 * c2.y; o3 = v3 * c3.x + p3 * c3.y; }
            u32x2 ow; ow.x = cvt_pk_bf16(o0, o1); ow.y = cvt_pk_bf16(o2, o3); *kp = ow;
        }
        THIN_REP(9) {
        for (long pc = (long)gw * 64 + lane; pc < (long)NG * 1024 * 128; pc += (long)NGW * 64) {
            const int kp8 = (int)(pc & 127), n = (int)((pc >> 7) & 1023), g = (int)(pc >> 17);
            const int j = n >> 4, co = n & 15, jp = kp8 >> 1, ci0 = (kp8 & 1) * 8;
            const int dsel = j >= jp ? 0 : 1, tau = j >= jp ? j - jp : jp - j;
            const float* src = K0T + (((size_t)(g * 2 + dsel) * CT + tau) * NCH + co) * NCH + ci0;
            f32x4 a = *(const f32x4*)src, b = *(const f32x4*)(src + 4);
            if (j == jp) { const float* s2 = K0T + (((size_t)(g * 2 + 1) * CT) * NCH + co) * NCH + ci0; a += *(const f32x4*)s2; b += *(const f32x4*)(s2 + 4); }
            *(u32x4*)(BTM + ((size_t)g * 1024 + n) * KA + kp8 * 8) = pg8::pack8(a, b);
        }
        for (int it = gw; it < NG * 2 * NCH; it += NGW) {
            const int g = it >> 5, d = (it >> 4) & 1, co = it & 15, p = lane; f32x2 lb, bs; ssm_disc(lam_re, lam_im, log_step, d, g, p, lb, bs);
            f32x2 c; c.x = c_re[((size_t)(d * NG + g) * NCH + co) * NPST + p]; c.y = c_im[((size_t)(d * NG + g) * NCH + co) * NPST + p];
            f32x2 w = cmul(c, lb);
            for (int e = 1; e <= CT; ++e) { const int j = d == 0 ? e - 1 : CT - e;
                bf16_t* dst = BTM + ((size_t)g * 1024 + j * 16 + co) * KA + 1024 + d * 128 + p;
                dst[0] = (bf16_t)(cvt_pk_bf16(w.x, w.x) & 0xffffu); dst[64] = (bf16_t)(cvt_pk_bf16(-w.y, -w.y) & 0xffffu);
                w = cmul(w, lb); }
        }
        }
        __syncthreads();
        {
            pg8::Gemm g{AG, WLR, KA, 1024, 1024, (size_t)NCHUNK * KA, (size_t)256 * 1024}; pg8::BatchOrder S; S.init(NG, 4, 1, G, vcu, REPF(2));
            pg8::EpiLR E{LR};
            pg8::gemm_phase<pg8::EpiLR, pg8::BatchOrder, true, true>(L + RING_OFF, g, S, E, wave);
        }
        if (BOTH(2)) GRID_BAR();
    }

    if (IN(3)) {
        PHASE_IDS();
        THIN_REP(10)
        for (int it = gw; it < 20 * NG * 2; it += NGW) {
            int s, rest; if (it < 4 * NG * 2) { s = 16 + it / (NG * 2); rest = it % (NG * 2); } else { const int t2 = it - 4 * NG * 2; s = t2 / (NG * 2); rest = t2 % (NG * 2); }
            const int g = rest >> 1, d = rest & 1, p = lane;
            const int c0 = s < 16 ? 32 * s : 512 + 128 * (s - 16), nc = s < 16 ? 32 : 128;
            const f32x2 lT = ssm_pow(lam_re, lam_im, log_step, d, g, p, CT);
            const float* lr = LR + ((size_t)g * NCHUNK) * 256 + d * 128 + p; bf16_t* ag = AG + ((size_t)g * NCHUNK) * KA + 1024 + d * 128 + p;
            f32x2 h; h.x = 0.f; h.y = 0.f;
            for (int cb = 0; cb < nc; cb += 8) {
                float xr[8], xi[8];
#pragma unroll
                for (int q = 0; q < 8; ++q) { const int ch = d == 0 ? c0 + cb + q : c0 + nc - 1 - (cb + q); xr[q] = lr[(size_t)ch * 256]; xi[q] = lr[(size_t)ch * 256 + 64]; }
#pragma unroll
                for (int q = 0; q < 8; ++q) { const int ch = d == 0 ? c0 + cb + q : c0 + nc - 1 - (cb + q);
                    ag[(size_t)ch * KA] = (bf16_t)(cvt_pk_bf16(h.x, h.x) & 0xffffu); ag[(size_t)ch * KA + 64] = (bf16_t)(cvt_pk_bf16(h.y, h.y) & 0xffffu);
                    h = cmul(h, lT); h.x += xr[q]; h.y += xi[q]; }
            }
        }
        __syncthreads();
        float kwmax;
        { float kw = fmaxf(fabsf(k_norm_w[lane]), fabsf(k_norm_w[lane + 64]));
#pragma unroll
          for (int o_ = 1; o_ < 64; o_ <<= 1) kw = fmaxf(kw, __shfl_xor(kw, o_));
          kwmax = __uint_as_float(__builtin_amdgcn_readfirstlane(__float_as_uint(kw))); }
        for (int i0 = 0; i0 < 2048; ++i0) {
            int seq_row0, seqlen, kvh, hq, qb; int i = i0;
            if (G == 256) {
                if (i0 >= 8 * REPF(3)) break; i = i0 & 7;
                const int xcd = vcu >> 5, loc = vcu & 31;
                if (i < 4) { const int s = xcd >> 1; kvh = xcd & 1; const int idx = loc * 4 + i; hq = idx >> 5; qb = idx & 31; seq_row0 = NPROMPT + s * SS; seqlen = SS; }
                else { const int combo = xcd * 4 + (i - 4); const int s = combo >> 1; kvh = combo & 1; hq = loc >> 3; qb = loc & 7; seq_row0 = s * SP; seqlen = SP; }
            } else {
                const int u = i * G + bx; if (u >= 2048) break;
                if (u < 1024) { const int combo = u >> 7, idx = u & 127; const int s = combo >> 1; kvh = combo & 1; hq = idx >> 5; qb = idx & 31; seq_row0 = NPROMPT + s * SS; seqlen = SS; }
                else { const int u2 = u - 1024; const int combo = u2 >> 5, idx = u2 & 31; const int s = combo >> 1; kvh = combo & 1; hq = idx >> 3; qb = idx & 7; seq_row0 = s * SP; seqlen = SP; }
            }
            const int h = kvh * 4 + hq; const long r0 = (long)seq_row0 + qb * 256;
            attn::attn_dense_body(QB + r0 * 1024 + h * 128, KVB + (long)seq_row0 * 512 + kvh * 128, KVB + (long)seq_row0 * 512 + 256 + kvh * 128,
                                  GA + r0 * 1024 + h * 128, MG + r0 * 2048 + h * 128, SSQA + r0 * 8 + h, q_norm_w, TAB, kwmax, wave, qb * 256, seqlen, (LAS char*)(L + RING_OFF), (LAS char*)(L + LDSCTL_OFF + 1024));
        }
        if (BOTH(3)) GRID_BAR();
    }

    if (IN(4)) {
        pg8::Gemm g{AG, BTM, KA, KA, KA, (size_t)NCHUNK * KA, (size_t)1024 * KA}; pg8::BatchOrder S; S.init(NG, 4, 4, G, vcu, REPF(4));
        pg8::EpiSsm E{AG, d_skip, YB};
        pg8::gemm_phase<pg8::EpiSsm, pg8::BatchOrder, true, true>(L + RING_OFF, g, S, E, wave);
        if (BOTH(4)) GRID_BAR();
    }

    if (IN(5)) {
        pg8::Gemm g{YB, WGLUT, 1024, 1024, 1024, 0, 0}; pg8::StaticOrder S; S.init(NTOK, 1024, G, bx, REPF(5));
        pg8::EpiGlu E{YB, GS, MG, SSQS};
        pg8::gemm_phase<pg8::EpiGlu, pg8::StaticOrder, true, true>(L + RING_OFF, g, S, E, wave);
        if (BOTH(5)) GRID_BAR();
    }

    if (IN(6)) {
        PHASE_IDS();
        for (int r = (vcu * NWAVES * 64) + tid; r < NTOK; r += G * NWAVES * 64) {
            const f32x4 a0 = *(const f32x4*)(SSQA + (size_t)r * 8), a1 = *(const f32x4*)(SSQA + (size_t)r * 8 + 4);
            const float sa = ((a0[0] + a0[1]) + (a0[2] + a0[3])) + ((a1[0] + a1[1]) + (a1[2] + a1[3]));
            float sb = 0.f;
#pragma unroll
            for (int q = 0; q < 4; ++q) { const f32x4 b = *(const f32x4*)(SSQS + (size_t)r * 16 + 4 * q); sb += (b[0] + b[1]) + (b[2] + b[3]); }
            const float ra = 1.0f / sqrtf(sa * (1.0f / 1024.0f) + EPS), rsv = 1.0f / sqrtf(sb * (1.0f / 1024.0f) + EPS);
            RATIO[r] = ra / rsv; RSN[r] = rsv;
        }
        if (BOTH(6)) GRID_BAR();
    }

    if (IN(7)) {
        pg8::Gemm g{MG, WOUTT, 2048, 2048, 2048, 0, 0}; pg8::StaticOrder S; S.init(NTOK, DM, G, bx, REPF(7));
        pg8::EpiOut E{x_p, x_s, args.out, RATIO, RSN};
        pg8::gemm_phase<pg8::EpiOut, pg8::StaticOrder, true, true>(L + RING_OFF, g, S, E, wave);
    }
#undef IN
#undef BOTH
#undef GRID_BAR
}

extern "C" void kernel_launch(void* const* d_in, const int* in_sizes, int n_in, void* d_out, int out_size, void* d_ws, size_t ws_size, hipStream_t stream) {
    static int grid = 0;
    if (grid == 0) {
        if (n_in != 18 || out_size != NTOK * DM || ws_size < WS_NEED) { fprintf(stderr, "kernel_launch: unexpected shapes (n_in %d out %d ws %zu)\n", n_in, out_size, ws_size); grid = -1; return; }
        int dev = 0, cus = 0, per_cu = 0;
        if (hipGetDevice(&dev) != hipSuccess || hipDeviceGetAttribute(&cus, hipDeviceAttributeMultiprocessorCount, dev) != hipSuccess) { grid = -1; return; }
        if (hipFuncSetAttribute((const void*)enc_fwd, hipFuncAttributeMaxDynamicSharedMemorySize, LDS_BYTES) != hipSuccess) { fprintf(stderr, "kernel_launch: hipFuncSetAttribute failed\n"); grid = -1; return; }
        if (hipOccupancyMaxActiveBlocksPerMultiprocessor(&per_cu, (const void*)enc_fwd, NWAVES * 64, LDS_BYTES) != hipSuccess || per_cu < 1) { fprintf(stderr, "kernel_launch: occupancy query says %d\n", per_cu); }
        (void)hipGetLastError();
        grid = cus;
    }
    if (grid < 0) return;
    (void)hipMemsetAsync((char*)d_ws + WS_CTL, 0, CTL_ZERO_BYTES, stream);
    Args a{};
    for (int i = 0; i < 18; ++i) a.in[i] = (const float*)d_in[i];
    a.out = (float*)d_out; a.ws = (unsigned char*)d_ws;
    for (int li = 0; li < N_LAUNCHES; ++li) {
        a.ph_lo = (N_LAUNCHES == NPH) ? li : 0; a.ph_hi = (N_LAUNCHES == NPH) ? li + 1 : NPH; a.li = (N_LAUNCHES == NPH) ? 0 : li;
        hipLaunchKernelGGL(enc_fwd, dim3(grid), dim3(NWAVES * 64), LDS_BYTES, stream, a);
    }
}
```

```cpp
#include <hip/hip_runtime.h>
#include <hip/hip_bf16.h>
#include <cstdio>
#include <cstdint>
#include <cmath>

#ifndef MK_N_LAUNCHES
#define MK_N_LAUNCHES 1
#endif
constexpr int NPH = 8;
constexpr int N_LAUNCHES = MK_N_LAUNCHES;

constexpr int DM = 2048, NTOK = 65536, NPROMPT = 32768, SP = 2048, SS = 8192;
constexpr int INC = 4608;
constexpr int NG = 64, NPST = 64, NCH = 16, CT = 32, NCHUNK = NTOK / CT;
constexpr int UC = CT * NCH;
constexpr int KA = UC + 4 * NPST;
constexpr int TB4 = CT / 4;
constexpr float EPS = 1e-6f;

#define GAS __attribute__((address_space(1)))
#define LAS __attribute__((address_space(3)))
typedef unsigned short bf16_t;
typedef short bf16x8 __attribute__((ext_vector_type(8)));
typedef float f32x4 __attribute__((ext_vector_type(4)));
typedef float f32x2 __attribute__((ext_vector_type(2)));
typedef unsigned u32x4 __attribute__((ext_vector_type(4)));
typedef unsigned u32x2 __attribute__((ext_vector_type(2)));
typedef GAS unsigned gu32;

__device__ __forceinline__ unsigned cvt_pk_bf16(float lo, float hi) { unsigned r; asm volatile("v_cvt_pk_bf16_f32 %0, %1, %2" : "=v"(r) : "v"(lo), "v"(hi)); return r; }
__device__ __forceinline__ float bf2f(unsigned short b) { return __uint_as_float(((unsigned)b) << 16); }
__device__ __forceinline__ float bflo(unsigned w) { return __uint_as_float(w << 16); }
__device__ __forceinline__ float bfhi(unsigned w) { return __uint_as_float(w & 0xffff0000u); }
__device__ __forceinline__ float fast_sigmoid(float x) { return __builtin_amdgcn_rcpf(1.0f + __builtin_amdgcn_exp2f(-1.4426950408889634f * x)); }
__device__ __forceinline__ float silu_f(float x) { return x * fast_sigmoid(x); }
__device__ __forceinline__ float gelu_tanh(float x) { const float z = 0.7978845608028654f * (x + 0.044715f * x * x * x); return x * fast_sigmoid(2.0f * z); }

__device__ __forceinline__ int fresh_lane() { int l; asm volatile("v_mbcnt_lo_u32_b32 %0, -1, 0\n\tv_mbcnt_hi_u32_b32 %0, -1, %0" : "=v"(l)); return l; }

namespace pg8 {
#define PG8_LAS __attribute__((address_space(3)))
constexpr int BM = 256, BK = 64, HALF = 128, HTB = HALF * BK * 2, STAGE_BYTES = 8 * HTB, NXCD = 8, WGM = 8;
__host__ __device__ __forceinline__ int lds_byte(int r, int c) { const int st = (r >> 4) * 2 + (c >> 5), rr = r & 15, cc = c & 31, ob = rr * 64 + cc * 2; return st * 1024 + (ob ^ (((ob >> 9) & 1) << 5)); }
__host__ __device__ __forceinline__ void stage_rc(int b, int& R, int& C) { const int st = b / 1024, sb = b % 1024, swz = sb ^ (((sb >> 9) & 1) << 5); R = (st >> 1) * 16 + swz / 64; C = (st & 1) * 32 + (swz % 64) / 2; }
__host__ __device__ __forceinline__ int perm32(int rho) { const int n = rho >> 4, i = rho & 15; return 8 * (i >> 2) + 4 * n + (i & 3); }

struct Unit { int pm, pn, g; };
struct Gemm { const bf16_t* A; const bf16_t* Bt; int lda, ldb, K; size_t gsA, gsB; };

struct StaticOrder {
    int nM, nN, nwg, G, c, rep;
    __host__ __device__ void init(int M, int N, int G_, int c_, int rep_ = 1) { nM = M / BM; nN = N / BM; nwg = nM * nN; G = G_; c = c_; rep = rep_; }
    __host__ __device__ bool next(int i, Unit& u) const {
        if (rep > 1) { const int rounds = (nwg + G - 1) / G; if (i >= rounds * rep) return false; i = i % rounds; }
        const long L = (long)i * G + c; if (L >= nwg) return false;
        int wgid = (int)L; { const int q = nwg / NXCD, r = nwg % NXCD, xcd = wgid % NXCD, off = wgid / NXCD; wgid = (xcd < r ? xcd * (q + 1) : r * (q + 1) + (xcd - r) * q) + off; }
        const int nig = WGM * nN, gid = wgid / nig, fm = gid * WGM, gsz = (nM - fm) < WGM ? (nM - fm) : WGM;
        u.pm = fm + ((wgid % nig) % gsz); u.pn = (wgid % nig) / gsz; u.g = 0; return true;
    }
};
struct BatchOrder {
    int nPm, nPn, ntot, G, vcu, rep;
    __host__ __device__ void init(int nb, int nPm_, int nPn_, int G_, int vcu_, int rep_ = 1) { nPm = nPm_; nPn = nPn_; ntot = nb * nPm_ * nPn_; G = G_; vcu = vcu_; rep = rep_; }
    __host__ __device__ bool next(int i, Unit& u) const {
        if (rep > 1) { const int rounds = (ntot + G - 1) / G; if (i >= rounds * rep) return false; i = i % rounds; }
        const long L = (long)i * G + vcu; if (L >= ntot) return false;
        const int per = nPm * nPn, l = (int)L; u.g = l / per; const int t = l % per; u.pm = t / nPn; u.pn = t % nPn; return true;
    }
};

template <class Epi, class Sched, bool ALIGN_EPI = false, bool SP2 = true>
__device__ __forceinline__ void gemm_phase(PG8_LAS unsigned char* lds, const Gemm g, const Sched& S, const Epi& E, int wave_s) {
    const int wid = wave_s, lane = fresh_lane(), tid = wid * 64 + lane, wr = wid >> 2, wc = wid & 3, fr = lane & 15, fq = lane >> 4;
    const int K = g.K, nt = K / BK;
    unsigned voffA[2], voffB[2];
#pragma unroll
    for (int i = 0; i < 2; ++i) { int R, C; stage_rc(tid * 16 + i * 8192, R, C); const int Rb = Epi::PERM ? ((R & ~31) + perm32(R & 31)) : R;
        voffA[i] = (unsigned)(R * g.lda + C) * 2u; voffB[i] = (unsigned)(Rb * g.ldb + C) * 2u; }
    const size_t kstep = (size_t)(BK * 2);
    const size_t hstepA = (size_t)HALF * g.lda * 2, hstepB = (size_t)HALF * g.ldb * 2;
    const size_t tstepA = 2 * hstepA, tstepB = 2 * hstepB;
    const unsigned ldsw = (unsigned)wid * 1024u;
    const int aoff = lds_byte(wr * 64 + fr, fq * 8), boff = lds_byte(wc * 32 + fr, fq * 8);
#define PG8_SA(b, h) (((b) * 2 + (h)) * HTB)
#define PG8_SB(b, h) ((4 + (b) * 2 + (h)) * HTB)
#define PG8_STAGE(bufoff, gbase, voff) do { _Pragma("unroll") for (int _i = 0; _i < 2; ++_i) \
        __builtin_amdgcn_global_load_lds((const unsigned*)((const char*)(gbase) + (voff)[_i]), (PG8_LAS unsigned*)(lds + (bufoff) + ldsw + _i * 8192), 16, 0, 0); } while (0)
#define PG8_LDA(dst, b, h) do { _Pragma("unroll") for (int m = 0; m < 4; ++m) _Pragma("unroll") for (int k = 0; k < 2; ++k) dst[m][k] = *(const PG8_LAS bf16x8*)(lds + PG8_SA(b, h) + aoff + m * 2048 + k * 1024); } while (0)
#define PG8_LDB(dst, b, h) do { _Pragma("unroll") for (int n = 0; n < 2; ++n) _Pragma("unroll") for (int k = 0; k < 2; ++k) dst[n][k] = *(const PG8_LAS bf16x8*)(lds + PG8_SB(b, h) + boff + n * 2048 + k * 1024); } while (0)
#define PG8_MMA(ai, bj, At, Bt) do { __builtin_amdgcn_s_setprio(1); _Pragma("unroll") for (int m = 0; m < 4; ++m) _Pragma("unroll") for (int n = 0; n < 2; ++n) _Pragma("unroll") for (int k = 0; k < 2; ++k) \
        acc[ai][bj][m][n] = __builtin_amdgcn_mfma_f32_16x16x32_bf16(Bt[n][k], At[m][k], acc[ai][bj][m][n], 0, 0, 0); __builtin_amdgcn_s_setprio(0); } while (0)
#define PG8_WAIT_V(n) asm volatile("s_waitcnt vmcnt(" #n ")" ::: "memory")
#define PG8_WAIT_L(n) asm volatile("s_waitcnt lgkmcnt(" #n ")" ::: "memory")
#define PG8_BAR __builtin_amdgcn_s_barrier()
#define PG8_SCHED __builtin_amdgcn_sched_barrier(0)
    Unit cur, nxt; int ui = 0;
    if (!S.next(0, cur)) return;
    f32x4 acc[2][2][4][2];
#pragma unroll
    for (int a = 0; a < 2; ++a)
#pragma unroll
        for (int b = 0; b < 2; ++b)
#pragma unroll
            for (int m = 0; m < 4; ++m)
#pragma unroll
                for (int n = 0; n < 2; ++n) acc[a][b][m][n] = (f32x4){0.f, 0.f, 0.f, 0.f};
    bf16x8 At[4][2], B0[2][2], B1[2][2];
    const char* cA = (const char*)(g.A + (size_t)cur.g * g.gsA) + (size_t)cur.pm * tstepA; const char* cB = (const char*)(g.Bt + (size_t)cur.g * g.gsB) + (size_t)cur.pn * tstepB;
    static_assert(SP2, "only the SP2 loop is kept in this file");
    PG8_STAGE(PG8_SB(0, 0), cB, voffB); PG8_STAGE(PG8_SB(0, 1), cB + hstepB, voffB); PG8_STAGE(PG8_SA(0, 0), cA, voffA); PG8_STAGE(PG8_SA(0, 1), cA + hstepA, voffA);
    if (wr == 1) PG8_BAR;
    PG8_WAIT_V(2); PG8_BAR;
    PG8_STAGE(PG8_SB(1, 0), cB + kstep, voffB); PG8_STAGE(PG8_SA(1, 0), cA + kstep, voffA); PG8_STAGE(PG8_SB(1, 1), cB + hstepB + kstep, voffB);
    PG8_WAIT_V(6); PG8_BAR;
    for (;;) {
        const bool has_next = S.next(ui + 1, nxt);
        const char* nA = has_next ? (const char*)(g.A + (size_t)nxt.g * g.gsA) + (size_t)nxt.pm * tstepA : cA;
        const char* nB = has_next ? (const char*)(g.Bt + (size_t)nxt.g * g.gsB) + (size_t)nxt.pn * tstepB : cB;
        for (int t = 0; t < nt; t += 2) {
            const bool last = (t == nt - 2);
            const char* a1 = cA + (size_t)(t + 1) * kstep;
            const char* a2 = last ? nA : cA + (size_t)(t + 2) * kstep; const char* b2 = last ? nB : cB + (size_t)(t + 2) * kstep;
            const char* a3 = a2 + kstep; const char* b3 = b2 + kstep;
            if constexpr (Epi::MIDK) { if (t == (nt >> 1)) E.midk(acc, cur, wr, wc, fr, fq); }
            PG8_LDB(B0, 0, 0); PG8_LDB(B1, 0, 1); PG8_SCHED; PG8_LDA(At, 0, 0); PG8_STAGE(PG8_SA(1, 1), a1 + hstepA, voffA);
            PG8_WAIT_V(8); PG8_WAIT_L(0); PG8_BAR; PG8_MMA(0, 0, At, B0); PG8_MMA(0, 1, At, B1); PG8_BAR; PG8_SCHED;
            PG8_LDA(At, 0, 1); PG8_STAGE(PG8_SB(0, 0), b2, voffB); PG8_STAGE(PG8_SB(0, 1), b2 + hstepB, voffB); PG8_STAGE(PG8_SA(0, 0), a2, voffA);
            PG8_WAIT_V(8); PG8_WAIT_L(0); PG8_BAR; PG8_MMA(1, 0, At, B0); PG8_MMA(1, 1, At, B1); PG8_BAR; PG8_SCHED;
            PG8_LDB(B0, 1, 0); PG8_LDB(B1, 1, 1); PG8_SCHED; PG8_LDA(At, 1, 0); PG8_STAGE(PG8_SA(0, 1), a2 + hstepA, voffA);
            PG8_WAIT_V(8); PG8_WAIT_L(0); PG8_BAR; PG8_MMA(0, 0, At, B0); PG8_MMA(0, 1, At, B1); PG8_BAR; PG8_SCHED;
            PG8_LDA(At, 1, 1); PG8_STAGE(PG8_SB(1, 0), b3, voffB); PG8_STAGE(PG8_SB(1, 1), b3 + hstepB, voffB); PG8_STAGE(PG8_SA(1, 0), a3, voffA);
            PG8_WAIT_V(8); PG8_WAIT_L(0); PG8_BAR; PG8_MMA(1, 0, At, B0); PG8_MMA(1, 1, At, B1); PG8_BAR; PG8_SCHED;
        }
        if constexpr (ALIGN_EPI) { if (wr == 0) PG8_BAR; }
        E(acc, cur, wr, wc, fr, fq);
#if defined(EPI_REP_PROBE)
        if (Epi::PROBE_ID == EPI_REP_PROBE) { asm volatile("" ::: "memory"); E(acc, cur, wr, wc, fr, fq); }
#endif
        if (!has_next) break;
#pragma unroll
        for (int a = 0; a < 2; ++a)
#pragma unroll
            for (int b = 0; b < 2; ++b)
#pragma unroll
                for (int m = 0; m < 4; ++m)
#pragma unroll
                    for (int n = 0; n < 2; ++n) acc[a][b][m][n] = (f32x4){0.f, 0.f, 0.f, 0.f};
        cur = nxt; cA = nA; cB = nB; ++ui;
        if constexpr (ALIGN_EPI) { if (wr == 1) PG8_BAR; }
    }
    PG8_WAIT_V(0);
    if constexpr (!ALIGN_EPI) { if (wr == 0) PG8_BAR; }
    PG8_BAR;
#undef PG8_SA
#undef PG8_SB
#undef PG8_STAGE
#undef PG8_LDA
#undef PG8_LDB
#undef PG8_MMA
#undef PG8_WAIT_V
#undef PG8_WAIT_L
#undef PG8_BAR
#undef PG8_SCHED
}

__device__ __forceinline__ u32x4 pack8(const f32x4 v0, const f32x4 v1) { u32x4 w; w.x = cvt_pk_bf16(v0[0], v0[1]); w.y = cvt_pk_bf16(v0[2], v0[3]); w.z = cvt_pk_bf16(v1[0], v1[1]); w.w = cvt_pk_bf16(v1[2], v1[3]); return w; }

struct EpiInProj {
    static constexpr int PROBE_ID = 1;
    static constexpr bool PERM = true, MIDK = false;
    const float* rs; bf16_t *Q, *KV, *GA, *GS, *AG;
    __device__ __forceinline__ void operator()(const f32x4 (&acc)[2][2][4][2], const Unit& u, int wr, int wc, int fr, int fq) const {
        const int pn = u.pn; const int row0 = u.pm * BM + wr * 64 + fr; const int colt = pn * BM + wc * 32 + 8 * fq;
        int kind = 0, ld = 1024, cb = colt; bf16_t* base = Q;
        if (pn >= 4 && pn < 6) { base = KV; ld = 512; cb = colt - 1024; }
        else if (pn >= 6 && pn < 10) { base = GA; cb = colt - 1536; kind = 1; }
        else if (pn >= 10 && pn < 14) { base = AG; cb = colt - 2560; kind = 2; }
        else if (pn >= 14) { base = GS; cb = colt - 3584; kind = 1; }
        float rsv[2][4];
#pragma unroll
        for (int ai = 0; ai < 2; ++ai)
#pragma unroll
            for (int m = 0; m < 4; ++m) rsv[ai][m] = rs[row0 + ai * HALF + m * 16];
#pragma unroll
        for (int ai = 0; ai < 2; ++ai)
#pragma unroll
            for (int m = 0; m < 4; ++m) { const int r = row0 + ai * HALF + m * 16; const float s = rsv[ai][m];
#pragma unroll
                for (int bj = 0; bj < 2; ++bj) { f32x4 v0 = acc[ai][bj][m][0] * s, v1 = acc[ai][bj][m][1] * s;
                    if (kind == 1) {
#pragma unroll
                        for (int e = 0; e < 4; ++e) { v0[e] = silu_f(v0[e]); v1[e] = silu_f(v1[e]); } }
                    const int c = cb + bj * HALF; size_t off;
                    if (kind == 2) off = ((size_t)((c >> 4) * NCHUNK + (r / CT))) * KA + (size_t)((r % CT) * 16 + (c & 15));
                    else off = (size_t)r * ld + c;
                    *(u32x4*)(base + off) = pack8(v0, v1); } }
    }
};
struct EpiLR {
    static constexpr int PROBE_ID = 2;
    static constexpr bool PERM = false, MIDK = false;
    float* LR;
    __device__ __forceinline__ void operator()(const f32x4 (&acc)[2][2][4][2], const Unit& u, int wr, int wc, int fr, int fq) const {
        const int row0 = u.pm * BM + wr * 64 + fr, col0 = wc * 32 + 4 * fq;
#pragma unroll
        for (int ai = 0; ai < 2; ++ai)
#pragma unroll
            for (int m = 0; m < 4; ++m) { float* rowp = LR + ((size_t)u.g * NCHUNK + row0 + ai * HALF + m * 16) * 256 + col0;
#pragma unroll
                for (int bj = 0; bj < 2; ++bj)
#pragma unroll
                    for (int n = 0; n < 2; ++n) *(f32x4*)(rowp + bj * HALF + n * 16) = acc[ai][bj][m][n]; }
    }
};
struct EpiSsm {
    static constexpr int PROBE_ID = 4;
    static constexpr bool PERM = true, MIDK = false;
    bf16_t* Y;
    __device__ __forceinline__ void operator()(const f32x4 (&acc)[2][2][4][2], const Unit& u, int wr, int wc, int fr, int fq) const {
        const int ch0 = u.pm * BM + wr * 64 + fr, n00 = u.pn * BM + wc * 32 + 8 * fq; const int g = u.g;
        const int co0 = n00 & 15;
#pragma unroll
        for (int ai = 0; ai < 2; ++ai)
#pragma unroll
            for (int m = 0; m < 4; ++m) { const int ch = ch0 + ai * HALF + m * 16;
#pragma unroll
                for (int bj = 0; bj < 2; ++bj) { const int n0 = n00 + bj * HALF, j = n0 >> 4;
                    f32x4 v0 = acc[ai][bj][m][0], v1 = acc[ai][bj][m][1];
#pragma unroll
                    for (int e = 0; e < 4; ++e) { v0[e] = gelu_tanh(v0[e]); v1[e] = gelu_tanh(v1[e]); }
                    *(u32x4*)(Y + ((size_t)ch * CT + j) * 1024 + g * 16 + co0) = pack8(v0, v1); } }
    }
};
struct EpiGlu {
    static constexpr int PROBE_ID = 5;
    static constexpr bool PERM = true, MIDK = false;
    const bf16_t* Y; const bf16_t* GS; bf16_t* MG; float* SSQS;
    __device__ __forceinline__ void operator()(const f32x4 (&acc)[2][2][4][2], const Unit& u, int wr, int wc, int fr, int fq) const {
        const int row0 = u.pm * BM + wr * 64 + fr, c00 = u.pn * BM + wc * 32 + 8 * fq;
#pragma unroll
        for (int ai = 0; ai < 2; ++ai) {
            u32x4 yw[4][2], gw[4][2];
#pragma unroll
            for (int m = 0; m < 4; ++m) { const int r = row0 + ai * HALF + m * 16;
#pragma unroll
                for (int bj = 0; bj < 2; ++bj) { const int c = c00 + bj * HALF; yw[m][bj] = *(const u32x4*)(Y + (size_t)r * 1024 + c); gw[m][bj] = *(const u32x4*)(GS + (size_t)r * 1024 + c); } }
#pragma unroll
            for (int m = 0; m < 4; ++m) { const int r = row0 + ai * HALF + m * 16; float ss = 0.f;
#pragma unroll
                for (int bj = 0; bj < 2; ++bj) { const int c = c00 + bj * HALF; const u32x4 y4 = yw[m][bj], g4 = gw[m][bj];
                    const f32x4 a0 = acc[ai][bj][m][0], a1 = acc[ai][bj][m][1]; f32x4 v0, v1;
                    v0[0] = bflo(y4.x) * fast_sigmoid(a0[0]) * bflo(g4.x); v0[1] = bfhi(y4.x) * fast_sigmoid(a0[1]) * bfhi(g4.x);
                    v0[2] = bflo(y4.y) * fast_sigmoid(a0[2]) * bflo(g4.y); v0[3] = bfhi(y4.y) * fast_sigmoid(a0[3]) * bfhi(g4.y);
                    v1[0] = bflo(y4.z) * fast_sigmoid(a1[0]) * bflo(g4.z); v1[1] = bfhi(y4.z) * fast_sigmoid(a1[1]) * bfhi(g4.z);
                    v1[2] = bflo(y4.w) * fast_sigmoid(a1[2]) * bflo(g4.w); v1[3] = bfhi(y4.w) * fast_sigmoid(a1[3]) * bfhi(g4.w);
#pragma unroll
                    for (int e = 0; e < 4; ++e) ss += v0[e] * v0[e] + v1[e] * v1[e];
                    *(u32x4*)(MG + (size_t)r * 2048 + 1024 + c) = pack8(v0, v1); }
                ss += __shfl_xor(ss, 16); ss += __shfl_xor(ss, 32);
                if (fq == 0) SSQS[(size_t)r * 16 + u.pn * 4 + wc] = ss; } }
    }
};
struct EpiOut {
    static constexpr int PROBE_ID = 7;
    static constexpr bool PERM = false, MIDK = true;
    const float* xp; const float* xs; float* out; const float* ratio; const float* rsn;
    __device__ __forceinline__ void midk(f32x4 (&acc)[2][2][4][2], const Unit& u, int wr, int wc, int fr, int fq) const {
        const int row0 = u.pm * BM + wr * 64 + fr;
#pragma unroll
        for (int ai = 0; ai < 2; ++ai)
#pragma unroll
            for (int m = 0; m < 4; ++m) { const float s = ratio[row0 + ai * HALF + m * 16];
#pragma unroll
                for (int bj = 0; bj < 2; ++bj)
#pragma unroll
                    for (int n = 0; n < 2; ++n) acc[ai][bj][m][n] *= s; }
    }
    __device__ __forceinline__ void operator()(const f32x4 (&acc)[2][2][4][2], const Unit& u, int wr, int wc, int fr, int fq) const {
        const int row0 = u.pm * BM + wr * 64 + fr, col0 = u.pn * BM + wc * 32 + 4 * fq;
#pragma unroll
        for (int ai = 0; ai < 2; ++ai) {
            f32x4 xv[4][2][2]; float sv[4];
#pragma unroll
            for (int m = 0; m < 4; ++m) { const int r = row0 + ai * HALF + m * 16; sv[m] = rsn[r];
                const float* xr = (r < NPROMPT ? xp + (size_t)r * DM : xs + (size_t)(r - NPROMPT) * DM) + col0;
#pragma unroll
                for (int bj = 0; bj < 2; ++bj)
#pragma unroll
                    for (int n = 0; n < 2; ++n) xv[m][bj][n] = *(const f32x4*)(xr + bj * HALF + n * 16); }
#pragma unroll
            for (int m = 0; m < 4; ++m) { const int r = row0 + ai * HALF + m * 16; float* orow = out + (size_t)r * DM + col0;
#pragma unroll
                for (int bj = 0; bj < 2; ++bj)
#pragma unroll
                    for (int n = 0; n < 2; ++n) *(f32x4*)(orow + bj * HALF + n * 16) = xv[m][bj][n] + acc[ai][bj][m][n] * sv[m]; } }
    }
};
}

namespace attn {
using bf16 = __hip_bfloat16;
constexpr int D = 128, NW = 8, QBLK = 32, KVBLK = 64;
constexpr float SCALE = 0.088388347648318440f;
constexpr float THR = 8.f;
constexpr int SDEPTH = 1;
constexpr int LDQ = 1024, LDK = 512, LDO = 2048;
constexpr size_t SHM_V = KVBLK * D * 2, SHM_K = KVBLK * D * 2, SHM_ATTN = 4 * SHM_V + 4 * SHM_K;
using s16x4 = __attribute__((ext_vector_type(4))) short;
using f32x16 = __attribute__((ext_vector_type(16))) float;
#define KSWZ(row, colB) ((row) * 256 + ((colB) ^ (((row) & 15) << 4)))
#define SBAR() __builtin_amdgcn_sched_barrier(0)
__device__ __forceinline__ int crow(int r, int hi) { return (r & 3) + 8 * (r >> 2) + 4 * hi; }
__device__ __forceinline__ unsigned cvtpk(float lo, float hi) { unsigned r; asm volatile("v_cvt_pk_bf16_f32 %0, %1, %2" : "=v"(r) : "v"(lo), "v"(hi)); return r; }
template <bool SHIFT> __device__ __forceinline__ void softmax_tile(f32x16& p0, f32x16& p1, float& l_part, bf16x8& pa0, bf16x8& pa1, bf16x8& pa2, bf16x8& pa3, float msub) {
  for (int r = 0; r < 16; ++r) p0[r] = __builtin_amdgcn_exp2f(SHIFT ? p0[r] - msub : p0[r]);
  for (int r = 0; r < 16; ++r) p1[r] = __builtin_amdgcn_exp2f(SHIFT ? p1[r] - msub : p1[r]);
  float ps = 0; for (int r = 0; r < 16; ++r) ps += p0[r]; for (int r = 0; r < 16; ++r) ps += p1[r];
  l_part += ps;
#define PK4(P, BASE, OUT) do { unsigned a0 = cvtpk(P[BASE + 0], P[BASE + 1]), a1 = cvtpk(P[BASE + 2], P[BASE + 3]);   \
    unsigned b0 = cvtpk(P[BASE + 4], P[BASE + 5]), b1 = cvtpk(P[BASE + 6], P[BASE + 7]);                              \
    auto r0 = __builtin_amdgcn_permlane32_swap(a0, b0, false, false); auto r1 = __builtin_amdgcn_permlane32_swap(a1, b1, false, false); \
    u32x4 w = {r0[0], r1[0], r0[1], r1[1]}; OUT = *reinterpret_cast<bf16x8*>(&w); } while (0)
  PK4(p0, 0, pa0); PK4(p0, 8, pa1); PK4(p1, 0, pa2); PK4(p1, 8, pa3);
#undef PK4
}
__device__ __forceinline__ int v_st(int k, int c) { const int kk = (k & ~0xC) | ((k & 4) << 1) | ((k & 8) >> 1); return ((kk >> 3) * 4 + (c >> 5)) * 512 + ((kk & 7) * 32 + (c & 31)) * 2; }
__device__ __forceinline__ int v_rd_base(int lane) { return ((lane & 3) << 3) | (((lane >> 2) & 3) << 6) | (((lane >> 4) & 1) << 5) | (((lane >> 5) & 1) << 8); }
constexpr int v_rd_off(int d0, int ks, int half) { return d0 * 512 + ks * 4096 + half * 2048; }
__device__ __forceinline__ void glds16s(unsigned voff, const void* sbase, unsigned lds_dst) { unsigned keep;
  asm volatile("s_mov_b32 %0, m0\n\ts_mov_b32 m0, %3\n\ts_nop 0\n\tglobal_load_lds_dwordx4 %1, %2\n\ts_mov_b32 m0, %0" : "=&s"(keep) : "v"(voff), "s"(sbase), "s"(lds_dst) : "memory"); }
template <int OFF> __device__ __forceinline__ s16x4 tr_read(int vb) {
  s16x4 r; asm volatile("ds_read_b64_tr_b16 %0, %1 offset:%2" : "=&v"(r) : "v"(vb), "i"(OFF) : "memory"); return r;
}
struct VFrag { s16x4 l0, h0, l1, h1, l2, h2, l3, h3; };
template <int D0, int SO> __device__ __forceinline__ void v_read8(VFrag& f, int vb) {
  f.l0 = tr_read<SO + v_rd_off(D0, 0, 0)>(vb); f.h0 = tr_read<SO + v_rd_off(D0, 0, 1)>(vb); f.l1 = tr_read<SO + v_rd_off(D0, 1, 0)>(vb); f.h1 = tr_read<SO + v_rd_off(D0, 1, 1)>(vb);
  f.l2 = tr_read<SO + v_rd_off(D0, 2, 0)>(vb); f.h2 = tr_read<SO + v_rd_off(D0, 2, 1)>(vb); f.l3 = tr_read<SO + v_rd_off(D0, 3, 0)>(vb); f.h3 = tr_read<SO + v_rd_off(D0, 3, 1)>(vb);
}
__device__ __forceinline__ void pv_mma4(f32x16& od, const VFrag& f, bf16x8 pa0, bf16x8 pa1, bf16x8 pa2, bf16x8 pa3) {
#define PK(L, H) (bf16x8){L[0], L[1], L[2], L[3], H[0], H[1], H[2], H[3]}
  __builtin_amdgcn_s_setprio(1);
  od = __builtin_amdgcn_mfma_f32_32x32x16_bf16(pa0, PK(f.l0, f.h0), od, 0, 0, 0);
  od = __builtin_amdgcn_mfma_f32_32x32x16_bf16(pa1, PK(f.l1, f.h1), od, 0, 0, 0);
  od = __builtin_amdgcn_mfma_f32_32x32x16_bf16(pa2, PK(f.l2, f.h2), od, 0, 0, 0);
  od = __builtin_amdgcn_mfma_f32_32x32x16_bf16(pa3, PK(f.l3, f.h3), od, 0, 0, 0);
  __builtin_amdgcn_s_setprio(0);
#undef PK
}
template <int SO> __device__ __forceinline__ void pv_d0(f32x16* o, int vb, bf16x8 pa0, bf16x8 pa1, bf16x8 pa2, bf16x8 pa3) {
  VFrag fa, fb;
  v_read8<0, SO>(fa, vb);
  v_read8<1, SO>(fb, vb); asm volatile("s_waitcnt lgkmcnt(8)" ::: "memory"); SBAR(); pv_mma4(o[0], fa, pa0, pa1, pa2, pa3); SBAR();
  v_read8<2, SO>(fa, vb); asm volatile("s_waitcnt lgkmcnt(8)" ::: "memory"); SBAR(); pv_mma4(o[1], fb, pa0, pa1, pa2, pa3); SBAR();
  v_read8<3, SO>(fb, vb); asm volatile("s_waitcnt lgkmcnt(8)" ::: "memory"); SBAR(); pv_mma4(o[2], fa, pa0, pa1, pa2, pa3); SBAR();
  asm volatile("s_waitcnt lgkmcnt(0)" ::: "memory"); SBAR(); pv_mma4(o[3], fb, pa0, pa1, pa2, pa3);
}

__device__ __forceinline__ void attn_q_prologue(const bf16_t* __restrict__ Qb, const float* __restrict__ qnw, const f32x2* __restrict__ tab, float kmaxc, int pos0,
                                                int wid, int r32, int hi, bf16x8 (&qr)[8], float& mshift) {
    const bf16_t* Qw = Qb + (long)(wid * QBLK + r32) * LDQ + hi * 8;
    u32x4 raw[8]; float ss = 0.f;
#pragma unroll
    for (int d0 = 0; d0 < 8; ++d0) raw[d0] = *reinterpret_cast<const u32x4*>(Qw + d0 * 16);
#pragma unroll
    for (int d0 = 0; d0 < 8; ++d0) {
#pragma unroll
      for (int q = 0; q < 4; ++q) { const float a = bflo(raw[d0][q]), b = bfhi(raw[d0][q]); ss += a * a + b * b; } }
    { auto rr = __builtin_amdgcn_permlane32_swap(__float_as_uint(ss), __float_as_uint(ss), false, false); ss = __uint_as_float(rr[0]) + __uint_as_float(rr[1]); }
    const float rn = (SCALE * 1.4426950408889634f) / sqrtf(ss * (1.0f / 128.0f) + EPS);
    float qn2 = 0.f;
    const int pos = pos0 + wid * QBLK + r32, prow = pos >> 6, pcol = pos & 63;
#pragma unroll
    for (int pg = 0; pg < 4; ++pg) { const int dd = pg & 1, ax = pg >> 1, d0 = ax * 4 + dd;
      const f32x2* tp = tab + (ax == 0 ? prow : pcol) * 32 + hi * 8 + dd * 16;
      const float* wa = qnw + d0 * 16 + hi * 8; const float* wb = wa + 32;
      float na[8], nb[8];
#pragma unroll
      for (int q = 0; q < 4; ++q) {
        const f32x2 c0 = tp[2 * q], c1 = tp[2 * q + 1];
        const float a0 = bflo(raw[d0][q]) * (rn * wa[2 * q]), a1 = bfhi(raw[d0][q]) * (rn * wa[2 * q + 1]);
        const float b0 = bflo(raw[d0 + 2][q]) * (rn * wb[2 * q]), b1 = bfhi(raw[d0 + 2][q]) * (rn * wb[2 * q + 1]);
        na[2 * q] = a0 * c0.x - b0 * c0.y; nb[2 * q] = b0 * c0.x + a0 * c0.y;
        na[2 * q + 1] = a1 * c1.x - b1 * c1.y; nb[2 * q + 1] = b1 * c1.x + a1 * c1.y;
        qn2 += (na[2 * q] * na[2 * q] + nb[2 * q] * nb[2 * q]) + (na[2 * q + 1] * na[2 * q + 1] + nb[2 * q + 1] * nb[2 * q + 1]); }
      { u32x4 w = {cvtpk(na[0], na[1]), cvtpk(na[2], na[3]), cvtpk(na[4], na[5]), cvtpk(na[6], na[7])}; qr[d0] = *reinterpret_cast<bf16x8*>(&w); }
      { u32x4 w = {cvtpk(nb[0], nb[1]), cvtpk(nb[2], nb[3]), cvtpk(nb[4], nb[5]), cvtpk(nb[6], nb[7])}; qr[d0 + 2] = *reinterpret_cast<bf16x8*>(&w); }
      asm volatile("" ::: "memory"); }
    { auto rr = __builtin_amdgcn_permlane32_swap(__float_as_uint(qn2), __float_as_uint(qn2), false, false); qn2 = __uint_as_float(rr[0]) + __uint_as_float(rr[1]); }
    mshift = fmaxf(sqrtf(qn2) * kmaxc - 40.0f, 0.0f);
}
template <bool SHIFT>
__device__ __forceinline__ void attn_main(const bf16_t* __restrict__ Kh, const bf16_t* __restrict__ Vh, const bf16_t* __restrict__ GAb, bf16_t* __restrict__ Ob, float* __restrict__ ssq,
                                          int seq, LAS char* lds, LAS char* lscr, int wave_s,
                                          const bf16_t* __restrict__ Qb, const float* __restrict__ qnw, const f32x2* __restrict__ tab, float kmaxc, int pos0) {
  const int lane = fresh_lane(), r32 = lane & 31, hi = lane >> 5;
  LAS char* const Vr = lds; LAS char* const Kr = lds + 4 * SHM_V;
  float l_reg = 0; f32x16 o[4] = {};
  unsigned ksrc[2], vsrc[2];
#pragma unroll
  for (int i = 0; i < 2; ++i) { const int p = 2 * wave_s + i;
    const int row = 4 * p + (lane >> 4), lc = (lane & 15) ^ (row & 15); ksrc[i] = (unsigned)(row * LDK + lc * 8) * 2u;
    const int st = 2 * p + (lane >> 5), q = lane & 31, kk = (st >> 2) * 8 + (q >> 2), k = (kk & ~0xC) | ((kk & 4) << 1) | ((kk & 8) >> 1), c = (st & 3) * 32 + (q & 3) * 8;
    vsrc[i] = (unsigned)(k * LDK + c) * 2u; }
  const unsigned ldsw = (unsigned)wave_s * 2048u;
  const int vb0 = (int)(uintptr_t)Vr + v_rd_base(lane);
  const LAS char* kp[8];
#pragma unroll
  for (int d0 = 0; d0 < 8; ++d0) kp[d0] = Kr + r32 * 256 + (((2 * d0 + hi) ^ (r32 & 15)) << 4);
#define DMA(T, TS) do { const char* kg = (const char*)Kh + (size_t)(T) * (KVBLK * LDK * 2); const char* vg = (const char*)Vh + (size_t)(T) * (KVBLK * LDK * 2); \
    const unsigned so = (unsigned)(uintptr_t)Vr + ((unsigned)(TS) & 3u) * (unsigned)SHM_K + ldsw; \
    glds16s(ksrc[0], kg, so + 4 * (unsigned)SHM_V); glds16s(vsrc[0], vg, so); glds16s(ksrc[1], kg, so + 4 * (unsigned)SHM_V + 1024u); glds16s(vsrc[1], vg, so + 1024u); } while (0)
#define WAITBAR(N) asm volatile("s_waitcnt vmcnt(" #N ") lgkmcnt(0)\n\ts_barrier" ::: "memory")
#define QKT(P0, P1, KSO) do { P0 = f32x16{}; P1 = f32x16{}; __builtin_amdgcn_s_setprio(1); \
    _Pragma("unroll") for (int d0 = 0; d0 < 8; ++d0) { const bf16x8 b0 = *(const LAS bf16x8*)(kp[d0] + (KSO)); \
      P0 = __builtin_amdgcn_mfma_f32_32x32x16_bf16(b0, qr[d0], P0, 0, 0, 0); } \
    _Pragma("unroll") for (int d0 = 0; d0 < 8; ++d0) { const bf16x8 b1 = *(const LAS bf16x8*)(kp[d0] + (KSO) + 8192); \
      P1 = __builtin_amdgcn_mfma_f32_32x32x16_bf16(b1, qr[d0], P1, 0, 0, 0); } __builtin_amdgcn_s_setprio(0); } while (0)
#define NEXTDMA(T) do { const int t2 = (T) + 2; DMA(t2 < NT ? t2 : t2 - NT, t2); } while (0)
#define SOFT() softmax_tile<SHIFT>(p0, p1, l_reg, pa0, pa1, pa2, pa3, mshift)
#define PV(T) pv_d0<0>(o, vb0 + ((T) & 3) * (int)SHM_V, pa0, pa1, pa2, pa3)
  f32x16 p0, p1; bf16x8 pa0, pa1, pa2, pa3; const int NT = seq / KVBLK;
  DMA(0, 0); DMA(1, 1);
  bf16x8 qr[8]; float mshift;
  attn_q_prologue(Qb, qnw, tab, kmaxc, pos0, wave_s, r32, hi, qr, mshift);
  if (!SHIFT) mshift = 0.f;
  if (wave_s < 4) {
    for (int j = 0; j < NT; ++j) {
      WAITBAR(4); NEXTDMA(j); SBAR();
      QKT(p0, p1, (j & 3) * (int)SHM_K); SBAR();
      SOFT(); SBAR();
      PV(j); SBAR();
    }
  } else {
    WAITBAR(4); NEXTDMA(0); SBAR();
    QKT(p0, p1, 0); SBAR();
    for (int j = 1; j < NT; ++j) {
      WAITBAR(4); NEXTDMA(j); SBAR();
      SOFT(); SBAR();
      PV(j - 1); SBAR();
      QKT(p0, p1, (j & 3) * (int)SHM_K); SBAR();
    }
    SOFT(); SBAR();
    PV(NT - 1); SBAR();
  }
  asm volatile("s_waitcnt vmcnt(0)" ::: "memory");
#undef NEXTDMA
#undef SOFT
#undef PV
  { auto rr = __builtin_amdgcn_permlane32_swap(__float_as_uint(l_reg), __float_as_uint(l_reg), false, false); l_reg = __uint_as_float(rr[0]) + __uint_as_float(rr[1]); }
  asm volatile("s_waitcnt lgkmcnt(0)\n\ts_barrier" ::: "memory");
  { const int le = fresh_lane(); LAS float* li_w = (LAS float*)lscr + wave_s * 64; if (le < 32) li_w[le] = l_reg; } asm volatile("s_waitcnt lgkmcnt(0)" ::: "memory");
  { const int te = fresh_lane(); const LAS float* li_l = (const LAS float*)lscr + wave_s * 64; LAS float* stg = (LAS float*)(lds + wave_s * 16384);
    const int er = te & 31, eh = (te >> 5) & 1;
#pragma unroll
    for (int r = 0; r < 16; ++r) { const int orow = (r & 3) + 8 * (r >> 2) + 4 * eh; const float rl = __builtin_amdgcn_rcpf(li_l[orow]);
#pragma unroll
      for (int d0 = 0; d0 < 4; ++d0) stg[orow * 128 + d0 * 32 + er] = o[d0][r] * rl; }
    asm volatile("s_waitcnt lgkmcnt(0)" ::: "memory");
    const int pc = te & 15, r0 = te >> 4;
    const bf16_t* gp = GAb + (long)(wave_s * QBLK + r0) * 1024 + pc * 8; bf16_t* op = Ob + (long)(wave_s * QBLK + r0) * LDO + pc * 8;
    u32x4 gw[8];
#pragma unroll
    for (int i = 0; i < 8; ++i) gw[i] = *(const u32x4*)(gp + (long)(4 * i) * 1024);
#pragma unroll
    for (int i = 0; i < 8; ++i) { const LAS f32x4* sp = (const LAS f32x4*)(stg + (r0 + 4 * i) * 128 + pc * 8); const f32x4 a = sp[0], b = sp[1]; f32x4 v0, v1;
      v0[0] = a[0] * bflo(gw[i].x); v0[1] = a[1] * bfhi(gw[i].x); v0[2] = a[2] * bflo(gw[i].y); v0[3] = a[3] * bfhi(gw[i].y);
      v1[0] = b[0] * bflo(gw[i].z); v1[1] = b[1] * bfhi(gw[i].z); v1[2] = b[2] * bflo(gw[i].w); v1[3] = b[3] * bfhi(gw[i].w);
      float s2 = 0.f;
#pragma unroll
      for (int e = 0; e < 4; ++e) s2 += v0[e] * v0[e] + v1[e] * v1[e];
      *(u32x4*)(op + (long)(4 * i) * LDO) = pg8::pack8(v0, v1);
      s2 += __shfl_xor(s2, 1); s2 += __shfl_xor(s2, 2); s2 += __shfl_xor(s2, 4); s2 += __shfl_xor(s2, 8);
      if (pc == 0) ssq[(long)(wave_s * QBLK + r0 + 4 * i) * 8] = s2; } }
  asm volatile("s_waitcnt lgkmcnt(0)\n\ts_barrier" ::: "memory");
#undef DMA
#undef WAITBAR
#undef QKT
}
__device__ __forceinline__ void attn_dense_body(const bf16_t* __restrict__ Qb, const bf16_t* __restrict__ Kh, const bf16_t* __restrict__ Vh,
                                                const bf16_t* __restrict__ GAb, bf16_t* __restrict__ Ob, float* __restrict__ ssq,
                                                const float* __restrict__ qnw, const f32x2* __restrict__ tab, float kwmax, bool need_shift, int wave_s, int pos0, int seq, LAS char* lds, LAS char* lscr) {
  unsigned kwb = __float_as_uint(kwmax); asm volatile("" : "+s"(kwb));
  const float kmaxc = __uint_as_float(kwb) * (11.313708498984761f * 1.01f);
  if (__builtin_expect(need_shift, 0)) attn_main<true>(Kh, Vh, GAb, Ob, ssq, seq, lds, lscr, wave_s, Qb, qnw, tab, kmaxc, pos0);
  else attn_main<false>(Kh, Vh, GAb, Ob, ssq, seq, lds, lscr, wave_s, Qb, qnw, tab, kmaxc, pos0);
}
#undef KSWZ
#undef SBAR
}

constexpr size_t MiB = 1u << 20;
constexpr size_t WS_CTL = 0, CTL_ZERO_BYTES = 1 * MiB;
constexpr size_t WS_RS = 1 * MiB;
constexpr size_t WS_RATIO = 2 * MiB;
constexpr size_t WS_RSN = 3 * MiB;
constexpr size_t WS_SSQA = 4 * MiB;
constexpr size_t WS_SSQS = 6 * MiB;
constexpr size_t WS_TAB = 10 * MiB;
constexpr size_t WS_WINT = 16 * MiB;
constexpr size_t WS_WGLUT = 34 * MiB;
constexpr size_t WS_WOUTT = 36 * MiB;
constexpr size_t WS_Q = 64 * MiB;
constexpr size_t WS_KV = 192 * MiB;
constexpr size_t WS_GA = 256 * MiB;
constexpr size_t WS_GS = 384 * MiB;
constexpr size_t WS_MG = 512 * MiB;
constexpr size_t WS_Y = 768 * MiB;
constexpr size_t WS_END = 896 * MiB;
constexpr size_t OU_XB = 0;
constexpr size_t OU_BTM = 0;
constexpr size_t OU_LR = 64 * MiB;
constexpr size_t OU_AG = 256 * MiB;
constexpr size_t OU_WLR = 448 * MiB;
constexpr size_t OU_K0 = 464 * MiB;
static_assert(OU_BTM + (size_t)NG * UC * KA * 2 <= OU_LR && OU_LR + (size_t)NG * NCHUNK * 256 * 4 <= OU_AG && OU_AG + (size_t)NG * NCHUNK * KA * 2 <= OU_WLR
              && OU_WLR + (size_t)NG * 256 * UC * 2 <= OU_K0 && OU_K0 + (size_t)NG * 2 * CT * 256 * 4 <= 512 * MiB, "d_out scratch map");
constexpr size_t WS_NEED = 896 * MiB;

constexpr int CW_TMO = 0, CW_BAR = 4096;

#define XB_TMO      128
#define XB_XCNT(j)  (256  + 64 * (j))
#define XB_XSUB(j)  (1280 + 64 * (j))
#define XB_XGEN(j)  (2304 + 64 * (j))
#define XB_TOP      3328
#define XB_TOPGEN   3392
#define XCD_BAR_WORDS 3456
#define XB_SPIN_CAP (1u << 20)
__device__ __forceinline__ unsigned xb_ld(unsigned* p)              { return __hip_atomic_load(p, __ATOMIC_RELAXED, __HIP_MEMORY_SCOPE_AGENT); }
__device__ __forceinline__ unsigned xb_add(unsigned* p, unsigned v) { return __hip_atomic_fetch_add(p, v, __ATOMIC_RELAXED, __HIP_MEMORY_SCOPE_AGENT); }
__device__ __forceinline__ unsigned xb_xcc_id() { return (unsigned)__builtin_amdgcn_s_getreg((3 << 11) | 20) & 0xFu; }
#define XB_SPIN(cond, bar) do { unsigned _sp = 0; while (cond) { __builtin_amdgcn_s_sleep(1); \
    if ((++_sp & 255u) == 0u) { if (xb_ld(&(bar)[XB_TMO])) break; if (_sp > XB_SPIN_CAP) { atomicAdd(&(bar)[XB_TMO], 1u); break; } } } } while (0)
struct XcdBarrier { unsigned* bar; unsigned x; volatile LAS unsigned* st; };
__device__ __forceinline__ XcdBarrier xcd_barrier_post(unsigned* bar, volatile LAS unsigned* st, bool leader) {
    XcdBarrier b; b.bar = bar; b.x = xb_xcc_id(); b.st = st;
    if (leader) (void)xb_add(&bar[XB_XCNT(b.x)], 1u);
    return b;
}
__device__ __forceinline__ void xcd_barrier_complete(unsigned* bar, unsigned x, unsigned& nloc, unsigned& nx) {
    const unsigned G = gridDim.x * gridDim.y * gridDim.z;
    unsigned sum, cnt, mine, sp = 0u;
    for (;;) {
        sum = 0u; cnt = 0u; mine = 0u;
#pragma unroll
        for (unsigned j = 0; j < 16; ++j) { const unsigned c = xb_ld(&bar[XB_XCNT(j)]); sum += c; cnt += (c > 0u) ? 1u : 0u; mine = (j == x) ? c : mine; }
        if (sum == G) break;
        __builtin_amdgcn_s_sleep(1);
        if ((++sp & 255u) == 0u) { if (xb_ld(&bar[XB_TMO])) break; if (sp > XB_SPIN_CAP) { atomicAdd(&bar[XB_TMO], 1u); break; } }
    }
    nloc = mine > 0u ? mine : 1u; nx = cnt > 0u ? cnt : 1u;
}
__device__ __forceinline__ void xcd_barrier(const XcdBarrier& b, bool leader) {
    asm volatile("s_waitcnt vmcnt(0)" ::: "memory");
    __syncthreads();
    if (leader) {
        unsigned* bar = b.bar;
        __builtin_amdgcn_s_waitcnt(0);
        unsigned nloc = b.st[0], nx = b.st[1];
        if (nloc == 0u) { xcd_barrier_complete(bar, b.x, nloc, nx); b.st[0] = nloc; b.st[1] = nx; }
        const unsigned old = xb_add(&bar[XB_XSUB(b.x)], 1u);
        const unsigned gen = old / nloc;
        if (old + 1u == (gen + 1u) * nloc) {
            __builtin_amdgcn_fence(__ATOMIC_RELEASE, "agent");
            asm volatile("s_waitcnt vmcnt(0)" ::: "memory");
            const unsigned og = xb_add(&bar[XB_TOP], 1u);
            const unsigned tg = og / nx;
            if (og + 1u == (tg + 1u) * nx) xb_add(&bar[XB_TOPGEN], 1u);
            else XB_SPIN(xb_ld(&bar[XB_TOPGEN]) == tg, bar);
            __builtin_amdgcn_fence(__ATOMIC_ACQUIRE, "agent");
            xb_add(&bar[XB_XGEN(b.x)], 1u);
            asm volatile("s_waitcnt vmcnt(0)" ::: "memory");
        } else {
            XB_SPIN(xb_ld(&bar[XB_XGEN(b.x)]) == gen, bar);
            __builtin_amdgcn_fence(__ATOMIC_ACQUIRE, "agent");
            asm volatile("s_waitcnt vmcnt(0)" ::: "memory");
        }
    }
    __syncthreads();
}

constexpr int RING_OFF = 0, RING_BYTES = 131072;
constexpr int LDSCTL_OFF = RING_BYTES, MISC_OFF = LDSCTL_OFF + 320;
constexpr int LDS_BYTES = 147456;
constexpr int NWAVES = 8;

struct Args {
    const float* in[18]; float* out; unsigned char* ws; int ph_lo, ph_hi, li, pad;
};

__device__ __forceinline__ float wave_sum(float v) {
#pragma unroll
    for (int o = 1; o < 64; o <<= 1) v += __shfl_xor(v, o);
    return v;
}
__device__ __forceinline__ void p0_transpose_item(const float* W, int K, int N, bf16_t* WT, LAS float* scr, int item, int lane, const float* ks1, const float* ks2, int ksplit) {
    const int nblk = N / 32, kb = item / nblk, nb = item % nblk, k0 = 64 * kb, n0 = 32 * nb;
    f32x4 v[8]; float sc[8];
#pragma unroll
    for (int i = 0; i < 8; ++i) { const int kk = 8 * i + (lane >> 3), k = k0 + kk; sc[i] = 1.f; if (ks1) sc[i] = (k < ksplit) ? ks1[k] : ks2[k - ksplit];
        v[i] = *(const f32x4*)(W + (size_t)k * N + n0 + (lane & 7) * 4); }
#pragma unroll
    for (int i = 0; i < 8; ++i) { const int kk = 8 * i + (lane >> 3); LAS float* d = scr + kk * 33 + (lane & 7) * 4;
        d[0] = v[i].x * sc[i]; d[1] = v[i].y * sc[i]; d[2] = v[i].z * sc[i]; d[3] = v[i].w * sc[i]; }
    asm volatile("s_waitcnt lgkmcnt(0)" ::: "memory");
    const int c = lane & 7;
#pragma unroll
    for (int j = 0; j < 4; ++j) { const int n = (lane >> 3) + 8 * j; const LAS float* s = scr + (8 * c) * 33 + n;
        u32x4 o; o.x = cvt_pk_bf16(s[0 * 33], s[1 * 33]); o.y = cvt_pk_bf16(s[2 * 33], s[3 * 33]); o.z = cvt_pk_bf16(s[4 * 33], s[5 * 33]); o.w = cvt_pk_bf16(s[6 * 33], s[7 * 33]);
        *(GAS u32x4*)(WT + (size_t)(n0 + n) * K + k0 + 8 * c) = o; }
    asm volatile("s_waitcnt lgkmcnt(0)" ::: "memory");
}
__device__ __forceinline__ void ssm_disc(const float* lre, const float* lim, const float* lstep, int d, int g, int p, f32x2& lb, f32x2& bs) {
    const float lr = lre[(d * NG + g) * NPST + p], li = lim[(d * NG + g) * NPST + p], dt = expf(lstep[d * NG + g]);
    const float mag = expf(lr * dt), ang = li * dt; lb.x = mag * cosf(ang); lb.y = mag * sinf(ang);
    const float nr = lb.x - 1.0f, ni = lb.y, den = 1.0f / (lr * lr + li * li);
    bs.x = (nr * lr + ni * li) * den; bs.y = (ni * lr - nr * li) * den;
}
__device__ __forceinline__ f32x2 ssm_pow(const float* lre, const float* lim, const float* lstep, int d, int g, int p, int e) {
    const float lr = lre[(d * NG + g) * NPST + p], li = lim[(d * NG + g) * NPST + p], dt = expf(lstep[d * NG + g]);
    const float mag = expf(lr * dt * (float)e), ang = li * dt * (float)e; f32x2 r; r.x = mag * cosf(ang); r.y = mag * sinf(ang); return r;
}
__device__ __forceinline__ f32x2 cmul(f32x2 a, f32x2 b) { f32x2 r; r.x = a.x * b.x - a.y * b.y; r.y = a.x * b.y + a.y * b.x; return r; }

__global__ void __launch_bounds__(NWAVES * 64, 2) enc_fwd(Args args) {
    extern __shared__ __attribute__((aligned(16))) unsigned char lds[];
    LAS unsigned char* const L = (LAS unsigned char*)lds;
    volatile LAS unsigned* const MISC = (volatile LAS unsigned*)(L + MISC_OFF);
    const int wave = __builtin_amdgcn_readfirstlane((int)threadIdx.x >> 6);
#define LEADER() (wave == 0 && fresh_lane() == 0)
#define PHASE_IDS() const int lane = fresh_lane(); const int tid = wave * 64 + lane; (void)tid
    const int G = gridDim.x; const int bx = blockIdx.x; const int vcu = (G % 8 == 0) ? (bx % 8) * (G / 8) + bx / 8 : bx;
    unsigned char* const ws = args.ws; unsigned char* const ou = (unsigned char*)args.out;
    gu32* const ctl = (gu32*)(ws + WS_CTL);
    const float* x_p = args.in[0]; const float* x_s = args.in[1]; const float* norm_w = args.in[2]; const float* w_in = args.in[3];
    const float* q_norm_w = args.in[4]; const float* k_norm_w = args.in[5]; const float* lam_re = args.in[6]; const float* lam_im = args.in[7]; const float* log_step = args.in[8];
    const float* b_re = args.in[9]; const float* b_im = args.in[10]; const float* c_re = args.in[11]; const float* c_im = args.in[12]; const float* d_skip = args.in[13];
    const float* w_glu = args.in[14]; const float* aonw = args.in[15]; const float* sonw = args.in[16]; const float* w_out = args.in[17];
    float* const RS = (float*)(ws + WS_RS); float* const RATIO = (float*)(ws + WS_RATIO); float* const RSN = (float*)(ws + WS_RSN);
    float* const SSQA = (float*)(ws + WS_SSQA); float* const SSQS = (float*)(ws + WS_SSQS); f32x2* const TAB = (f32x2*)(ws + WS_TAB);
    bf16_t* const WINT = (bf16_t*)(ws + WS_WINT); bf16_t* const WGLUT = (bf16_t*)(ws + WS_WGLUT); bf16_t* const WOUTT = (bf16_t*)(ws + WS_WOUTT);
    bf16_t* const QB = (bf16_t*)(ws + WS_Q); bf16_t* const KVB = (bf16_t*)(ws + WS_KV); bf16_t* const GA = (bf16_t*)(ws + WS_GA); bf16_t* const GS = (bf16_t*)(ws + WS_GS);
    bf16_t* const MG = (bf16_t*)(ws + WS_MG); bf16_t* const YB = (bf16_t*)(ws + WS_Y); float* const LR = (float*)(ou + OU_LR);
    bf16_t* const XB = (bf16_t*)(ou + OU_XB); bf16_t* const BTM = (bf16_t*)(ou + OU_BTM); bf16_t* const AG = (bf16_t*)(ou + OU_AG);
    bf16_t* const WLR = (bf16_t*)(ou + OU_WLR); float* const K0T = (float*)(ou + OU_K0);

    { PHASE_IDS(); for (int u = tid; u < (LDS_BYTES - LDSCTL_OFF) / 4; u += NWAVES * 64) ((LAS unsigned*)(L + LDSCTL_OFF))[u] = 0u; }
    __syncthreads();
    XcdBarrier bar; bar.bar = (unsigned*)(ctl + CW_BAR) + args.li * XCD_BAR_WORDS; bar.x = 0; bar.st = nullptr;
    if (N_LAUNCHES != NPH) bar = xcd_barrier_post((unsigned*)(ctl + CW_BAR) + args.li * XCD_BAR_WORDS, MISC + 8, LEADER());
#define GRID_BAR() do { if (N_LAUNCHES == NPH) { if (LEADER()) __hip_atomic_store(ctl + CW_TMO, 0xBADBA0u, __ATOMIC_RELAXED, __HIP_MEMORY_SCOPE_AGENT); } else { xcd_barrier(bar, LEADER()); } } while (0)
    const int lo = args.ph_lo, hi = args.ph_hi;
#ifndef PH_ONLY
#define PH_ONLY -1
#endif
#define IN(k) ((PH_ONLY < 0 || PH_ONLY == (k)) && lo <= (k) && (k) < hi)
#define BOTH(k) (IN(k) && IN((k) + 1))
#ifndef REPMASK
#define REPMASK 0
#endif
#define REPF(k) (1 + ((REPMASK >> (k)) & 1))
#define THIN_REP(k) _Pragma("unroll") for (int rep_ = 0; rep_ < REPF(k); ++rep_)
    const int gw = vcu * NWAVES + wave, NGW = G * NWAVES;
    LAS float* const scr = (LAS float*)(L + RING_OFF + wave * 16384);

    if (IN(0)) {
        PHASE_IDS();
        THIN_REP(8) {
        {
            constexpr int I_IN = (DM / 64) * (INC / 32), I_GLU = (1024 / 64) * (1024 / 32), I_OUT = (2048 / 64) * (2048 / 32);
            for (int it = gw; it < I_IN + I_GLU + I_OUT; it += NGW) {
                int r = it;
                if (r < I_IN) { p0_transpose_item(w_in, DM, INC, WINT, scr, r, lane, norm_w, norm_w, DM); continue; } r -= I_IN;
                if (r < I_GLU) { p0_transpose_item(w_glu, 1024, 1024, WGLUT, scr, r, lane, nullptr, nullptr, 0); continue; } r -= I_GLU;
                p0_transpose_item(w_out, 2048, 2048, WOUTT, scr, r, lane, aonw, sonw, 1024);
            }
        }
        for (int i = gw * 64 + lane; i < 128 * 32; i += NGW * 64) { const int pos = i >> 5, f = i & 31;
            const float inv = 1.0f / powf(10000.0f, (float)f * (1.0f / 32.0f)); const float ang = (float)pos * inv; f32x2 cs; cs.x = cosf(ang); cs.y = sinf(ang); TAB[i] = cs; }
        for (int it = gw; it < NG * 2 * TB4; it += NGW) {
            const int g = __builtin_amdgcn_readfirstlane(it / (2 * TB4)), d = __builtin_amdgcn_readfirstlane((it / TB4) & 1), tb = __builtin_amdgcn_readfirstlane(it % TB4);
            const int tl = lane >> 4, co = lane & 15, tau = tb * 4 + tl;
            LAS f32x2* Es = (LAS f32x2*)scr;
            LAS f32x2* Cs = (LAS f32x2*)(scr + 512);
#pragma unroll
            for (int i = 0; i < 4; ++i) { const int p = co + 16 * i; f32x2 lb, bs; ssm_disc(lam_re, lam_im, log_step, d, g, p, lb, bs); const f32x2 pw = ssm_pow(lam_re, lam_im, log_step, d, g, p, tau); Es[tl * 64 + p] = cmul(pw, bs); }
#pragma unroll
            for (int k = 0; k < 16; ++k) { f32x2 c; c.x = c_re[((size_t)(d * NG + g) * NCH + k) * NPST + lane]; c.y = c_im[((size_t)(d * NG + g) * NCH + k) * NPST + lane]; Cs[k * 65 + lane] = c; }
            asm volatile("s_waitcnt lgkmcnt(0)" ::: "memory");
            float acc[16];
#pragma unroll
            for (int ci = 0; ci < 16; ++ci) acc[ci] = 0.f;
            LAS float* Bs = scr + 512 + 2 * 16 * 65;
#pragma unroll
            for (int ph = 0; ph < 2; ++ph) {
                const float* brg = b_re + ((size_t)g * NPST + 32 * ph) * NCH; const float* big = b_im + ((size_t)g * NPST + 32 * ph) * NCH;
                const f32x4 r0 = *(const f32x4*)(brg + lane * 8), r1 = *(const f32x4*)(brg + lane * 8 + 4), i0 = *(const f32x4*)(big + lane * 8), i1 = *(const f32x4*)(big + lane * 8 + 4);
                asm volatile("s_waitcnt lgkmcnt(0)" ::: "memory");
                *(LAS f32x4*)(Bs + lane * 8) = r0; *(LAS f32x4*)(Bs + lane * 8 + 4) = r1; *(LAS f32x4*)(Bs + 512 + lane * 8) = i0; *(LAS f32x4*)(Bs + 512 + lane * 8 + 4) = i1;
                asm volatile("s_waitcnt lgkmcnt(0)" ::: "memory");
#pragma unroll 4
                for (int pp = 0; pp < 32; ++pp) { const int p = 32 * ph + pp; const f32x2 ce = cmul(Cs[co * 65 + p], Es[tl * 64 + p]);
                    const LAS f32x4* br = (const LAS f32x4*)(Bs + pp * 16); const LAS f32x4* bi = (const LAS f32x4*)(Bs + 512 + pp * 16);
#pragma unroll
                    for (int q = 0; q < 4; ++q) { const f32x4 a = br[q], b2 = bi[q];
                        acc[4 * q] += ce.x * a.x - ce.y * b2.x; acc[4 * q + 1] += ce.x * a.y - ce.y * b2.y; acc[4 * q + 2] += ce.x * a.z - ce.y * b2.z; acc[4 * q + 3] += ce.x * a.w - ce.y * b2.w; } }
            }
            if (d == 0 && tau == 0) {
                const float dsk = d_skip[g * NCH + co];
#pragma unroll
                for (int ci = 0; ci < 16; ++ci) acc[ci] += (ci == co) ? dsk : 0.f; }
            float* dst = K0T + (((size_t)(g * 2 + d) * CT + tau) * NCH + co) * NCH;
#pragma unroll
            for (int q = 0; q < 4; ++q) *(f32x4*)(dst + 4 * q) = (f32x4){acc[4 * q], acc[4 * q + 1], acc[4 * q + 2], acc[4 * q + 3]};
            asm volatile("s_waitcnt lgkmcnt(0)" ::: "memory");
        }
        for (int it = gw; it < NG * 2 * TB4; it += NGW) {
            const int g = it / (2 * TB4), d = (it / TB4) & 1, jb = it % TB4, p = lane; f32x2 lb, bs; ssm_disc(lam_re, lam_im, log_step, d, g, p, lb, bs);
            float br[16], bi[16];
#pragma unroll
            for (int ci = 0; ci < 16; ++ci) { br[ci] = b_re[((size_t)g * NPST + p) * NCH + ci]; bi[ci] = b_im[((size_t)g * NPST + p) * NCH + ci]; }
            const int e0 = d == 0 ? (CT - 4 - 4 * jb) : 4 * jb;
            f32x2 w = cmul(bs, ssm_pow(lam_re, lam_im, log_step, d, g, p, e0));
            bf16_t* rre = WLR + ((size_t)g * 256 + d * 128 + p) * UC; bf16_t* rim = rre + (size_t)64 * UC;
#pragma unroll
            for (int es = 0; es < 4; ++es) { const int e = e0 + es, jp = d == 0 ? (CT - 1 - e) : e; float vr[16], vi[16];
#pragma unroll
                for (int ci = 0; ci < 16; ++ci) { vr[ci] = w.x * br[ci] - w.y * bi[ci]; vi[ci] = w.x * bi[ci] + w.y * br[ci]; }
                u32x4 o0, o1, o2, o3;
                o0.x = cvt_pk_bf16(vr[0], vr[1]); o0.y = cvt_pk_bf16(vr[2], vr[3]); o0.z = cvt_pk_bf16(vr[4], vr[5]); o0.w = cvt_pk_bf16(vr[6], vr[7]);
                o1.x = cvt_pk_bf16(vr[8], vr[9]); o1.y = cvt_pk_bf16(vr[10], vr[11]); o1.z = cvt_pk_bf16(vr[12], vr[13]); o1.w = cvt_pk_bf16(vr[14], vr[15]);
                o2.x = cvt_pk_bf16(vi[0], vi[1]); o2.y = cvt_pk_bf16(vi[2], vi[3]); o2.z = cvt_pk_bf16(vi[4], vi[5]); o2.w = cvt_pk_bf16(vi[6], vi[7]);
                o3.x = cvt_pk_bf16(vi[8], vi[9]); o3.y = cvt_pk_bf16(vi[10], vi[11]); o3.z = cvt_pk_bf16(vi[12], vi[13]); o3.w = cvt_pk_bf16(vi[14], vi[15]);
                *(u32x4*)(rre + jp * 16) = o0; *(u32x4*)(rre + jp * 16 + 8) = o1; *(u32x4*)(rim + jp * 16) = o2; *(u32x4*)(rim + jp * 16 + 8) = o3;
                w = cmul(w, lb); }
        }
        for (int m = gw * 4; m < NTOK; m += NGW * 4) {
            const float* xrow = m < NPROMPT ? x_p + (size_t)m * DM : x_s + (size_t)(m - NPROMPT) * DM;
            const f32x4* xr = (const f32x4*)xrow + lane; f32x4 v[4][8]; float ssum[4];
#pragma unroll
            for (int q = 0; q < 4; ++q)
#pragma unroll
                for (int j = 0; j < 8; ++j) v[q][j] = __builtin_nontemporal_load(xr + 512 * q + 64 * j);
#pragma unroll
            for (int q = 0; q < 4; ++q) { float s0 = 0.f;
#pragma unroll
                for (int j = 0; j < 8; ++j) s0 += (v[q][j].x * v[q][j].x + v[q][j].y * v[q][j].y) + (v[q][j].z * v[q][j].z + v[q][j].w * v[q][j].w);
                ssum[q] = wave_sum(s0); }
            if (lane == 0) { f32x4 r; r.x = 1.0f / sqrtf(ssum[0] * (1.0f / DM) + EPS); r.y = 1.0f / sqrtf(ssum[1] * (1.0f / DM) + EPS); r.z = 1.0f / sqrtf(ssum[2] * (1.0f / DM) + EPS); r.w = 1.0f / sqrtf(ssum[3] * (1.0f / DM) + EPS); *(f32x4*)(RS + m) = r; }
            GAS u32x2* o8 = (GAS u32x2*)(XB + (size_t)m * DM) + lane;
#pragma unroll
            for (int q = 0; q < 4; ++q)
#pragma unroll
                for (int j = 0; j < 8; ++j) { u32x2 w; w.x = cvt_pk_bf16(v[q][j].x, v[q][j].y); w.y = cvt_pk_bf16(v[q][j].z, v[q][j].w); o8[512 * q + 64 * j] = w; }
        }
        }
        if (BOTH(0)) GRID_BAR();
    }

    if (IN(1)) {
        pg8::Gemm g{XB, WINT, DM, DM, DM, 0, 0}; pg8::StaticOrder S; S.init(NTOK, INC, G, bx, REPF(1));
        pg8::EpiInProj E{RS, QB, KVB, GA, GS, AG};
        pg8::gemm_phase<pg8::EpiInProj, pg8::StaticOrder, true, true>(L + RING_OFF, g, S, E, wave);
        if (BOTH(1)) GRID_BAR();
    }

    if (IN(2)) {
        PHASE_IDS();
        for (int m = gw; m < NTOK; m += NGW) {
            const int pos = m < NPROMPT ? (m & (SP - 1)) : ((m - NPROMPT) & (SS - 1)); const int prow = pos >> 6, pcol = pos & 63;
            GAS u32x2* kp = (GAS u32x2*)(KVB + (size_t)m * 512) + lane; const u32x2 w = *kp;
            float v0 = bflo(w.x), v1 = bfhi(w.x), v2 = bflo(w.y), v3 = bfhi(w.y);
            float ss = (v0 * v0 + v1 * v1) + (v2 * v2 + v3 * v3);
            ss += __shfl_xor(ss, 1); ss += __shfl_xor(ss, 2); ss += __shfl_xor(ss, 4); ss += __shfl_xor(ss, 8); ss += __shfl_xor(ss, 16);
            const float rn = 1.0f / sqrtf(ss * (1.0f / 128.0f) + EPS);
            const int dl = (lane & 31) * 4;
            const f32x4 kw = *(const f32x4*)(k_norm_w + dl);
            v0 *= rn * kw[0]; v1 *= rn * kw[1]; v2 *= rn * kw[2]; v3 *= rn * kw[3];
            const int ax = dl >> 6, half = (dl >> 5) & 1, fi = dl & 31;
            const f32x2* tp = TAB + (ax == 0 ? prow : pcol) * 32 + fi;
            const f32x2 c0 = tp[0], c1 = tp[1], c2 = tp[2], c3 = tp[3];
            const float p0 = __shfl_xor(v0, 8), p1 = __shfl_xor(v1, 8), p2 = __shfl_xor(v2, 8), p3 = __shfl_xor(v3, 8);
            float o0, o1, o2, o3;
            if (half == 0) { o0 = v0 * c0.x - p0 * c0.y; o1 = v1 * c1.x - p1 * c1.y; o2 = v2 * c2.x - p2 * c2.y; o3 = v3 * c3.x - p3 * c3.y; }
            else           { o0 = v0 * c0.x + p0 * c0.y; o1 = v1 * c1.x + p1 * c1.y; o2 = v2 * c2.x + p2 * c2.y; o3 = v3 * c3.x + p3 * c3.y; }
            u32x2 ow; ow.x = cvt_pk_bf16(o0, o1); ow.y = cvt_pk_bf16(o2, o3); *kp = ow;
        }
        THIN_REP(9) {
        for (long pc = (long)gw * 64 + lane; pc < (long)NG * UC * (UC / 8); pc += (long)NGW * 64) {
            const int kp8 = (int)(pc % (UC / 8)), n = (int)((pc / (UC / 8)) % UC), g = (int)(pc / ((long)UC * (UC / 8)));
            const int j = n >> 4, co = n & 15, jp = kp8 >> 1, ci0 = (kp8 & 1) * 8;
            const int dsel = j >= jp ? 0 : 1, tau = j >= jp ? j - jp : jp - j;
            const float* src = K0T + (((size_t)(g * 2 + dsel) * CT + tau) * NCH + co) * NCH + ci0;
            f32x4 a = *(const f32x4*)src, b = *(const f32x4*)(src + 4);
            if (j == jp) { const float* s2 = K0T + (((size_t)(g * 2 + 1) * CT) * NCH + co) * NCH + ci0; a += *(const f32x4*)s2; b += *(const f32x4*)(s2 + 4); }
            *(u32x4*)(BTM + ((size_t)g * UC + n) * KA + kp8 * 8) = pg8::pack8(a, b);
        }
        for (int it = gw; it < NG * 2 * NCH; it += NGW) {
            const int g = it >> 5, d = (it >> 4) & 1, co = it & 15, p = lane; f32x2 lb, bs; ssm_disc(lam_re, lam_im, log_step, d, g, p, lb, bs);
            f32x2 c; c.x = c_re[((size_t)(d * NG + g) * NCH + co) * NPST + p]; c.y = c_im[((size_t)(d * NG + g) * NCH + co) * NPST + p];
            f32x2 w = cmul(c, lb);
            for (int e = 1; e <= CT; ++e) { const int j = d == 0 ? e - 1 : CT - e;
                bf16_t* dst = BTM + ((size_t)g * UC + j * 16 + co) * KA + UC + d * 128 + p;
                dst[0] = (bf16_t)(cvt_pk_bf16(w.x, w.x) & 0xffffu); dst[64] = (bf16_t)(cvt_pk_bf16(-w.y, -w.y) & 0xffffu);
                w = cmul(w, lb); }
        }
        }
        __syncthreads();
        {
            pg8::Gemm g{AG, WLR, KA, UC, UC, (size_t)NCHUNK * KA, (size_t)256 * UC}; pg8::BatchOrder S; S.init(NG, NCHUNK / 256, 1, G, vcu, REPF(2));
            pg8::EpiLR E{LR};
            pg8::gemm_phase<pg8::EpiLR, pg8::BatchOrder, true, true>(L + RING_OFF, g, S, E, wave);
        }
        if (BOTH(2)) GRID_BAR();
    }

    if (IN(3)) {
        PHASE_IDS();
        THIN_REP(10)
        for (int it = gw; it < 20 * NG * 2; it += NGW) {
            int s, rest; if (it < 4 * NG * 2) { s = 16 + it / (NG * 2); rest = it % (NG * 2); } else { const int t2 = it - 4 * NG * 2; s = t2 / (NG * 2); rest = t2 % (NG * 2); }
            const int g = rest >> 1, d = rest & 1, p = lane;
            const int c0 = s < 16 ? (SP / CT) * s : NPROMPT / CT + (SS / CT) * (s - 16), nc = s < 16 ? SP / CT : SS / CT;
            const f32x2 lT = ssm_pow(lam_re, lam_im, log_step, d, g, p, CT);
            const float* lr = LR + ((size_t)g * NCHUNK) * 256 + d * 128 + p; bf16_t* ag = AG + ((size_t)g * NCHUNK) * KA + UC + d * 128 + p;
            f32x2 h; h.x = 0.f; h.y = 0.f;
            for (int cb = 0; cb < nc; cb += 8) {
                float xr[8], xi[8];
#pragma unroll
                for (int q = 0; q < 8; ++q) { const int ch = d == 0 ? c0 + cb + q : c0 + nc - 1 - (cb + q); xr[q] = lr[(size_t)ch * 256]; xi[q] = lr[(size_t)ch * 256 + 64]; }
#pragma unroll
                for (int q = 0; q < 8; ++q) { const int ch = d == 0 ? c0 + cb + q : c0 + nc - 1 - (cb + q);
                    ag[(size_t)ch * KA] = (bf16_t)(cvt_pk_bf16(h.x, h.x) & 0xffffu); ag[(size_t)ch * KA + 64] = (bf16_t)(cvt_pk_bf16(h.y, h.y) & 0xffffu);
                    h = cmul(h, lT); h.x += xr[q]; h.y += xi[q]; }
            }
        }
        __syncthreads();
        float kwmax;
        { float kw = fmaxf(fabsf(k_norm_w[lane]), fabsf(k_norm_w[lane + 64]));
#pragma unroll
          for (int o_ = 1; o_ < 64; o_ <<= 1) kw = fmaxf(kw, __shfl_xor(kw, o_));
          kwmax = __uint_as_float(__builtin_amdgcn_readfirstlane(__float_as_uint(kw))); }
        bool need_shift;
        { float qw = fmaxf(fabsf(q_norm_w[lane]), fabsf(q_norm_w[lane + 64]));
#pragma unroll
          for (int o_ = 1; o_ < 64; o_ <<= 1) qw = fmaxf(qw, __shfl_xor(qw, o_));
          need_shift = __builtin_amdgcn_readfirstlane((int)(qw * kwmax * (0.088388347648318440f * 1.4426950408889634f * 128.0f * 1.0201f) > 40.0f)) != 0; }
        for (int i0 = 0; i0 < 2048; ++i0) {
            int seq_row0, seqlen, kvh, hq, qb; int i = i0;
            if (G == 256) {
                if (i0 >= 8 * REPF(3)) break; i = i0 & 7;
                const int xcd = vcu >> 5, loc = vcu & 31;
                if (i < 4) { const int s = xcd >> 1; kvh = xcd & 1; const int idx = loc * 4 + i; hq = idx >> 5; qb = idx & 31; seq_row0 = NPROMPT + s * SS; seqlen = SS; }
                else { const int combo = xcd * 4 + (i - 4); const int s = combo >> 1; kvh = combo & 1; hq = loc >> 3; qb = loc & 7; seq_row0 = s * SP; seqlen = SP; }
            } else {
                const int u = i * G + bx; if (u >= 2048) break;
                if (u < 1024) { const int combo = u >> 7, idx = u & 127; const int s = combo >> 1; kvh = combo & 1; hq = idx >> 5; qb = idx & 31; seq_row0 = NPROMPT + s * SS; seqlen = SS; }
                else { const int u2 = u - 1024; const int combo = u2 >> 5, idx = u2 & 31; const int s = combo >> 1; kvh = combo & 1; hq = idx >> 3; qb = idx & 7; seq_row0 = s * SP; seqlen = SP; }
            }
            const int h = kvh * 4 + hq; const long r0 = (long)seq_row0 + qb * 256;
            attn::attn_dense_body(QB + r0 * 1024 + h * 128, KVB + (long)seq_row0 * 512 + kvh * 128, KVB + (long)seq_row0 * 512 + 256 + kvh * 128,
                                  GA + r0 * 1024 + h * 128, MG + r0 * 2048 + h * 128, SSQA + r0 * 8 + h, q_norm_w, TAB, kwmax, need_shift, wave, qb * 256, seqlen, (LAS char*)(L + RING_OFF), (LAS char*)(L + LDSCTL_OFF + 1024));
        }
        if (BOTH(3)) GRID_BAR();
    }

    if (IN(4)) {
        pg8::Gemm g{AG, BTM, KA, KA, KA, (size_t)NCHUNK * KA, (size_t)UC * KA}; pg8::BatchOrder S; S.init(NG, NCHUNK / 256, UC / 256, G, vcu, REPF(4));
        pg8::EpiSsm E{YB};
        pg8::gemm_phase<pg8::EpiSsm, pg8::BatchOrder, true, true>(L + RING_OFF, g, S, E, wave);
        if (BOTH(4)) GRID_BAR();
    }

    if (IN(5)) {
        pg8::Gemm g{YB, WGLUT, 1024, 1024, 1024, 0, 0}; pg8::StaticOrder S; S.init(NTOK, 1024, G, bx, REPF(5));
        pg8::EpiGlu E{YB, GS, MG, SSQS};
        pg8::gemm_phase<pg8::EpiGlu, pg8::StaticOrder, true, true>(L + RING_OFF, g, S, E, wave);
        if (BOTH(5)) GRID_BAR();
    }

    if (IN(6)) {
        PHASE_IDS();
        for (int r = (vcu * NWAVES * 64) + tid; r < NTOK; r += G * NWAVES * 64) {
            const f32x4 a0 = *(const f32x4*)(SSQA + (size_t)r * 8), a1 = *(const f32x4*)(SSQA + (size_t)r * 8 + 4);
            const float sa = ((a0[0] + a0[1]) + (a0[2] + a0[3])) + ((a1[0] + a1[1]) + (a1[2] + a1[3]));
            float sb = 0.f;
#pragma unroll
            for (int q = 0; q < 4; ++q) { const f32x4 b = *(const f32x4*)(SSQS + (size_t)r * 16 + 4 * q); sb += (b[0] + b[1]) + (b[2] + b[3]); }
            const float ra = 1.0f / sqrtf(sa * (1.0f / 1024.0f) + EPS), rsv = 1.0f / sqrtf(sb * (1.0f / 1024.0f) + EPS);
            RATIO[r] = ra / rsv; RSN[r] = rsv;
        }
        if (BOTH(6)) GRID_BAR();
    }

    if (IN(7)) {
        pg8::Gemm g{MG, WOUTT, 2048, 2048, 2048, 0, 0}; pg8::StaticOrder S; S.init(NTOK, DM, G, bx, REPF(7));
        pg8::EpiOut E{x_p, x_s, args.out, RATIO, RSN};
        pg8::gemm_phase<pg8::EpiOut, pg8::StaticOrder, true, true>(L + RING_OFF, g, S, E, wave);
    }
#undef IN
#undef BOTH
#undef GRID_BAR
}

extern "C" void kernel_launch(void* const* d_in, const int* in_sizes, int n_in, void* d_out, int out_size, void* d_ws, size_t ws_size, hipStream_t stream) {
    static int grid = 0;
    if (grid == 0) {
        if (n_in != 18 || out_size != NTOK * DM || ws_size < WS_NEED) { fprintf(stderr, "kernel_launch: unexpected shapes (n_in %d out %d ws %zu)\n", n_in, out_size, ws_size); grid = -1; return; }
        int dev = 0, cus = 0, per_cu = 0;
        if (hipGetDevice(&dev) != hipSuccess || hipDeviceGetAttribute(&cus, hipDeviceAttributeMultiprocessorCount, dev) != hipSuccess) { grid = -1; return; }
        if (hipFuncSetAttribute((const void*)enc_fwd, hipFuncAttributeMaxDynamicSharedMemorySize, LDS_BYTES) != hipSuccess) { fprintf(stderr, "kernel_launch: hipFuncSetAttribute failed\n"); grid = -1; return; }
        if (hipOccupancyMaxActiveBlocksPerMultiprocessor(&per_cu, (const void*)enc_fwd, NWAVES * 64, LDS_BYTES) != hipSuccess || per_cu < 1) { fprintf(stderr, "kernel_launch: occupancy query says %d\n", per_cu); }
        (void)hipGetLastError();
        grid = cus;
    }
    if (grid < 0) return;
    (void)hipMemsetAsync((char*)d_ws + WS_CTL, 0, CTL_ZERO_BYTES, stream);
    Args a{};
    for (int i = 0; i < 18; ++i) a.in[i] = (const float*)d_in[i];
    a.out = (float*)d_out; a.ws = (unsigned char*)d_ws;
    for (int li = 0; li < N_LAUNCHES; ++li) {
        a.ph_lo = (N_LAUNCHES == NPH) ? li : 0; a.ph_hi = (N_LAUNCHES == NPH) ? li + 1 : NPH; a.li = (N_LAUNCHES == NPH) ? 0 : li;
        hipLaunchKernelGGL(enc_fwd, dim3(grid), dim3(NWAVES * 64), LDS_BYTES, stream, a);
    }
}
```

```cpp
#include <hip/hip_runtime.h>
#include <hip/hip_bf16.h>
#include <cstdio>
#include <cstdint>
#include <cmath>

#ifndef MK_N_LAUNCHES
#define MK_N_LAUNCHES 1
#endif
constexpr int NPH = 8;
constexpr int N_LAUNCHES = MK_N_LAUNCHES;

constexpr int DM = 2048, NTOK = 65536, NPROMPT = 32768, SP = 2048, SS = 8192;
constexpr int INC = 4608;
constexpr int NG = 64, NPST = 64, NCH = 16, CT = 32, NCHUNK = NTOK / CT;
constexpr int UC = CT * NCH;
constexpr int KA = UC + 4 * NPST;
constexpr int TB4 = CT / 4;
constexpr float EPS = 1e-6f;

#define GAS __attribute__((address_space(1)))
#define LAS __attribute__((address_space(3)))
typedef unsigned short bf16_t;
typedef short bf16x8 __attribute__((ext_vector_type(8)));
typedef float f32x4 __attribute__((ext_vector_type(4)));
typedef float f32x2 __attribute__((ext_vector_type(2)));
typedef unsigned u32x4 __attribute__((ext_vector_type(4)));
typedef unsigned u32x2 __attribute__((ext_vector_type(2)));
typedef GAS unsigned gu32;

__device__ __forceinline__ unsigned cvt_pk_bf16(float lo, float hi) { unsigned r; asm volatile("v_cvt_pk_bf16_f32 %0, %1, %2" : "=v"(r) : "v"(lo), "v"(hi)); return r; }
__device__ __forceinline__ float bf2f(unsigned short b) { return __uint_as_float(((unsigned)b) << 16); }
__device__ __forceinline__ float bflo(unsigned w) { return __uint_as_float(w << 16); }
__device__ __forceinline__ float bfhi(unsigned w) { return __uint_as_float(w & 0xffff0000u); }
__device__ __forceinline__ float fast_sigmoid(float x) { return __builtin_amdgcn_rcpf(1.0f + __builtin_amdgcn_exp2f(-1.4426950408889634f * x)); }
__device__ __forceinline__ float silu_f(float x) { return x * fast_sigmoid(x); }
__device__ __forceinline__ float gelu_tanh(float x) { const float z = 0.7978845608028654f * (x + 0.044715f * x * x * x); return x * fast_sigmoid(2.0f * z); }

__device__ __forceinline__ int fresh_lane() { int l; asm volatile("v_mbcnt_lo_u32_b32 %0, -1, 0\n\tv_mbcnt_hi_u32_b32 %0, -1, %0" : "=v"(l)); return l; }

namespace pg8 {
#define PG8_LAS __attribute__((address_space(3)))
constexpr int BM = 256, BK = 64, HALF = 128, HTB = HALF * BK * 2, STAGE_BYTES = 8 * HTB, NXCD = 8, WGM = 8;
__host__ __device__ __forceinline__ int lds_byte(int r, int c) { const int st = (r >> 4) * 2 + (c >> 5), rr = r & 15, cc = c & 31, ob = rr * 64 + cc * 2; return st * 1024 + (ob ^ (((ob >> 9) & 1) << 5)); }
__host__ __device__ __forceinline__ void stage_rc(int b, int& R, int& C) { const int st = b / 1024, sb = b % 1024, swz = sb ^ (((sb >> 9) & 1) << 5); R = (st >> 1) * 16 + swz / 64; C = (st & 1) * 32 + (swz % 64) / 2; }
__host__ __device__ __forceinline__ int perm32(int rho) { const int n = rho >> 4, i = rho & 15; return 8 * (i >> 2) + 4 * n + (i & 3); }

struct Unit { int pm, pn, g; };
struct Gemm { const bf16_t* A; const bf16_t* Bt; int lda, ldb, K; size_t gsA, gsB; };

struct StaticOrder {
    int nM, nN, nwg, G, c, rep;
    __host__ __device__ void init(int M, int N, int G_, int c_, int rep_ = 1) { nM = M / BM; nN = N / BM; nwg = nM * nN; G = G_; c = c_; rep = rep_; }
    __host__ __device__ bool next(int i, Unit& u) const {
        if (rep > 1) { const int rounds = (nwg + G - 1) / G; if (i >= rounds * rep) return false; i = i % rounds; }
        const long L = (long)i * G + c; if (L >= nwg) return false;
        int wgid = (int)L; { const int q = nwg / NXCD, r = nwg % NXCD, xcd = wgid % NXCD, off = wgid / NXCD; wgid = (xcd < r ? xcd * (q + 1) : r * (q + 1) + (xcd - r) * q) + off; }
        const int nig = WGM * nN, gid = wgid / nig, fm = gid * WGM, gsz = (nM - fm) < WGM ? (nM - fm) : WGM;
        u.pm = fm + ((wgid % nig) % gsz); u.pn = (wgid % nig) / gsz; u.g = 0; return true;
    }
};
struct BatchOrder {
    int nPm, nPn, ntot, G, vcu, rep;
    __host__ __device__ void init(int nb, int nPm_, int nPn_, int G_, int vcu_, int rep_ = 1) { nPm = nPm_; nPn = nPn_; ntot = nb * nPm_ * nPn_; G = G_; vcu = vcu_; rep = rep_; }
    __host__ __device__ bool next(int i, Unit& u) const {
        if (rep > 1) { const int rounds = (ntot + G - 1) / G; if (i >= rounds * rep) return false; i = i % rounds; }
        const long L = (long)i * G + vcu; if (L >= ntot) return false;
        const int per = nPm * nPn, l = (int)L; u.g = l / per; const int t = l % per; u.pm = t / nPn; u.pn = t % nPn; return true;
    }
};

template <class Epi, class Sched, bool ALIGN_EPI = false, bool SP2 = true>
__device__ __forceinline__ void gemm_phase(PG8_LAS unsigned char* lds, const Gemm g, const Sched& S, const Epi& E, int wave_s) {
    const int wid = wave_s, lane = fresh_lane(), tid = wid * 64 + lane, wr = wid >> 2, wc = wid & 3, fr = lane & 15, fq = lane >> 4;
    const int K = g.K, nt = K / BK;
    unsigned voffA[2], voffB[2];
#pragma unroll
    for (int i = 0; i < 2; ++i) { int R, C; stage_rc(tid * 16 + i * 8192, R, C); const int Rb = Epi::PERM ? ((R & ~31) + perm32(R & 31)) : R;
        voffA[i] = (unsigned)(R * g.lda + C) * 2u; voffB[i] = (unsigned)(Rb * g.ldb + C) * 2u; }
    const size_t kstep = (size_t)(BK * 2);
    const size_t hstepA = (size_t)HALF * g.lda * 2, hstepB = (size_t)HALF * g.ldb * 2;
    const size_t tstepA = 2 * hstepA, tstepB = 2 * hstepB;
    const unsigned ldsw = (unsigned)wid * 1024u;
    const int aoff = lds_byte(wr * 64 + fr, fq * 8), boff = lds_byte(wc * 32 + fr, fq * 8);
#define PG8_SA(b, h) (((b) * 2 + (h)) * HTB)
#define PG8_SB(b, h) ((4 + (b) * 2 + (h)) * HTB)
#define PG8_STAGE(bufoff, gbase, voff) do { _Pragma("unroll") for (int _i = 0; _i < 2; ++_i) \
        __builtin_amdgcn_global_load_lds((const unsigned*)((const char*)(gbase) + (voff)[_i]), (PG8_LAS unsigned*)(lds + (bufoff) + ldsw + _i * 8192), 16, 0, 0); } while (0)
#define PG8_LDA(dst, b, h) do { _Pragma("unroll") for (int m = 0; m < 4; ++m) _Pragma("unroll") for (int k = 0; k < 2; ++k) dst[m][k] = *(const PG8_LAS bf16x8*)(lds + PG8_SA(b, h) + aoff + m * 2048 + k * 1024); } while (0)
#define PG8_LDB(dst, b, h) do { _Pragma("unroll") for (int n = 0; n < 2; ++n) _Pragma("unroll") for (int k = 0; k < 2; ++k) dst[n][k] = *(const PG8_LAS bf16x8*)(lds + PG8_SB(b, h) + boff + n * 2048 + k * 1024); } while (0)
#define PG8_MMA(ai, bj, At, Bt) do { __builtin_amdgcn_s_setprio(1); _Pragma("unroll") for (int m = 0; m < 4; ++m) _Pragma("unroll") for (int n = 0; n < 2; ++n) _Pragma("unroll") for (int k = 0; k < 2; ++k) \
        acc[ai][bj][m][n] = __builtin_amdgcn_mfma_f32_16x16x32_bf16(Bt[n][k], At[m][k], acc[ai][bj][m][n], 0, 0, 0); __builtin_amdgcn_s_setprio(0); } while (0)
#define PG8_WAIT_V(n) asm volatile("s_waitcnt vmcnt(" #n ")" ::: "memory")
#define PG8_WAIT_L(n) asm volatile("s_waitcnt lgkmcnt(" #n ")" ::: "memory")
#define PG8_BAR __builtin_amdgcn_s_barrier()
#define PG8_SCHED __builtin_amdgcn_sched_barrier(0)
    Unit cur, nxt; int ui = 0;
    if (!S.next(0, cur)) return;
    f32x4 acc[2][2][4][2];
#pragma unroll
    for (int a = 0; a < 2; ++a)
#pragma unroll
        for (int b = 0; b < 2; ++b)
#pragma unroll
            for (int m = 0; m < 4; ++m)
#pragma unroll
                for (int n = 0; n < 2; ++n) acc[a][b][m][n] = (f32x4){0.f, 0.f, 0.f, 0.f};
    bf16x8 At[4][2], B0[2][2], B1[2][2];
    const char* cA = (const char*)(g.A + (size_t)cur.g * g.gsA) + (size_t)cur.pm * tstepA; const char* cB = (const char*)(g.Bt + (size_t)cur.g * g.gsB) + (size_t)cur.pn * tstepB;
    static_assert(SP2, "only the SP2 loop is kept in this file");
    PG8_STAGE(PG8_SB(0, 0), cB, voffB); PG8_STAGE(PG8_SB(0, 1), cB + hstepB, voffB); PG8_STAGE(PG8_SA(0, 0), cA, voffA); PG8_STAGE(PG8_SA(0, 1), cA + hstepA, voffA);
    if (wr == 1) PG8_BAR;
    PG8_WAIT_V(2); PG8_BAR;
    PG8_STAGE(PG8_SB(1, 0), cB + kstep, voffB); PG8_STAGE(PG8_SA(1, 0), cA + kstep, voffA); PG8_STAGE(PG8_SB(1, 1), cB + hstepB + kstep, voffB);
    PG8_WAIT_V(6); PG8_BAR;
    for (;;) {
        const bool has_next = S.next(ui + 1, nxt);
        const char* nA = has_next ? (const char*)(g.A + (size_t)nxt.g * g.gsA) + (size_t)nxt.pm * tstepA : cA;
        const char* nB = has_next ? (const char*)(g.Bt + (size_t)nxt.g * g.gsB) + (size_t)nxt.pn * tstepB : cB;
        for (int t = 0; t < nt; t += 2) {
            const bool last = (t == nt - 2);
            const char* a1 = cA + (size_t)(t + 1) * kstep;
            const char* a2 = last ? nA : cA + (size_t)(t + 2) * kstep; const char* b2 = last ? nB : cB + (size_t)(t + 2) * kstep;
            const char* a3 = a2 + kstep; const char* b3 = b2 + kstep;
            if constexpr (Epi::MIDK) { if (t == (nt >> 1)) E.midk(acc, cur, wr, wc, fr, fq); }
            PG8_LDB(B0, 0, 0); PG8_LDB(B1, 0, 1); PG8_SCHED; PG8_LDA(At, 0, 0); PG8_STAGE(PG8_SA(1, 1), a1 + hstepA, voffA);
            PG8_WAIT_V(8); PG8_WAIT_L(0); PG8_BAR; PG8_MMA(0, 0, At, B0); PG8_MMA(0, 1, At, B1); PG8_BAR; PG8_SCHED;
            PG8_LDA(At, 0, 1); PG8_STAGE(PG8_SB(0, 0), b2, voffB); PG8_STAGE(PG8_SB(0, 1), b2 + hstepB, voffB); PG8_STAGE(PG8_SA(0, 0), a2, voffA);
            PG8_WAIT_V(8); PG8_WAIT_L(0); PG8_BAR; PG8_MMA(1, 0, At, B0); PG8_MMA(1, 1, At, B1); PG8_BAR; PG8_SCHED;
            PG8_LDB(B0, 1, 0); PG8_LDB(B1, 1, 1); PG8_SCHED; PG8_LDA(At, 1, 0); PG8_STAGE(PG8_SA(0, 1), a2 + hstepA, voffA);
            PG8_WAIT_V(8); PG8_WAIT_L(0); PG8_BAR; PG8_MMA(0, 0, At, B0); PG8_MMA(0, 1, At, B1); PG8_BAR; PG8_SCHED;
            PG8_LDA(At, 1, 1); PG8_STAGE(PG8_SB(1, 0), b3, voffB); PG8_STAGE(PG8_SB(1, 1), b3 + hstepB, voffB); PG8_STAGE(PG8_SA(1, 0), a3, voffA);
            PG8_WAIT_V(8); PG8_WAIT_L(0); PG8_BAR; PG8_MMA(1, 0, At, B0); PG8_MMA(1, 1, At, B1); PG8_BAR; PG8_SCHED;
        }
        if constexpr (ALIGN_EPI) { if (wr == 0) PG8_BAR; }
        E(acc, cur, wr, wc, fr, fq);
#if defined(EPI_REP_PROBE)
        if (Epi::PROBE_ID == EPI_REP_PROBE) { asm volatile("" ::: "memory"); E(acc, cur, wr, wc, fr, fq); }
#endif
        if (!has_next) break;
#pragma unroll
        for (int a = 0; a < 2; ++a)
#pragma unroll
            for (int b = 0; b < 2; ++b)
#pragma unroll
                for (int m = 0; m < 4; ++m)
#pragma unroll
                    for (int n = 0; n < 2; ++n) acc[a][b][m][n] = (f32x4){0.f, 0.f, 0.f, 0.f};
        cur = nxt; cA = nA; cB = nB; ++ui;
        if constexpr (ALIGN_EPI) { if (wr == 1) PG8_BAR; }
    }
    PG8_WAIT_V(0);
    if constexpr (!ALIGN_EPI) { if (wr == 0) PG8_BAR; }
    PG8_BAR;
#undef PG8_SA
#undef PG8_SB
#undef PG8_STAGE
#undef PG8_LDA
#undef PG8_LDB
#undef PG8_MMA
#undef PG8_WAIT_V
#undef PG8_WAIT_L
#undef PG8_BAR
#undef PG8_SCHED
}

__device__ __forceinline__ u32x4 pack8(const f32x4 v0, const f32x4 v1) { u32x4 w; w.x = cvt_pk_bf16(v0[0], v0[1]); w.y = cvt_pk_bf16(v0[2], v0[3]); w.z = cvt_pk_bf16(v1[0], v1[1]); w.w = cvt_pk_bf16(v1[2], v1[3]); return w; }

struct EpiInProj {
    static constexpr int PROBE_ID = 1;
    static constexpr bool PERM = true, MIDK = false;
    const float* rs; bf16_t *Q, *KV, *GA, *GS, *AG;
    __device__ __forceinline__ void operator()(const f32x4 (&acc)[2][2][4][2], const Unit& u, int wr, int wc, int fr, int fq) const {
        const int pn = u.pn; const int row0 = u.pm * BM + wr * 64 + fr; const int colt = pn * BM + wc * 32 + 8 * fq;
        int kind = 0, ld = 1024, cb = colt; bf16_t* base = Q;
        if (pn >= 4 && pn < 6) { base = KV; ld = 512; cb = colt - 1024; }
        else if (pn >= 6 && pn < 10) { base = GA; cb = colt - 1536; kind = 1; }
        else if (pn >= 10 && pn < 14) { base = AG; cb = colt - 2560; kind = 2; }
        else if (pn >= 14) { base = GS; cb = colt - 3584; kind = 1; }
        float rsv[2][4];
#pragma unroll
        for (int ai = 0; ai < 2; ++ai)
#pragma unroll
            for (int m = 0; m < 4; ++m) rsv[ai][m] = rs[row0 + ai * HALF + m * 16];
#pragma unroll
        for (int ai = 0; ai < 2; ++ai)
#pragma unroll
            for (int m = 0; m < 4; ++m) { const int r = row0 + ai * HALF + m * 16; const float s = rsv[ai][m];
#pragma unroll
                for (int bj = 0; bj < 2; ++bj) { f32x4 v0 = acc[ai][bj][m][0] * s, v1 = acc[ai][bj][m][1] * s;
                    if (kind == 1) {
#pragma unroll
                        for (int e = 0; e < 4; ++e) { v0[e] = silu_f(v0[e]); v1[e] = silu_f(v1[e]); } }
                    const int c = cb + bj * HALF; size_t off;
                    if (kind == 2) off = ((size_t)((c >> 4) * NCHUNK + (r / CT))) * KA + (size_t)((r % CT) * 16 + (c & 15));
                    else off = (size_t)r * ld + c;
                    *(u32x4*)(base + off) = pack8(v0, v1); } }
    }
};
struct EpiLR {
    static constexpr int PROBE_ID = 2;
    static constexpr bool PERM = false, MIDK = false;
    float* LR;
    __device__ __forceinline__ void operator()(const f32x4 (&acc)[2][2][4][2], const Unit& u, int wr, int wc, int fr, int fq) const {
        const int row0 = u.pm * BM + wr * 64 + fr, col0 = wc * 32 + 4 * fq;
#pragma unroll
        for (int ai = 0; ai < 2; ++ai)
#pragma unroll
            for (int m = 0; m < 4; ++m) { float* rowp = LR + ((size_t)u.g * NCHUNK + row0 + ai * HALF + m * 16) * 256 + col0;
#pragma unroll
                for (int bj = 0; bj < 2; ++bj)
#pragma unroll
                    for (int n = 0; n < 2; ++n) *(f32x4*)(rowp + bj * HALF + n * 16) = acc[ai][bj][m][n]; }
    }
};
struct EpiSsm {
    static constexpr int PROBE_ID = 4;
    static constexpr bool PERM = true, MIDK = false;
    bf16_t* Y;
    __device__ __forceinline__ void operator()(const f32x4 (&acc)[2][2][4][2], const Unit& u, int wr, int wc, int fr, int fq) const {
        const int ch0 = u.pm * BM + wr * 64 + fr, n00 = u.pn * BM + wc * 32 + 8 * fq; const int g = u.g;
        const int co0 = n00 & 15;
#pragma unroll
        for (int ai = 0; ai < 2; ++ai)
#pragma unroll
            for (int m = 0; m < 4; ++m) { const int ch = ch0 + ai * HALF + m * 16;
#pragma unroll
                for (int bj = 0; bj < 2; ++bj) { const int n0 = n00 + bj * HALF, j = n0 >> 4;
                    f32x4 v0 = acc[ai][bj][m][0], v1 = acc[ai][bj][m][1];
#pragma unroll
                    for (int e = 0; e < 4; ++e) { v0[e] = gelu_tanh(v0[e]); v1[e] = gelu_tanh(v1[e]); }
                    *(u32x4*)(Y + ((size_t)ch * CT + j) * 1024 + g * 16 + co0) = pack8(v0, v1); } }
    }
};
struct EpiGlu {
    static constexpr int PROBE_ID = 5;
    static constexpr bool PERM = true, MIDK = false;
    const bf16_t* Y; const bf16_t* GS; bf16_t* MG; float* SSQS;
    __device__ __forceinline__ void operator()(const f32x4 (&acc)[2][2][4][2], const Unit& u, int wr, int wc, int fr, int fq) const {
        const int row0 = u.pm * BM + wr * 64 + fr, c00 = u.pn * BM + wc * 32 + 8 * fq;
#pragma unroll
        for (int ai = 0; ai < 2; ++ai) {
            u32x4 yw[4][2], gw[4][2];
#pragma unroll
            for (int m = 0; m < 4; ++m) { const int r = row0 + ai * HALF + m * 16;
#pragma unroll
                for (int bj = 0; bj < 2; ++bj) { const int c = c00 + bj * HALF; yw[m][bj] = *(const u32x4*)(Y + (size_t)r * 1024 + c); gw[m][bj] = *(const u32x4*)(GS + (size_t)r * 1024 + c); } }
#pragma unroll
            for (int m = 0; m < 4; ++m) { const int r = row0 + ai * HALF + m * 16; float ss = 0.f;
#pragma unroll
                for (int bj = 0; bj < 2; ++bj) { const int c = c00 + bj * HALF; const u32x4 y4 = yw[m][bj], g4 = gw[m][bj];
                    const f32x4 a0 = acc[ai][bj][m][0], a1 = acc[ai][bj][m][1]; f32x4 v0, v1;
                    v0[0] = bflo(y4.x) * fast_sigmoid(a0[0]) * bflo(g4.x); v0[1] = bfhi(y4.x) * fast_sigmoid(a0[1]) * bfhi(g4.x);
                    v0[2] = bflo(y4.y) * fast_sigmoid(a0[2]) * bflo(g4.y); v0[3] = bfhi(y4.y) * fast_sigmoid(a0[3]) * bfhi(g4.y);
                    v1[0] = bflo(y4.z) * fast_sigmoid(a1[0]) * bflo(g4.z); v1[1] = bfhi(y4.z) * fast_sigmoid(a1[1]) * bfhi(g4.z);
                    v1[2] = bflo(y4.w) * fast_sigmoid(a1[2]) * bflo(g4.w); v1[3] = bfhi(y4.w) * fast_sigmoid(a1[3]) * bfhi(g4.w);
#pragma unroll
                    for (int e = 0; e < 4; ++e) ss += v0[e] * v0[e] + v1[e] * v1[e];
                    *(u32x4*)(MG + (size_t)r * 2048 + 1024 + c) = pack8(v0, v1); }
                ss += __shfl_xor(ss, 16); ss += __shfl_xor(ss, 32);
                if (fq == 0) SSQS[(size_t)r * 16 + u.pn * 4 + wc] = ss; } }
    }
};
struct EpiOut {
    static constexpr int PROBE_ID = 7;
    static constexpr bool PERM = false, MIDK = true;
    const float* xp; const float* xs; float* out; const float* ratio; const float* rsn;
    __device__ __forceinline__ void midk(f32x4 (&acc)[2][2][4][2], const Unit& u, int wr, int wc, int fr, int fq) const {
        const int row0 = u.pm * BM + wr * 64 + fr;
#pragma unroll
        for (int ai = 0; ai < 2; ++ai)
#pragma unroll
            for (int m = 0; m < 4; ++m) { const float s = ratio[row0 + ai * HALF + m * 16];
#pragma unroll
                for (int bj = 0; bj < 2; ++bj)
#pragma unroll
                    for (int n = 0; n < 2; ++n) acc[ai][bj][m][n] *= s; }
    }
    __device__ __forceinline__ void operator()(const f32x4 (&acc)[2][2][4][2], const Unit& u, int wr, int wc, int fr, int fq) const {
        const int row0 = u.pm * BM + wr * 64 + fr, col0 = u.pn * BM + wc * 32 + 4 * fq;
#pragma unroll
        for (int ai = 0; ai < 2; ++ai) {
            f32x4 xv[4][2][2]; float sv[4];
#pragma unroll
            for (int m = 0; m < 4; ++m) { const int r = row0 + ai * HALF + m * 16; sv[m] = rsn[r];
                const float* xr = (r < NPROMPT ? xp + (size_t)r * DM : xs + (size_t)(r - NPROMPT) * DM) + col0;
#pragma unroll
                for (int bj = 0; bj < 2; ++bj)
#pragma unroll
                    for (int n = 0; n < 2; ++n) xv[m][bj][n] = *(const f32x4*)(xr + bj * HALF + n * 16); }
#pragma unroll
            for (int m = 0; m < 4; ++m) { const int r = row0 + ai * HALF + m * 16; float* orow = out + (size_t)r * DM + col0;
#pragma unroll
                for (int bj = 0; bj < 2; ++bj)
#pragma unroll
                    for (int n = 0; n < 2; ++n) *(f32x4*)(orow + bj * HALF + n * 16) = xv[m][bj][n] + acc[ai][bj][m][n] * sv[m]; } }
    }
};
}

namespace attn {
using bf16 = __hip_bfloat16;
constexpr int D = 128, NW = 8, QBLK = 32, KVBLK = 64;
constexpr float SCALE = 0.088388347648318440f;
constexpr float THR = 8.f;
constexpr int SDEPTH = 1;
constexpr int LDQ = 1024, LDK = 512, LDO = 2048;
constexpr size_t SHM_V = KVBLK * D * 2, SHM_K = KVBLK * D * 2, SHM_ATTN = 4 * SHM_V + 4 * SHM_K;
using s16x4 = __attribute__((ext_vector_type(4))) short;
using f32x16 = __attribute__((ext_vector_type(16))) float;
#define KSWZ(row, colB) ((row) * 256 + ((colB) ^ (((row) & 15) << 4)))
#define SBAR() __builtin_amdgcn_sched_barrier(0)
__device__ __forceinline__ int crow(int r, int hi) { return (r & 3) + 8 * (r >> 2) + 4 * hi; }
__device__ __forceinline__ unsigned cvtpk(float lo, float hi) { unsigned r; asm volatile("v_cvt_pk_bf16_f32 %0, %1, %2" : "=v"(r) : "v"(lo), "v"(hi)); return r; }
template <bool SHIFT> __device__ __forceinline__ void softmax_tile(f32x16& p0, f32x16& p1, float& l_part, bf16x8& pa0, bf16x8& pa1, bf16x8& pa2, bf16x8& pa3, float msub) {
  for (int r = 0; r < 16; ++r) p0[r] = __builtin_amdgcn_exp2f(SHIFT ? p0[r] - msub : p0[r]);
  for (int r = 0; r < 16; ++r) p1[r] = __builtin_amdgcn_exp2f(SHIFT ? p1[r] - msub : p1[r]);
  float ps = 0; for (int r = 0; r < 16; ++r) ps += p0[r]; for (int r = 0; r < 16; ++r) ps += p1[r];
  l_part += ps;
#define PK4(P, BASE, OUT) do { unsigned a0 = cvtpk(P[BASE + 0], P[BASE + 1]), a1 = cvtpk(P[BASE + 2], P[BASE + 3]);   \
    unsigned b0 = cvtpk(P[BASE + 4], P[BASE + 5]), b1 = cvtpk(P[BASE + 6], P[BASE + 7]);                              \
    auto r0 = __builtin_amdgcn_permlane32_swap(a0, b0, false, false); auto r1 = __builtin_amdgcn_permlane32_swap(a1, b1, false, false); \
    u32x4 w = {r0[0], r1[0], r0[1], r1[1]}; OUT = *reinterpret_cast<bf16x8*>(&w); } while (0)
  PK4(p0, 0, pa0); PK4(p0, 8, pa1); PK4(p1, 0, pa2); PK4(p1, 8, pa3);
#undef PK4
}
__device__ __forceinline__ int v_st(int k, int c) { const int kk = (k & ~0xC) | ((k & 4) << 1) | ((k & 8) >> 1); return ((kk >> 3) * 4 + (c >> 5)) * 512 + ((kk & 7) * 32 + (c & 31)) * 2; }
__device__ __forceinline__ int v_rd_base(int lane) { return ((lane & 3) << 3) | (((lane >> 2) & 3) << 6) | (((lane >> 4) & 1) << 5) | (((lane >> 5) & 1) << 8); }
constexpr int v_rd_off(int d0, int ks, int half) { return d0 * 512 + ks * 4096 + half * 2048; }
__device__ __forceinline__ void glds16s(unsigned voff, const void* sbase, unsigned lds_dst) { unsigned keep;
  asm volatile("s_mov_b32 %0, m0\n\ts_mov_b32 m0, %3\n\ts_nop 0\n\tglobal_load_lds_dwordx4 %1, %2\n\ts_mov_b32 m0, %0" : "=&s"(keep) : "v"(voff), "s"(sbase), "s"(lds_dst) : "memory"); }
template <int OFF> __device__ __forceinline__ s16x4 tr_read(int vb) {
  s16x4 r; asm volatile("ds_read_b64_tr_b16 %0, %1 offset:%2" : "=&v"(r) : "v"(vb), "i"(OFF) : "memory"); return r;
}
struct VFrag { s16x4 l0, h0, l1, h1, l2, h2, l3, h3; };
template <int D0, int SO> __device__ __forceinline__ void v_read8(VFrag& f, int vb) {
  f.l0 = tr_read<SO + v_rd_off(D0, 0, 0)>(vb); f.h0 = tr_read<SO + v_rd_off(D0, 0, 1)>(vb); f.l1 = tr_read<SO + v_rd_off(D0, 1, 0)>(vb); f.h1 = tr_read<SO + v_rd_off(D0, 1, 1)>(vb);
  f.l2 = tr_read<SO + v_rd_off(D0, 2, 0)>(vb); f.h2 = tr_read<SO + v_rd_off(D0, 2, 1)>(vb); f.l3 = tr_read<SO + v_rd_off(D0, 3, 0)>(vb); f.h3 = tr_read<SO + v_rd_off(D0, 3, 1)>(vb);
}
__device__ __forceinline__ void pv_mma4(f32x16& od, const VFrag& f, bf16x8 pa0, bf16x8 pa1, bf16x8 pa2, bf16x8 pa3) {
#define PK(L, H) (bf16x8){L[0], L[1], L[2], L[3], H[0], H[1], H[2], H[3]}
  __builtin_amdgcn_s_setprio(1);
  od = __builtin_amdgcn_mfma_f32_32x32x16_bf16(pa0, PK(f.l0, f.h0), od, 0, 0, 0);
  od = __builtin_amdgcn_mfma_f32_32x32x16_bf16(pa1, PK(f.l1, f.h1), od, 0, 0, 0);
  od = __builtin_amdgcn_mfma_f32_32x32x16_bf16(pa2, PK(f.l2, f.h2), od, 0, 0, 0);
  od = __builtin_amdgcn_mfma_f32_32x32x16_bf16(pa3, PK(f.l3, f.h3), od, 0, 0, 0);
  __builtin_amdgcn_s_setprio(0);
#undef PK
}
template <int SO> __device__ __forceinline__ void pv_d0(f32x16* o, int vb, bf16x8 pa0, bf16x8 pa1, bf16x8 pa2, bf16x8 pa3) {
  VFrag fa, fb;
  v_read8<0, SO>(fa, vb);
  v_read8<1, SO>(fb, vb); asm volatile("s_waitcnt lgkmcnt(8)" ::: "memory"); SBAR(); pv_mma4(o[0], fa, pa0, pa1, pa2, pa3); SBAR();
  v_read8<2, SO>(fa, vb); asm volatile("s_waitcnt lgkmcnt(8)" ::: "memory"); SBAR(); pv_mma4(o[1], fb, pa0, pa1, pa2, pa3); SBAR();
  v_read8<3, SO>(fb, vb); asm volatile("s_waitcnt lgkmcnt(8)" ::: "memory"); SBAR(); pv_mma4(o[2], fa, pa0, pa1, pa2, pa3); SBAR();
  asm volatile("s_waitcnt lgkmcnt(0)" ::: "memory"); SBAR(); pv_mma4(o[3], fb, pa0, pa1, pa2, pa3);
}

__device__ __forceinline__ void attn_q_prologue(const bf16_t* __restrict__ Qb, const float* __restrict__ qnw, const f32x2* __restrict__ tab, float kmaxc, int pos0,
                                                int wid, int r32, int hi, bf16x8 (&qr)[8], float& mshift) {
    const bf16_t* Qw = Qb + (long)(wid * QBLK + r32) * LDQ + hi * 8;
    u32x4 raw[8]; float ss = 0.f;
#pragma unroll
    for (int d0 = 0; d0 < 8; ++d0) raw[d0] = *reinterpret_cast<const u32x4*>(Qw + d0 * 16);
#pragma unroll
    for (int d0 = 0; d0 < 8; ++d0) {
#pragma unroll
      for (int q = 0; q < 4; ++q) { const float a = bflo(raw[d0][q]), b = bfhi(raw[d0][q]); ss += a * a + b * b; } }
    { auto rr = __builtin_amdgcn_permlane32_swap(__float_as_uint(ss), __float_as_uint(ss), false, false); ss = __uint_as_float(rr[0]) + __uint_as_float(rr[1]); }
    const float rn = (SCALE * 1.4426950408889634f) / sqrtf(ss * (1.0f / 128.0f) + EPS);
    float qn2 = 0.f;
    const int pos = pos0 + wid * QBLK + r32, prow = pos >> 6, pcol = pos & 63;
#pragma unroll
    for (int pg = 0; pg < 4; ++pg) { const int dd = pg & 1, ax = pg >> 1, d0 = ax * 4 + dd;
      const f32x2* tp = tab + (ax == 0 ? prow : pcol) * 32 + hi * 8 + dd * 16;
      const float* wa = qnw + d0 * 16 + hi * 8; const float* wb = wa + 32;
      float na[8], nb[8];
#pragma unroll
      for (int q = 0; q < 4; ++q) {
        const f32x2 c0 = tp[2 * q], c1 = tp[2 * q + 1];
        const float a0 = bflo(raw[d0][q]) * (rn * wa[2 * q]), a1 = bfhi(raw[d0][q]) * (rn * wa[2 * q + 1]);
        const float b0 = bflo(raw[d0 + 2][q]) * (rn * wb[2 * q]), b1 = bfhi(raw[d0 + 2][q]) * (rn * wb[2 * q + 1]);
        na[2 * q] = a0 * c0.x - b0 * c0.y; nb[2 * q] = b0 * c0.x + a0 * c0.y;
        na[2 * q + 1] = a1 * c1.x - b1 * c1.y; nb[2 * q + 1] = b1 * c1.x + a1 * c1.y;
        qn2 += (na[2 * q] * na[2 * q] + nb[2 * q] * nb[2 * q]) + (na[2 * q + 1] * na[2 * q + 1] + nb[2 * q + 1] * nb[2 * q + 1]); }
      { u32x4 w = {cvtpk(na[0], na[1]), cvtpk(na[2], na[3]), cvtpk(na[4], na[5]), cvtpk(na[6], na[7])}; qr[d0] = *reinterpret_cast<bf16x8*>(&w); }
      { u32x4 w = {cvtpk(nb[0], nb[1]), cvtpk(nb[2], nb[3]), cvtpk(nb[4], nb[5]), cvtpk(nb[6], nb[7])}; qr[d0 + 2] = *reinterpret_cast<bf16x8*>(&w); }
      asm volatile("" ::: "memory"); }
    { auto rr = __builtin_amdgcn_permlane32_swap(__float_as_uint(qn2), __float_as_uint(qn2), false, false); qn2 = __uint_as_float(rr[0]) + __uint_as_float(rr[1]); }
    mshift = fmaxf(sqrtf(qn2) * kmaxc - 40.0f, 0.0f);
}
template <bool SHIFT>
__device__ __forceinline__ void attn_main(const bf16_t* __restrict__ Kh, const bf16_t* __restrict__ Vh, const bf16_t* __restrict__ GAb, bf16_t* __restrict__ Ob, float* __restrict__ ssq,
                                          int seq, LAS char* lds, LAS char* lscr, int wave_s,
                                          const bf16_t* __restrict__ Qb, const float* __restrict__ qnw, const f32x2* __restrict__ tab, float kmaxc, int pos0) {
  const int lane = fresh_lane(), r32 = lane & 31, hi = lane >> 5;
  LAS char* const Vr = lds; LAS char* const Kr = lds + 4 * SHM_V;
  float l_reg = 0; f32x16 o[4] = {};
  unsigned ksrc[2], vsrc[2];
#pragma unroll
  for (int i = 0; i < 2; ++i) { const int p = 2 * wave_s + i;
    const int row = 4 * p + (lane >> 4), lc = (lane & 15) ^ (row & 15); ksrc[i] = (unsigned)(row * LDK + lc * 8) * 2u;
    const int st = 2 * p + (lane >> 5), q = lane & 31, kk = (st >> 2) * 8 + (q >> 2), k = (kk & ~0xC) | ((kk & 4) << 1) | ((kk & 8) >> 1), c = (st & 3) * 32 + (q & 3) * 8;
    vsrc[i] = (unsigned)(k * LDK + c) * 2u; }
  const unsigned ldsw = (unsigned)wave_s * 2048u;
  const int vb0 = (int)(uintptr_t)Vr + v_rd_base(lane);
  const LAS char* kp[8];
#pragma unroll
  for (int d0 = 0; d0 < 8; ++d0) kp[d0] = Kr + r32 * 256 + (((2 * d0 + hi) ^ (r32 & 15)) << 4);
#define DMA(T, TS) do { const char* kg = (const char*)Kh + (size_t)(T) * (KVBLK * LDK * 2); const char* vg = (const char*)Vh + (size_t)(T) * (KVBLK * LDK * 2); \
    const unsigned so = (unsigned)(uintptr_t)Vr + ((unsigned)(TS) & 3u) * (unsigned)SHM_K + ldsw; \
    glds16s(ksrc[0], kg, so + 4 * (unsigned)SHM_V); glds16s(vsrc[0], vg, so); glds16s(ksrc[1], kg, so + 4 * (unsigned)SHM_V + 1024u); glds16s(vsrc[1], vg, so + 1024u); } while (0)
#define WAITBAR(N) asm volatile("s_waitcnt vmcnt(" #N ") lgkmcnt(0)\n\ts_barrier" ::: "memory")
#define QKT(P0, P1, KSO) do { P0 = f32x16{}; P1 = f32x16{}; __builtin_amdgcn_s_setprio(1); \
    _Pragma("unroll") for (int d0 = 0; d0 < 8; ++d0) { const bf16x8 b0 = *(const LAS bf16x8*)(kp[d0] + (KSO)); \
      P0 = __builtin_amdgcn_mfma_f32_32x32x16_bf16(b0, qr[d0], P0, 0, 0, 0); } \
    _Pragma("unroll") for (int d0 = 0; d0 < 8; ++d0) { const bf16x8 b1 = *(const LAS bf16x8*)(kp[d0] + (KSO) + 8192); \
      P1 = __builtin_amdgcn_mfma_f32_32x32x16_bf16(b1, qr[d0], P1, 0, 0, 0); } __builtin_amdgcn_s_setprio(0); } while (0)
#define NEXTDMA(T) do { const int t2 = (T) + 2; DMA(t2 < NT ? t2 : t2 - NT, t2); } while (0)
#define SOFT() softmax_tile<SHIFT>(p0, p1, l_reg, pa0, pa1, pa2, pa3, mshift)
#define PV(T) pv_d0<0>(o, vb0 + ((T) & 3) * (int)SHM_V, pa0, pa1, pa2, pa3)
  f32x16 p0, p1; bf16x8 pa0, pa1, pa2, pa3; const int NT = seq / KVBLK;
  DMA(0, 0); DMA(1, 1);
  bf16x8 qr[8]; float mshift;
  attn_q_prologue(Qb, qnw, tab, kmaxc, pos0, wave_s, r32, hi, qr, mshift);
  if (!SHIFT) mshift = 0.f;
  if (wave_s < 4) {
    for (int j = 0; j < NT; ++j) {
      WAITBAR(4); NEXTDMA(j); SBAR();
      QKT(p0, p1, (j & 3) * (int)SHM_K); SBAR();
      SOFT(); SBAR();
      PV(j); SBAR();
    }
  } else {
    WAITBAR(4); NEXTDMA(0); SBAR();
    QKT(p0, p1, 0); SBAR();
    for (int j = 1; j < NT; ++j) {
      WAITBAR(4); NEXTDMA(j); SBAR();
      SOFT(); SBAR();
      PV(j - 1); SBAR();
      QKT(p0, p1, (j & 3) * (int)SHM_K); SBAR();
    }
    SOFT(); SBAR();
    PV(NT - 1); SBAR();
  }
  asm volatile("s_waitcnt vmcnt(0)" ::: "memory");
#undef NEXTDMA
#undef SOFT
#undef PV
  { auto rr = __builtin_amdgcn_permlane32_swap(__float_as_uint(l_reg), __float_as_uint(l_reg), false, false); l_reg = __uint_as_float(rr[0]) + __uint_as_float(rr[1]); }
  u32x4 gw[8];
  { const int tg = fresh_lane(); const bf16_t* gp = GAb + (long)(wave_s * QBLK + (tg >> 4)) * 1024 + (tg & 15) * 8;
#pragma unroll
    for (int i = 0; i < 8; ++i) gw[i] = *(const u32x4*)(gp + (long)(4 * i) * 1024); }
  asm volatile("s_waitcnt lgkmcnt(0)\n\ts_barrier" ::: "memory");
  { const int le = fresh_lane(); LAS float* li_w = (LAS float*)lscr + wave_s * 64; if (le < 32) li_w[le] = l_reg; } asm volatile("s_waitcnt lgkmcnt(0)" ::: "memory");
  { const int te = fresh_lane(); const LAS float* li_l = (const LAS float*)lscr + wave_s * 64; LAS float* stg = (LAS float*)(lds + wave_s * 16384);
    const int er = te & 31, eh = (te >> 5) & 1;
#pragma unroll
    for (int r = 0; r < 16; ++r) { const int orow = (r & 3) + 8 * (r >> 2) + 4 * eh; const float rl = __builtin_amdgcn_rcpf(li_l[orow]);
#pragma unroll
      for (int d0 = 0; d0 < 4; ++d0) stg[orow * 128 + d0 * 32 + er] = o[d0][r] * rl; }
    asm volatile("s_waitcnt lgkmcnt(0)" ::: "memory");
    const int pc = te & 15, r0 = te >> 4;
    bf16_t* op = Ob + (long)(wave_s * QBLK + r0) * LDO + pc * 8;
#pragma unroll
    for (int i = 0; i < 8; ++i) { const LAS f32x4* sp = (const LAS f32x4*)(stg + (r0 + 4 * i) * 128 + pc * 8); const f32x4 a = sp[0], b = sp[1]; f32x4 v0, v1;
      v0[0] = a[0] * bflo(gw[i].x); v0[1] = a[1] * bfhi(gw[i].x); v0[2] = a[2] * bflo(gw[i].y); v0[3] = a[3] * bfhi(gw[i].y);
      v1[0] = b[0] * bflo(gw[i].z); v1[1] = b[1] * bfhi(gw[i].z); v1[2] = b[2] * bflo(gw[i].w); v1[3] = b[3] * bfhi(gw[i].w);
      float s2 = 0.f;
#pragma unroll
      for (int e = 0; e < 4; ++e) s2 += v0[e] * v0[e] + v1[e] * v1[e];
      *(u32x4*)(op + (long)(4 * i) * LDO) = pg8::pack8(v0, v1);
      s2 += __shfl_xor(s2, 1); s2 += __shfl_xor(s2, 2); s2 += __shfl_xor(s2, 4); s2 += __shfl_xor(s2, 8);
      if (pc == 0) ssq[(long)(wave_s * QBLK + r0 + 4 * i) * 8] = s2; } }
  asm volatile("s_waitcnt lgkmcnt(0)\n\ts_barrier" ::: "memory");
#undef DMA
#undef WAITBAR
#undef QKT
}
__device__ __forceinline__ void attn_dense_body(const bf16_t* __restrict__ Qb, const bf16_t* __restrict__ Kh, const bf16_t* __restrict__ Vh,
                                                const bf16_t* __restrict__ GAb, bf16_t* __restrict__ Ob, float* __restrict__ ssq,
                                                const float* __restrict__ qnw, const f32x2* __restrict__ tab, float kwmax, bool need_shift, int wave_s, int pos0, int seq, LAS char* lds, LAS char* lscr) {
  unsigned kwb = __float_as_uint(kwmax); asm volatile("" : "+s"(kwb));
  const float kmaxc = __uint_as_float(kwb) * (11.313708498984761f * 1.01f);
  if (__builtin_expect(need_shift, 0)) attn_main<true>(Kh, Vh, GAb, Ob, ssq, seq, lds, lscr, wave_s, Qb, qnw, tab, kmaxc, pos0);
  else attn_main<false>(Kh, Vh, GAb, Ob, ssq, seq, lds, lscr, wave_s, Qb, qnw, tab, kmaxc, pos0);
}
#undef KSWZ
#undef SBAR
}

constexpr size_t MiB = 1u << 20;
constexpr size_t WS_CTL = 0, CTL_ZERO_BYTES = 1 * MiB;
constexpr size_t WS_RS = 1 * MiB;
constexpr size_t WS_RATIO = 2 * MiB;
constexpr size_t WS_RSN = 3 * MiB;
constexpr size_t WS_SSQA = 4 * MiB;
constexpr size_t WS_SSQS = 6 * MiB;
constexpr size_t WS_TAB = 10 * MiB;
constexpr size_t WS_WINT = 16 * MiB;
constexpr size_t WS_WGLUT = 34 * MiB;
constexpr size_t WS_WOUTT = 36 * MiB;
constexpr size_t WS_Q = 64 * MiB;
constexpr size_t WS_KV = 192 * MiB;
constexpr size_t WS_GA = 256 * MiB;
constexpr size_t WS_GS = 384 * MiB;
constexpr size_t WS_MG = 512 * MiB;
constexpr size_t WS_Y = 768 * MiB;
constexpr size_t WS_END = 896 * MiB;
constexpr size_t OU_XB = 0;
constexpr size_t OU_BTM = 0;
constexpr size_t OU_LR = 64 * MiB;
constexpr size_t OU_AG = 256 * MiB;
constexpr size_t OU_WLR = 448 * MiB;
constexpr size_t OU_K0 = 464 * MiB;
static_assert(OU_BTM + (size_t)NG * UC * KA * 2 <= OU_LR && OU_LR + (size_t)NG * NCHUNK * 256 * 4 <= OU_AG && OU_AG + (size_t)NG * NCHUNK * KA * 2 <= OU_WLR
              && OU_WLR + (size_t)NG * 256 * UC * 2 <= OU_K0 && OU_K0 + (size_t)NG * 2 * CT * 256 * 4 <= 512 * MiB, "d_out scratch map");
constexpr size_t WS_NEED = 896 * MiB;

constexpr int CW_TMO = 0, CW_BAR = 4096;

#define XB_TMO      128
#define XB_XCNT(j)  (256  + 64 * (j))
#define XB_XSUB(j)  (1280 + 64 * (j))
#define XB_XGEN(j)  (2304 + 64 * (j))
#define XB_TOP      3328
#define XB_TOPGEN   3392
#define XCD_BAR_WORDS 3456
#define XB_SPIN_CAP (1u << 20)
__device__ __forceinline__ unsigned xb_ld(unsigned* p)              { return __hip_atomic_load(p, __ATOMIC_RELAXED, __HIP_MEMORY_SCOPE_AGENT); }
__device__ __forceinline__ unsigned xb_add(unsigned* p, unsigned v) { return __hip_atomic_fetch_add(p, v, __ATOMIC_RELAXED, __HIP_MEMORY_SCOPE_AGENT); }
__device__ __forceinline__ unsigned xb_xcc_id() { return (unsigned)__builtin_amdgcn_s_getreg((3 << 11) | 20) & 0xFu; }
#define XB_SPIN(cond, bar) do { unsigned _sp = 0; while (cond) { __builtin_amdgcn_s_sleep(1); \
    if ((++_sp & 255u) == 0u) { if (xb_ld(&(bar)[XB_TMO])) break; if (_sp > XB_SPIN_CAP) { atomicAdd(&(bar)[XB_TMO], 1u); break; } } } } while (0)
struct XcdBarrier { unsigned* bar; unsigned x; volatile LAS unsigned* st; };
__device__ __forceinline__ XcdBarrier xcd_barrier_post(unsigned* bar, volatile LAS unsigned* st, bool leader) {
    XcdBarrier b; b.bar = bar; b.x = xb_xcc_id(); b.st = st;
    if (leader) (void)xb_add(&bar[XB_XCNT(b.x)], 1u);
    return b;
}
__device__ __forceinline__ void xcd_barrier_complete(unsigned* bar, unsigned x, unsigned& nloc, unsigned& nx) {
    const unsigned G = gridDim.x * gridDim.y * gridDim.z;
    unsigned sum, cnt, mine, sp = 0u;
    for (;;) {
        sum = 0u; cnt = 0u; mine = 0u;
#pragma unroll
        for (unsigned j = 0; j < 16; ++j) { const unsigned c = xb_ld(&bar[XB_XCNT(j)]); sum += c; cnt += (c > 0u) ? 1u : 0u; mine = (j == x) ? c : mine; }
        if (sum == G) break;
        __builtin_amdgcn_s_sleep(1);
        if ((++sp & 255u) == 0u) { if (xb_ld(&bar[XB_TMO])) break; if (sp > XB_SPIN_CAP) { atomicAdd(&bar[XB_TMO], 1u); break; } }
    }
    nloc = mine > 0u ? mine : 1u; nx = cnt > 0u ? cnt : 1u;
}
__device__ __forceinline__ void xcd_barrier(const XcdBarrier& b, bool leader) {
    asm volatile("s_waitcnt vmcnt(0)" ::: "memory");
    __syncthreads();
    if (leader) {
        unsigned* bar = b.bar;
        __builtin_amdgcn_s_waitcnt(0);
        unsigned nloc = b.st[0], nx = b.st[1];
        if (nloc == 0u) { xcd_barrier_complete(bar, b.x, nloc, nx); b.st[0] = nloc; b.st[1] = nx; }
        const unsigned old = xb_add(&bar[XB_XSUB(b.x)], 1u);
        const unsigned gen = old / nloc;
        if (old + 1u == (gen + 1u) * nloc) {
            __builtin_amdgcn_fence(__ATOMIC_RELEASE, "agent");
            asm volatile("s_waitcnt vmcnt(0)" ::: "memory");
            const unsigned og = xb_add(&bar[XB_TOP], 1u);
            const unsigned tg = og / nx;
            if (og + 1u == (tg + 1u) * nx) xb_add(&bar[XB_TOPGEN], 1u);
            else XB_SPIN(xb_ld(&bar[XB_TOPGEN]) == tg, bar);
            __builtin_amdgcn_fence(__ATOMIC_ACQUIRE, "agent");
            xb_add(&bar[XB_XGEN(b.x)], 1u);
            asm volatile("s_waitcnt vmcnt(0)" ::: "memory");
        } else {
            XB_SPIN(xb_ld(&bar[XB_XGEN(b.x)]) == gen, bar);
            __builtin_amdgcn_fence(__ATOMIC_ACQUIRE, "agent");
            asm volatile("s_waitcnt vmcnt(0)" ::: "memory");
        }
    }
    __syncthreads();
}

constexpr int RING_OFF = 0, RING_BYTES = 131072;
constexpr int LDSCTL_OFF = RING_BYTES, MISC_OFF = LDSCTL_OFF + 320;
constexpr int LDS_BYTES = 147456;
constexpr int NWAVES = 8;

struct Args {
    const float* in[18]; float* out; unsigned char* ws; int ph_lo, ph_hi, li, pad;
};

__device__ __forceinline__ float wave_sum(float v) {
#pragma unroll
    for (int o = 1; o < 64; o <<= 1) v += __shfl_xor(v, o);
    return v;
}
__device__ __forceinline__ void p0_transpose_item(const float* W, int K, int N, bf16_t* WT, LAS float* scr, int item, int lane, const float* ks1, const float* ks2, int ksplit) {
    const int nblk = N / 32, kb = item / nblk, nb = item % nblk, k0 = 64 * kb, n0 = 32 * nb;
    f32x4 v[8]; float sc[8];
#pragma unroll
    for (int i = 0; i < 8; ++i) { const int kk = 8 * i + (lane >> 3), k = k0 + kk; sc[i] = 1.f; if (ks1) sc[i] = (k < ksplit) ? ks1[k] : ks2[k - ksplit];
        v[i] = *(const f32x4*)(W + (size_t)k * N + n0 + (lane & 7) * 4); }
#pragma unroll
    for (int i = 0; i < 8; ++i) { const int kk = 8 * i + (lane >> 3); LAS float* d = scr + kk * 33 + (lane & 7) * 4;
        d[0] = v[i].x * sc[i]; d[1] = v[i].y * sc[i]; d[2] = v[i].z * sc[i]; d[3] = v[i].w * sc[i]; }
    asm volatile("s_waitcnt lgkmcnt(0)" ::: "memory");
    const int c = lane & 7;
#pragma unroll
    for (int j = 0; j < 4; ++j) { const int n = (lane >> 3) + 8 * j; const LAS float* s = scr + (8 * c) * 33 + n;
        u32x4 o; o.x = cvt_pk_bf16(s[0 * 33], s[1 * 33]); o.y = cvt_pk_bf16(s[2 * 33], s[3 * 33]); o.z = cvt_pk_bf16(s[4 * 33], s[5 * 33]); o.w = cvt_pk_bf16(s[6 * 33], s[7 * 33]);
        *(GAS u32x4*)(WT + (size_t)(n0 + n) * K + k0 + 8 * c) = o; }
    asm volatile("s_waitcnt lgkmcnt(0)" ::: "memory");
}
__device__ __forceinline__ void ssm_disc(const float* lre, const float* lim, const float* lstep, int d, int g, int p, f32x2& lb, f32x2& bs) {
    const float lr = lre[(d * NG + g) * NPST + p], li = lim[(d * NG + g) * NPST + p], dt = expf(lstep[d * NG + g]);
    const float mag = expf(lr * dt), ang = li * dt; lb.x = mag * cosf(ang); lb.y = mag * sinf(ang);
    const float nr = lb.x - 1.0f, ni = lb.y, den = 1.0f / (lr * lr + li * li);
    bs.x = (nr * lr + ni * li) * den; bs.y = (ni * lr - nr * li) * den;
}
__device__ __forceinline__ f32x2 ssm_pow(const float* lre, const float* lim, const float* lstep, int d, int g, int p, int e) {
    const float lr = lre[(d * NG + g) * NPST + p], li = lim[(d * NG + g) * NPST + p], dt = expf(lstep[d * NG + g]);
    const float mag = expf(lr * dt * (float)e), ang = li * dt * (float)e; f32x2 r; r.x = mag * cosf(ang); r.y = mag * sinf(ang); return r;
}
__device__ __forceinline__ f32x2 cmul(f32x2 a, f32x2 b) { f32x2 r; r.x = a.x * b.x - a.y * b.y; r.y = a.x * b.y + a.y * b.x; return r; }

__global__ void __launch_bounds__(NWAVES * 64, 2) enc_fwd(Args args) {
    extern __shared__ __attribute__((aligned(16))) unsigned char lds[];
    LAS unsigned char* const L = (LAS unsigned char*)lds;
    volatile LAS unsigned* const MISC = (volatile LAS unsigned*)(L + MISC_OFF);
    const int wave = __builtin_amdgcn_readfirstlane((int)threadIdx.x >> 6);
#define LEADER() (wave == 0 && fresh_lane() == 0)
#define PHASE_IDS() const int lane = fresh_lane(); const int tid = wave * 64 + lane; (void)tid
    const int G = gridDim.x; const int bx = blockIdx.x; const int vcu = (G % 8 == 0) ? (bx % 8) * (G / 8) + bx / 8 : bx;
    unsigned char* const ws = args.ws; unsigned char* const ou = (unsigned char*)args.out;
    gu32* const ctl = (gu32*)(ws + WS_CTL);
    const float* x_p = args.in[0]; const float* x_s = args.in[1]; const float* norm_w = args.in[2]; const float* w_in = args.in[3];
    const float* q_norm_w = args.in[4]; const float* k_norm_w = args.in[5]; const float* lam_re = args.in[6]; const float* lam_im = args.in[7]; const float* log_step = args.in[8];
    const float* b_re = args.in[9]; const float* b_im = args.in[10]; const float* c_re = args.in[11]; const float* c_im = args.in[12]; const float* d_skip = args.in[13];
    const float* w_glu = args.in[14]; const float* aonw = args.in[15]; const float* sonw = args.in[16]; const float* w_out = args.in[17];
    float* const RS = (float*)(ws + WS_RS); float* const RATIO = (float*)(ws + WS_RATIO); float* const RSN = (float*)(ws + WS_RSN);
    float* const SSQA = (float*)(ws + WS_SSQA); float* const SSQS = (float*)(ws + WS_SSQS); f32x2* const TAB = (f32x2*)(ws + WS_TAB);
    bf16_t* const WINT = (bf16_t*)(ws + WS_WINT); bf16_t* const WGLUT = (bf16_t*)(ws + WS_WGLUT); bf16_t* const WOUTT = (bf16_t*)(ws + WS_WOUTT);
    bf16_t* const QB = (bf16_t*)(ws + WS_Q); bf16_t* const KVB = (bf16_t*)(ws + WS_KV); bf16_t* const GA = (bf16_t*)(ws + WS_GA); bf16_t* const GS = (bf16_t*)(ws + WS_GS);
    bf16_t* const MG = (bf16_t*)(ws + WS_MG); bf16_t* const YB = (bf16_t*)(ws + WS_Y); float* const LR = (float*)(ou + OU_LR);
    bf16_t* const XB = (bf16_t*)(ou + OU_XB); bf16_t* const BTM = (bf16_t*)(ou + OU_BTM); bf16_t* const AG = (bf16_t*)(ou + OU_AG);
    bf16_t* const WLR = (bf16_t*)(ou + OU_WLR); float* const K0T = (float*)(ou + OU_K0);

    { PHASE_IDS(); for (int u = tid; u < (LDS_BYTES - LDSCTL_OFF) / 4; u += NWAVES * 64) ((LAS unsigned*)(L + LDSCTL_OFF))[u] = 0u; }
    __syncthreads();
    XcdBarrier bar; bar.bar = (unsigned*)(ctl + CW_BAR) + args.li * XCD_BAR_WORDS; bar.x = 0; bar.st = nullptr;
    if (N_LAUNCHES != NPH) bar = xcd_barrier_post((unsigned*)(ctl + CW_BAR) + args.li * XCD_BAR_WORDS, MISC + 8, LEADER());
#define GRID_BAR() do { if (N_LAUNCHES == NPH) { if (LEADER()) __hip_atomic_store(ctl + CW_TMO, 0xBADBA0u, __ATOMIC_RELAXED, __HIP_MEMORY_SCOPE_AGENT); } else { xcd_barrier(bar, LEADER()); } } while (0)
    const int lo = args.ph_lo, hi = args.ph_hi;
#ifndef PH_ONLY
#define PH_ONLY -1
#endif
#define IN(k) ((PH_ONLY < 0 || PH_ONLY == (k)) && lo <= (k) && (k) < hi)
#define BOTH(k) (IN(k) && IN((k) + 1))
#ifndef REPMASK
#define REPMASK 0
#endif
#define REPF(k) (1 + ((REPMASK >> (k)) & 1))
#define THIN_REP(k) _Pragma("unroll") for (int rep_ = 0; rep_ < REPF(k); ++rep_)
    const int gw = vcu * NWAVES + wave, NGW = G * NWAVES;
    LAS float* const scr = (LAS float*)(L + RING_OFF + wave * 16384);

    if (IN(0)) {
        PHASE_IDS();
        THIN_REP(8) {
        {
            constexpr int I_IN = (DM / 64) * (INC / 32), I_GLU = (1024 / 64) * (1024 / 32), I_OUT = (2048 / 64) * (2048 / 32);
            for (int it = gw; it < I_IN + I_GLU + I_OUT; it += NGW) {
                int r = it;
                if (r < I_IN) { p0_transpose_item(w_in, DM, INC, WINT, scr, r, lane, norm_w, norm_w, DM); continue; } r -= I_IN;
                if (r < I_GLU) { p0_transpose_item(w_glu, 1024, 1024, WGLUT, scr, r, lane, nullptr, nullptr, 0); continue; } r -= I_GLU;
                p0_transpose_item(w_out, 2048, 2048, WOUTT, scr, r, lane, aonw, sonw, 1024);
            }
        }
        for (int i = gw * 64 + lane; i < 128 * 32; i += NGW * 64) { const int pos = i >> 5, f = i & 31;
            const float inv = 1.0f / powf(10000.0f, (float)f * (1.0f / 32.0f)); const float ang = (float)pos * inv; f32x2 cs; cs.x = cosf(ang); cs.y = sinf(ang); TAB[i] = cs; }
        for (int it = gw; it < NG * 2 * TB4; it += NGW) {
            const int g = __builtin_amdgcn_readfirstlane(it / (2 * TB4)), d = __builtin_amdgcn_readfirstlane((it / TB4) & 1), tb = __builtin_amdgcn_readfirstlane(it % TB4);
            const int tl = lane >> 4, co = lane & 15, tau = tb * 4 + tl;
            LAS f32x2* Es = (LAS f32x2*)scr;
            LAS f32x2* Cs = (LAS f32x2*)(scr + 512);
#pragma unroll
            for (int i = 0; i < 4; ++i) { const int p = co + 16 * i; f32x2 lb, bs; ssm_disc(lam_re, lam_im, log_step, d, g, p, lb, bs); const f32x2 pw = ssm_pow(lam_re, lam_im, log_step, d, g, p, tau); Es[tl * 64 + p] = cmul(pw, bs); }
#pragma unroll
            for (int k = 0; k < 16; ++k) { f32x2 c; c.x = c_re[((size_t)(d * NG + g) * NCH + k) * NPST + lane]; c.y = c_im[((size_t)(d * NG + g) * NCH + k) * NPST + lane]; Cs[k * 65 + lane] = c; }
            asm volatile("s_waitcnt lgkmcnt(0)" ::: "memory");
            float acc[16];
#pragma unroll
            for (int ci = 0; ci < 16; ++ci) acc[ci] = 0.f;
            LAS float* Bs = scr + 512 + 2 * 16 * 65;
#pragma unroll
            for (int ph = 0; ph < 2; ++ph) {
                const float* brg = b_re + ((size_t)g * NPST + 32 * ph) * NCH; const float* big = b_im + ((size_t)g * NPST + 32 * ph) * NCH;
                const f32x4 r0 = *(const f32x4*)(brg + lane * 8), r1 = *(const f32x4*)(brg + lane * 8 + 4), i0 = *(const f32x4*)(big + lane * 8), i1 = *(const f32x4*)(big + lane * 8 + 4);
                asm volatile("s_waitcnt lgkmcnt(0)" ::: "memory");
                *(LAS f32x4*)(Bs + lane * 8) = r0; *(LAS f32x4*)(Bs + lane * 8 + 4) = r1; *(LAS f32x4*)(Bs + 512 + lane * 8) = i0; *(LAS f32x4*)(Bs + 512 + lane * 8 + 4) = i1;
                asm volatile("s_waitcnt lgkmcnt(0)" ::: "memory");
#pragma unroll 4
                for (int pp = 0; pp < 32; ++pp) { const int p = 32 * ph + pp; const f32x2 ce = cmul(Cs[co * 65 + p], Es[tl * 64 + p]);
                    const LAS f32x4* br = (const LAS f32x4*)(Bs + pp * 16); const LAS f32x4* bi = (const LAS f32x4*)(Bs + 512 + pp * 16);
#pragma unroll
                    for (int q = 0; q < 4; ++q) { const f32x4 a = br[q], b2 = bi[q];
                        acc[4 * q] += ce.x * a.x - ce.y * b2.x; acc[4 * q + 1] += ce.x * a.y - ce.y * b2.y; acc[4 * q + 2] += ce.x * a.z - ce.y * b2.z; acc[4 * q + 3] += ce.x * a.w - ce.y * b2.w; } }
            }
            if (d == 0 && tau == 0) {
                const float dsk = d_skip[g * NCH + co];
#pragma unroll
                for (int ci = 0; ci < 16; ++ci) acc[ci] += (ci == co) ? dsk : 0.f; }
            float* dst = K0T + (((size_t)(g * 2 + d) * CT + tau) * NCH + co) * NCH;
#pragma unroll
            for (int q = 0; q < 4; ++q) *(f32x4*)(dst + 4 * q) = (f32x4){acc[4 * q], acc[4 * q + 1], acc[4 * q + 2], acc[4 * q + 3]};
            asm volatile("s_waitcnt lgkmcnt(0)" ::: "memory");
        }
        for (int it = gw; it < NG * 2 * TB4; it += NGW) {
            const int g = it / (2 * TB4), d = (it / TB4) & 1, jb = it % TB4, p = lane; f32x2 lb, bs; ssm_disc(lam_re, lam_im, log_step, d, g, p, lb, bs);
            float br[16], bi[16];
#pragma unroll
            for (int ci = 0; ci < 16; ++ci) { br[ci] = b_re[((size_t)g * NPST + p) * NCH + ci]; bi[ci] = b_im[((size_t)g * NPST + p) * NCH + ci]; }
            const int e0 = d == 0 ? (CT - 4 - 4 * jb) : 4 * jb;
            f32x2 w = cmul(bs, ssm_pow(lam_re, lam_im, log_step, d, g, p, e0));
            bf16_t* rre = WLR + ((size_t)g * 256 + d * 128 + p) * UC; bf16_t* rim = rre + (size_t)64 * UC;
#pragma unroll
            for (int es = 0; es < 4; ++es) { const int e = e0 + es, jp = d == 0 ? (CT - 1 - e) : e; float vr[16], vi[16];
#pragma unroll
                for (int ci = 0; ci < 16; ++ci) { vr[ci] = w.x * br[ci] - w.y * bi[ci]; vi[ci] = w.x * bi[ci] + w.y * br[ci]; }
                u32x4 o0, o1, o2, o3;
                o0.x = cvt_pk_bf16(vr[0], vr[1]); o0.y = cvt_pk_bf16(vr[2], vr[3]); o0.z = cvt_pk_bf16(vr[4], vr[5]); o0.w = cvt_pk_bf16(vr[6], vr[7]);
                o1.x = cvt_pk_bf16(vr[8], vr[9]); o1.y = cvt_pk_bf16(vr[10], vr[11]); o1.z = cvt_pk_bf16(vr[12], vr[13]); o1.w = cvt_pk_bf16(vr[14], vr[15]);
                o2.x = cvt_pk_bf16(vi[0], vi[1]); o2.y = cvt_pk_bf16(vi[2], vi[3]); o2.z = cvt_pk_bf16(vi[4], vi[5]); o2.w = cvt_pk_bf16(vi[6], vi[7]);
                o3.x = cvt_pk_bf16(vi[8], vi[9]); o3.y = cvt_pk_bf16(vi[10], vi[11]); o3.z = cvt_pk_bf16(vi[12], vi[13]); o3.w = cvt_pk_bf16(vi[14], vi[15]);
                *(u32x4*)(rre + jp * 16) = o0; *(u32x4*)(rre + jp * 16 + 8) = o1; *(u32x4*)(rim + jp * 16) = o2; *(u32x4*)(rim + jp * 16 + 8) = o3;
                w = cmul(w, lb); }
        }
        for (int m = gw * 4; m < NTOK; m += NGW * 4) {
            const float* xrow = m < NPROMPT ? x_p + (size_t)m * DM : x_s + (size_t)(m - NPROMPT) * DM;
            const f32x4* xr = (const f32x4*)xrow + lane; f32x4 v[4][8]; float ssum[4];
#pragma unroll
            for (int q = 0; q < 4; ++q)
#pragma unroll
                for (int j = 0; j < 8; ++j) v[q][j] = __builtin_nontemporal_load(xr + 512 * q + 64 * j);
#pragma unroll
            for (int q = 0; q < 4; ++q) { float s0 = 0.f;
#pragma unroll
                for (int j = 0; j < 8; ++j) s0 += (v[q][j].x * v[q][j].x + v[q][j].y * v[q][j].y) + (v[q][j].z * v[q][j].z + v[q][j].w * v[q][j].w);
                ssum[q] = wave_sum(s0); }
            if (lane == 0) { f32x4 r; r.x = 1.0f / sqrtf(ssum[0] * (1.0f / DM) + EPS); r.y = 1.0f / sqrtf(ssum[1] * (1.0f / DM) + EPS); r.z = 1.0f / sqrtf(ssum[2] * (1.0f / DM) + EPS); r.w = 1.0f / sqrtf(ssum[3] * (1.0f / DM) + EPS); *(f32x4*)(RS + m) = r; }
            GAS u32x2* o8 = (GAS u32x2*)(XB + (size_t)m * DM) + lane;
#pragma unroll
            for (int q = 0; q < 4; ++q)
#pragma unroll
                for (int j = 0; j < 8; ++j) { u32x2 w; w.x = cvt_pk_bf16(v[q][j].x, v[q][j].y); w.y = cvt_pk_bf16(v[q][j].z, v[q][j].w); o8[512 * q + 64 * j] = w; }
        }
        }
        if (BOTH(0)) GRID_BAR();
    }

    if (IN(1)) {
        pg8::Gemm g{XB, WINT, DM, DM, DM, 0, 0}; pg8::StaticOrder S; S.init(NTOK, INC, G, bx, REPF(1));
        pg8::EpiInProj E{RS, QB, KVB, GA, GS, AG};
        pg8::gemm_phase<pg8::EpiInProj, pg8::StaticOrder, true, true>(L + RING_OFF, g, S, E, wave);
        if (BOTH(1)) GRID_BAR();
    }

    if (IN(2)) {
        PHASE_IDS();
        for (int m0 = gw * 8; m0 < NTOK; m0 += NGW * 8) {
            const int dl = (lane & 31) * 4;
            const int ax = dl >> 6, half = (dl >> 5) & 1, fi = dl & 31;
            const f32x4 kw = *(const f32x4*)(k_norm_w + dl);
            u32x2 wv[8]; f32x2 cs[8][4];
#pragma unroll
            for (int q = 0; q < 8; ++q) { const int m = m0 + q; wv[q] = *((const GAS u32x2*)(KVB + (size_t)m * 512) + lane);
                const int pos = m < NPROMPT ? (m & (SP - 1)) : ((m - NPROMPT) & (SS - 1)); const int prow = pos >> 6, pcol = pos & 63;
                const f32x2* tp = TAB + (ax == 0 ? prow : pcol) * 32 + fi; cs[q][0] = tp[0]; cs[q][1] = tp[1]; cs[q][2] = tp[2]; cs[q][3] = tp[3]; }
#pragma unroll
            for (int q = 0; q < 8; ++q) { const int m = m0 + q; const u32x2 w = wv[q];
                float v0 = bflo(w.x), v1 = bfhi(w.x), v2 = bflo(w.y), v3 = bfhi(w.y);
                float ss = (v0 * v0 + v1 * v1) + (v2 * v2 + v3 * v3);
                ss += __shfl_xor(ss, 1); ss += __shfl_xor(ss, 2); ss += __shfl_xor(ss, 4); ss += __shfl_xor(ss, 8); ss += __shfl_xor(ss, 16);
                const float rn = 1.0f / sqrtf(ss * (1.0f / 128.0f) + EPS);
                v0 *= rn * kw[0]; v1 *= rn * kw[1]; v2 *= rn * kw[2]; v3 *= rn * kw[3];
                const f32x2 c0 = cs[q][0], c1 = cs[q][1], c2 = cs[q][2], c3 = cs[q][3];
                const float p0 = __shfl_xor(v0, 8), p1 = __shfl_xor(v1, 8), p2 = __shfl_xor(v2, 8), p3 = __shfl_xor(v3, 8);
                float o0, o1, o2, o3;
                if (half == 0) { o0 = v0 * c0.x - p0 * c0.y; o1 = v1 * c1.x - p1 * c1.y; o2 = v2 * c2.x - p2 * c2.y; o3 = v3 * c3.x - p3 * c3.y; }
                else           { o0 = v0 * c0.x + p0 * c0.y; o1 = v1 * c1.x + p1 * c1.y; o2 = v2 * c2.x + p2 * c2.y; o3 = v3 * c3.x + p3 * c3.y; }
                u32x2 ow; ow.x = cvt_pk_bf16(o0, o1); ow.y = cvt_pk_bf16(o2, o3); *((GAS u32x2*)(KVB + (size_t)m * 512) + lane) = ow; }
        }
        THIN_REP(9) {
        for (long pc0 = (long)gw * 64 + lane; pc0 < (long)NG * UC * (UC / 8); pc0 += (long)NGW * 64 * 4) {
            f32x4 av[4], bv[4]; size_t dsto[4];
#pragma unroll
            for (int q = 0; q < 4; ++q) { const long pc = pc0 + (long)q * NGW * 64;
                const int kp8 = (int)(pc % (UC / 8)), n = (int)((pc / (UC / 8)) % UC), g = (int)(pc / ((long)UC * (UC / 8)));
                const int j = n >> 4, co = n & 15, jp = kp8 >> 1, ci0 = (kp8 & 1) * 8;
                const int dsel = j >= jp ? 0 : 1, tau = j >= jp ? j - jp : jp - j;
                const float* src = K0T + (((size_t)(g * 2 + dsel) * CT + tau) * NCH + co) * NCH + ci0;
                const float* s2 = K0T + (((size_t)(g * 2 + 1) * CT) * NCH + co) * NCH + ci0;
                const float dg = (j == jp) ? 1.f : 0.f;
                av[q] = *(const f32x4*)src + *(const f32x4*)s2 * dg; bv[q] = *(const f32x4*)(src + 4) + *(const f32x4*)(s2 + 4) * dg;
                dsto[q] = ((size_t)g * UC + n) * KA + kp8 * 8; }
#pragma unroll
            for (int q = 0; q < 4; ++q) *(u32x4*)(BTM + dsto[q]) = pg8::pack8(av[q], bv[q]);
        }
        for (int it = gw; it < NG * 2 * NCH; it += NGW) {
            const int g = it >> 5, d = (it >> 4) & 1, co = it & 15, p = lane; f32x2 lb, bs; ssm_disc(lam_re, lam_im, log_step, d, g, p, lb, bs);
            f32x2 c; c.x = c_re[((size_t)(d * NG + g) * NCH + co) * NPST + p]; c.y = c_im[((size_t)(d * NG + g) * NCH + co) * NPST + p];
            f32x2 w = cmul(c, lb);
            for (int e = 1; e <= CT; ++e) { const int j = d == 0 ? e - 1 : CT - e;
                bf16_t* dst = BTM + ((size_t)g * UC + j * 16 + co) * KA + UC + d * 128 + p;
                dst[0] = (bf16_t)(cvt_pk_bf16(w.x, w.x) & 0xffffu); dst[64] = (bf16_t)(cvt_pk_bf16(-w.y, -w.y) & 0xffffu);
                w = cmul(w, lb); }
        }
        }
        __syncthreads();
        {
            pg8::Gemm g{AG, WLR, KA, UC, UC, (size_t)NCHUNK * KA, (size_t)256 * UC}; pg8::BatchOrder S; S.init(NG, NCHUNK / 256, 1, G, vcu, REPF(2));
            pg8::EpiLR E{LR};
            pg8::gemm_phase<pg8::EpiLR, pg8::BatchOrder, true, true>(L + RING_OFF, g, S, E, wave);
        }
        if (BOTH(2)) GRID_BAR();
    }

    if (IN(3)) {
        PHASE_IDS();
        THIN_REP(10)
        for (int it = gw; it < 20 * NG * 2; it += NGW) {
            int s, rest; if (it < 4 * NG * 2) { s = 16 + it / (NG * 2); rest = it % (NG * 2); } else { const int t2 = it - 4 * NG * 2; s = t2 / (NG * 2); rest = t2 % (NG * 2); }
            const int g = rest >> 1, d = rest & 1, p = lane;
            const int c0 = s < 16 ? (SP / CT) * s : NPROMPT / CT + (SS / CT) * (s - 16), nc = s < 16 ? SP / CT : SS / CT;
            const f32x2 lT = ssm_pow(lam_re, lam_im, log_step, d, g, p, CT);
            const float* lr = LR + ((size_t)g * NCHUNK) * 256 + d * 128 + p; bf16_t* ag = AG + ((size_t)g * NCHUNK) * KA + UC + d * 128 + p;
            f32x2 h; h.x = 0.f; h.y = 0.f;
            for (int cb = 0; cb < nc; cb += 8) {
                float xr[8], xi[8];
#pragma unroll
                for (int q = 0; q < 8; ++q) { const int ch = d == 0 ? c0 + cb + q : c0 + nc - 1 - (cb + q); xr[q] = lr[(size_t)ch * 256]; xi[q] = lr[(size_t)ch * 256 + 64]; }
#pragma unroll
                for (int q = 0; q < 8; ++q) { const int ch = d == 0 ? c0 + cb + q : c0 + nc - 1 - (cb + q);
                    ag[(size_t)ch * KA] = (bf16_t)(cvt_pk_bf16(h.x, h.x) & 0xffffu); ag[(size_t)ch * KA + 64] = (bf16_t)(cvt_pk_bf16(h.y, h.y) & 0xffffu);
                    h = cmul(h, lT); h.x += xr[q]; h.y += xi[q]; }
            }
        }
        __syncthreads();
        float kwmax;
        { float kw = fmaxf(fabsf(k_norm_w[lane]), fabsf(k_norm_w[lane + 64]));
#pragma unroll
          for (int o_ = 1; o_ < 64; o_ <<= 1) kw = fmaxf(kw, __shfl_xor(kw, o_));
          kwmax = __uint_as_float(__builtin_amdgcn_readfirstlane(__float_as_uint(kw))); }
        bool need_shift;
        { float qw = fmaxf(fabsf(q_norm_w[lane]), fabsf(q_norm_w[lane + 64]));
#pragma unroll
          for (int o_ = 1; o_ < 64; o_ <<= 1) qw = fmaxf(qw, __shfl_xor(qw, o_));
          need_shift = __builtin_amdgcn_readfirstlane((int)(qw * kwmax * (0.088388347648318440f * 1.4426950408889634f * 128.0f * 1.0201f) > 40.0f)) != 0; }
        for (int i0 = 0; i0 < 2048; ++i0) {
            int seq_row0, seqlen, kvh, hq, qb; int i = i0;
            if (G == 256) {
                if (i0 >= 8 * REPF(3)) break; i = i0 & 7;
                const int xcd = vcu >> 5, loc = vcu & 31;
                if (i < 4) { const int s = xcd >> 1; kvh = xcd & 1; const int idx = loc * 4 + i; hq = idx >> 5; qb = idx & 31; seq_row0 = NPROMPT + s * SS; seqlen = SS; }
                else { const int combo = xcd * 4 + (i - 4); const int s = combo >> 1; kvh = combo & 1; hq = loc >> 3; qb = loc & 7; seq_row0 = s * SP; seqlen = SP; }
            } else {
                const int u = i * G + bx; if (u >= 2048) break;
                if (u < 1024) { const int combo = u >> 7, idx = u & 127; const int s = combo >> 1; kvh = combo & 1; hq = idx >> 5; qb = idx & 31; seq_row0 = NPROMPT + s * SS; seqlen = SS; }
                else { const int u2 = u - 1024; const int combo = u2 >> 5, idx = u2 & 31; const int s = combo >> 1; kvh = combo & 1; hq = idx >> 3; qb = idx & 7; seq_row0 = s * SP; seqlen = SP; }
            }
            const int h = kvh * 4 + hq; const long r0 = (long)seq_row0 + qb * 256;
            attn::attn_dense_body(QB + r0 * 1024 + h * 128, KVB + (long)seq_row0 * 512 + kvh * 128, KVB + (long)seq_row0 * 512 + 256 + kvh * 128,
                                  GA + r0 * 1024 + h * 128, MG + r0 * 2048 + h * 128, SSQA + r0 * 8 + h, q_norm_w, TAB, kwmax, need_shift, wave, qb * 256, seqlen, (LAS char*)(L + RING_OFF), (LAS char*)(L + LDSCTL_OFF + 1024));
        }
        if (BOTH(3)) GRID_BAR();
    }

    if (IN(4)) {
        pg8::Gemm g{AG, BTM, KA, KA, KA, (size_t)NCHUNK * KA, (size_t)UC * KA}; pg8::BatchOrder S; S.init(NG, NCHUNK / 256, UC / 256, G, vcu, REPF(4));
        pg8::EpiSsm E{YB};
        pg8::gemm_phase<pg8::EpiSsm, pg8::BatchOrder, true, true>(L + RING_OFF, g, S, E, wave);
        if (BOTH(4)) GRID_BAR();
    }

    if (IN(5)) {
        pg8::Gemm g{YB, WGLUT, 1024, 1024, 1024, 0, 0}; pg8::StaticOrder S; S.init(NTOK, 1024, G, bx, REPF(5));
        pg8::EpiGlu E{YB, GS, MG, SSQS};
        pg8::gemm_phase<pg8::EpiGlu, pg8::StaticOrder, true, true>(L + RING_OFF, g, S, E, wave);
        if (BOTH(5)) GRID_BAR();
    }

    if (IN(6)) {
        PHASE_IDS();
        for (int r = (vcu * NWAVES * 64) + tid; r < NTOK; r += G * NWAVES * 64) {
            const f32x4 a0 = *(const f32x4*)(SSQA + (size_t)r * 8), a1 = *(const f32x4*)(SSQA + (size_t)r * 8 + 4);
            const float sa = ((a0[0] + a0[1]) + (a0[2] + a0[3])) + ((a1[0] + a1[1]) + (a1[2] + a1[3]));
            float sb = 0.f;
#pragma unroll
            for (int q = 0; q < 4; ++q) { const f32x4 b = *(const f32x4*)(SSQS + (size_t)r * 16 + 4 * q); sb += (b[0] + b[1]) + (b[2] + b[3]); }
            const float ra = 1.0f / sqrtf(sa * (1.0f / 1024.0f) + EPS), rsv = 1.0f / sqrtf(sb * (1.0f / 1024.0f) + EPS);
            RATIO[r] = ra / rsv; RSN[r] = rsv;
        }
        if (BOTH(6)) GRID_BAR();
    }

    if (IN(7)) {
        pg8::Gemm g{MG, WOUTT, 2048, 2048, 2048, 0, 0}; pg8::StaticOrder S; S.init(NTOK, DM, G, bx, REPF(7));
        pg8::EpiOut E{x_p, x_s, args.out, RATIO, RSN};
        pg8::gemm_phase<pg8::EpiOut, pg8::StaticOrder, true, true>(L + RING_OFF, g, S, E, wave);
    }
#undef IN
#undef BOTH
#undef GRID_BAR
}

extern "C" void kernel_launch(void* const* d_in, const int* in_sizes, int n_in, void* d_out, int out_size, void* d_ws, size_t ws_size, hipStream_t stream) {
    static int grid = 0;
    if (grid == 0) {
        if (n_in != 18 || out_size != NTOK * DM || ws_size < WS_NEED) { fprintf(stderr, "kernel_launch: unexpected shapes (n_in %d out %d ws %zu)\n", n_in, out_size, ws_size); grid = -1; return; }
        int dev = 0, cus = 0, per_cu = 0;
        if (hipGetDevice(&dev) != hipSuccess || hipDeviceGetAttribute(&cus, hipDeviceAttributeMultiprocessorCount, dev) != hipSuccess) { grid = -1; return; }
        if (hipFuncSetAttribute((const void*)enc_fwd, hipFuncAttributeMaxDynamicSharedMemorySize, LDS_BYTES) != hipSuccess) { fprintf(stderr, "kernel_launch: hipFuncSetAttribute failed\n"); grid = -1; return; }
        if (hipOccupancyMaxActiveBlocksPerMultiprocessor(&per_cu, (const void*)enc_fwd, NWAVES * 64, LDS_BYTES) != hipSuccess || per_cu < 1) { fprintf(stderr, "kernel_launch: occupancy query says %d\n", per_cu); }
        (void)hipGetLastError();
        grid = cus;
    }
    if (grid < 0) return;
    (void)hipMemsetAsync((char*)d_ws + WS_CTL, 0, CTL_ZERO_BYTES, stream);
    Args a{};
    for (int i = 0; i < 18; ++i) a.in[i] = (const float*)d_in[i];
    a.out = (float*)d_out; a.ws = (unsigned char*)d_ws;
    for (int li = 0; li < N_LAUNCHES; ++li) {
        a.ph_lo = (N_LAUNCHES == NPH) ? li : 0; a.ph_hi = (N_LAUNCHES == NPH) ? li + 1 : NPH; a.li = (N_LAUNCHES == NPH) ? 0 : li;
        hipLaunchKernelGGL(enc_fwd, dim3(grid), dim3(NWAVES * 64), LDS_BYTES, stream, a);
    }
}
```
